# Optimizing an MI355X kernel written in HIP

```python
import math
import jax
import jax.numpy as jnp
from jax import lax
import numpy as np

D_MODEL = 1024
BATCH = 4
SEQ = 4096
DEPTH = 1

CTX_LEN = 256
GRID_W = 64
HEAD_DIM = 128
N_HEADS_GDN = 4
N_HEADS_RET = 4
W_GDN = N_HEADS_GDN * HEAD_DIM
W_RET = N_HEADS_RET * HEAD_DIM
MIX_WIDTH = W_GDN + W_RET
IN_COLS = 4 * W_GDN + 4 * N_HEADS_GDN + 4 * W_RET
CONV_K = 5
CHUNK = 64
D_FF = ((8 * D_MODEL + 3 * 256 - 1) // (3 * 256)) * 256
ROPE_THETA = 10000.0
ROPE_SEQ_PAIRS = 16
ROPE_ROW_PAIRS = 24
ROPE_COL_PAIRS = 24
HALF = HEAD_DIM // 2
NORM_EPS = 1e-6

kernel_name = "hybrid_gdn_retention_dit_block"


def rms_norm(x, g):
    xf = x.astype(jnp.float32)
    y = xf * lax.rsqrt(jnp.mean(xf * xf, axis=-1, keepdims=True) + NORM_EPS)
    return (y * g.astype(jnp.float32)).astype(x.dtype)


def head_group_norm(t, g):
    mu = jnp.mean(t, axis=-1, keepdims=True)
    var = jnp.mean(jnp.square(t - mu), axis=-1, keepdims=True)
    return (t - mu) * lax.rsqrt(var + NORM_EPS) * g.astype(jnp.float32)


def l2_normalize(t):
    return t * lax.rsqrt(jnp.sum(t * t, axis=-1, keepdims=True) + NORM_EPS)


def modulate(h, shift, scale):
    return h * (1.0 + scale) + shift


def adaln(cond, w, b):
    mod = (jax.nn.silu(cond) @ w + b)[:, None, :]
    return jnp.split(mod, 6, axis=-1)


def swiglu(h, w_in, w_out):
    gate, up = jnp.split(h @ w_in, 2, axis=-1)
    return (jax.nn.silu(gate) * up) @ w_out


def axis_angles(pos, n_pairs):
    inv_freq = ROPE_THETA ** (-jnp.arange(n_pairs, dtype=jnp.float32) / n_pairs)
    return pos[:, None] * inv_freq[None, :]


def rope_tables(rows):
    n_lat = rows * GRID_W
    row = jnp.repeat(jnp.arange(rows, dtype=jnp.float32), GRID_W)
    col = jnp.tile(jnp.arange(GRID_W, dtype=jnp.float32), rows)
    zeros_ctx = jnp.zeros((CTX_LEN,), jnp.float32)
    p_seq = jnp.concatenate([jnp.arange(CTX_LEN, dtype=jnp.float32),
                             jnp.full((n_lat,), float(CTX_LEN), jnp.float32)])
    p_row = jnp.concatenate([zeros_ctx, row])
    p_col = jnp.concatenate([zeros_ctx, col])
    ang = jnp.concatenate([axis_angles(p_seq, ROPE_SEQ_PAIRS),
                           axis_angles(p_row, ROPE_ROW_PAIRS),
                           axis_angles(p_col, ROPE_COL_PAIRS)], axis=-1)
    return jnp.cos(ang), jnp.sin(ang)


def apply_rope(t, cos, sin):
    c = cos[None, :, None, :]
    s = sin[None, :, None, :]
    t1, t2 = t[..., :HALF], t[..., HALF:]
    return jnp.concatenate([t1 * c - t2 * s, t1 * s + t2 * c], axis=-1)


def to_bwd(t):
    return jnp.concatenate([jnp.flip(t[:, :CTX_LEN], axis=1), jnp.flip(t[:, CTX_LEN:], axis=1)], axis=1)


def short_conv(u, w):
    n = u.shape[1]
    pad = (CONV_K - 1) // 2
    up = jnp.pad(u, ((0, 0), (pad, pad), (0, 0)))
    y = up[:, 0:n] * w[0]
    for i in range(1, CONV_K):
        y = y + up[:, i:i + n] * w[i]
    return jax.nn.silu(y)


def to_chunks(t):
    b, tl, h = t.shape[:3]
    t = t.reshape((b, tl // CHUNK, CHUNK, h) + t.shape[3:])
    return t.transpose((1, 0, 3, 2) + tuple(range(4, t.ndim)))


def from_chunks(o):
    nc, b, h, cl, d = o.shape
    return o.transpose(1, 0, 3, 2, 4).reshape(b, nc * cl, h, d)


def gated_delta_rule(q, k, v, g, beta):
    b, tl, h, dk = q.shape
    dv = v.shape[-1]
    qc, kc, vc = to_chunks(q), to_chunks(k), to_chunks(v)
    gc, bc = to_chunks(g), to_chunks(beta)
    G = jnp.cumsum(gc, axis=-1)
    idx = jnp.arange(CHUNK)
    incl = idx[:, None] >= idx[None, :]
    strict = idx[:, None] > idx[None, :]
    diff = G[..., :, None] - G[..., None, :]
    decay = jnp.where(incl, jnp.exp(jnp.where(incl, diff, 0.0)), 0.0)
    kb = kc * bc[..., None]
    A = jnp.where(strict, jnp.einsum('nbhid,nbhjd->nbhij', kb, kc) * decay, 0.0)
    rhs = jnp.concatenate([vc * bc[..., None], kb * jnp.exp(G)[..., None]], axis=-1)
    sol = lax.linalg.triangular_solve(A + jnp.eye(CHUNK, dtype=A.dtype), rhs,
                                      left_side=True, lower=True, unit_diagonal=True)
    u, w = sol[..., :dv], sol[..., dv:]
    qk = jnp.einsum('nbhid,nbhjd->nbhij', qc, kc) * decay
    q_dec = qc * jnp.exp(G)[..., None]
    k_dec = kc * jnp.exp(G[..., -1:] - G)[..., None]
    g_last = jnp.exp(G[..., -1])[..., None, None]

    def step(S, xs):
        u_c, w_c, q_c, qk_c, k_c, gl = xs
        v_new = u_c - jnp.einsum('bhck,bhkv->bhcv', w_c, S)
        o = jnp.einsum('bhck,bhkv->bhcv', q_c, S) + jnp.einsum('bhij,bhjv->bhiv', qk_c, v_new)
        S = gl * S + jnp.einsum('bhck,bhcv->bhkv', k_c, v_new)
        return S, o

    S0 = jnp.zeros((b, h, dk, dv), q.dtype)
    _, o = lax.scan(step, S0, (u, w, q_dec, qk, k_dec, g_last))
    return from_chunks(o)


def retention_chunkwise(q, k, v, log_gamma):
    b, tl, h, dk = q.shape
    dv = v.shape[-1]
    qc, kc, vc = to_chunks(q), to_chunks(k), to_chunks(v)
    pos = jnp.arange(CHUNK, dtype=jnp.float32)
    lg = log_gamma.astype(jnp.float32)[:, None]
    diff = pos[:, None] - pos[None, :]
    decay = jnp.where(diff >= 0, jnp.exp(lg[:, :, None] * jnp.maximum(diff, 0.0)), 0.0)
    xi = jnp.exp(lg * (pos + 1.0))
    zeta = jnp.exp(lg * (CHUNK - 1.0 - pos))
    g_chunk = jnp.exp(lg * CHUNK)[..., None]
    inner = jnp.einsum('nbhij,nbhjv->nbhiv', jnp.einsum('nbhid,nbhjd->nbhij', qc, kc) * decay, vc)

    def step(R, xs):
        q_c, k_c, v_c = xs
        o = jnp.einsum('bhik,bhkv->bhiv', q_c * xi[..., None], R)
        R = g_chunk * R + jnp.einsum('bhjk,bhjv->bhkv', k_c * zeta[..., None], v_c)
        return R, o

    R0 = jnp.zeros((b, h, dk, dv), q.dtype)
    _, cross = lax.scan(step, R0, (qc, kc, vc))
    return from_chunks(inner + cross)


def hybrid_mixer(h_ctx, h_lat, w_in, conv_w, gdn_a_log, gdn_dt_bias, gdn_norm_g,
                 ret_decay_logit, ret_norm_g, cos, sin):
    out_dtype = h_lat.dtype
    f32 = jnp.float32
    h = jnp.concatenate([h_ctx, h_lat], axis=1)
    p = (h @ w_in).astype(f32)
    b, tl, _ = p.shape
    splits = [3 * W_GDN, 4 * W_GDN, 4 * W_GDN + 4 * N_HEADS_GDN,
              4 * W_GDN + 4 * N_HEADS_GDN + W_RET,
              4 * W_GDN + 4 * N_HEADS_GDN + 2 * W_RET,
              4 * W_GDN + 4 * N_HEADS_GDN + 3 * W_RET]
    qkv_a, z, ab, rq, rk, rv, rg = jnp.split(p, splits, axis=-1)

    cw = conv_w.astype(f32)
    qkv_a = jnp.concatenate([short_conv(qkv_a[:, :CTX_LEN], cw), short_conv(qkv_a[:, CTX_LEN:], cw)], axis=1)
    q, k, v = [t.reshape(b, tl, N_HEADS_GDN, HEAD_DIM) for t in jnp.split(qkv_a, 3, axis=-1)]
    q = l2_normalize(q) * (HEAD_DIM ** -0.5)
    k = l2_normalize(k)
    a_f, a_b, b_f, b_b = jnp.split(ab, 4, axis=-1)
    A = jnp.exp(gdn_a_log.astype(f32))
    dtb = gdn_dt_bias.astype(f32)
    g_f = -A[0] * jax.nn.softplus(a_f + dtb[0])
    g_b = -A[1] * jax.nn.softplus(a_b + dtb[1])
    o_f = gated_delta_rule(q, k, v, g_f, jax.nn.sigmoid(b_f))
    o_b = to_bwd(gated_delta_rule(to_bwd(q), to_bwd(k), to_bwd(v), to_bwd(g_b), to_bwd(jax.nn.sigmoid(b_b))))
    o_gdn = rms_norm(o_f + o_b, gdn_norm_g) * jax.nn.silu(z.reshape(b, tl, N_HEADS_GDN, HEAD_DIM))

    rq = apply_rope(rq.reshape(b, tl, N_HEADS_RET, HEAD_DIM), cos, sin)
    rk = apply_rope(rk.reshape(b, tl, N_HEADS_RET, HEAD_DIM), cos, sin) * (HEAD_DIM ** -0.5)
    rv = rv.reshape(b, tl, N_HEADS_RET, HEAD_DIM)
    lg = jax.nn.log_sigmoid(ret_decay_logit.astype(f32))
    r_f = retention_chunkwise(rq, rk, rv, lg[0])
    r_b = to_bwd(retention_chunkwise(to_bwd(rq), to_bwd(rk), to_bwd(rv), lg[1]))
    o_ret = head_group_norm(r_f + r_b, ret_norm_g) * jax.nn.silu(rg.reshape(b, tl, N_HEADS_RET, HEAD_DIM))

    y = jnp.concatenate([o_gdn.reshape(b, tl, W_GDN), o_ret.reshape(b, tl, W_RET)], axis=-1)
    return y.astype(out_dtype)


def setup_inputs(seed: int = 0) -> dict:
    key = jax.random.key(seed)
    ks = jax.random.split(key, 19)
    f32 = jnp.float32

    def nrm(k, shape, scale):
        return scale * jax.random.normal(k, shape, f32)

    x = nrm(ks[0], (BATCH, SEQ, D_MODEL), 1.0)
    c = nrm(ks[1], (BATCH, D_MODEL), 1.0)
    ctx = nrm(ks[2], (BATCH, CTX_LEN, D_MODEL), 1.0)
    c_ctx = nrm(ks[3], (D_MODEL,), 1.0)
    ada_w = nrm(ks[4], (DEPTH, D_MODEL, 6 * D_MODEL), D_MODEL ** -0.5)
    ada_b = nrm(ks[5], (DEPTH, 6 * D_MODEL), 0.02)
    norm_mix_g = 1.0 + nrm(ks[6], (DEPTH, D_MODEL), 0.05)
    norm_ffn_g = 1.0 + nrm(ks[7], (DEPTH, D_MODEL), 0.05)
    w_in = nrm(ks[8], (DEPTH, D_MODEL, IN_COLS), D_MODEL ** -0.5)
    conv_w = nrm(ks[9], (DEPTH, CONV_K, 3 * W_GDN), CONV_K ** -0.5)
    gdn_a_log = jnp.log(jax.random.uniform(ks[10], (DEPTH, 2, N_HEADS_GDN), f32, 1.0, 16.0))
    dt = jnp.exp(jax.random.uniform(ks[11], (DEPTH, 2, N_HEADS_GDN), f32, math.log(1e-3), math.log(1e-1)))
    gdn_dt_bias = dt + jnp.log(-jnp.expm1(-dt))
    gdn_norm_g = 1.0 + nrm(ks[12], (DEPTH, HEAD_DIM), 0.05)
    heads = jnp.arange(N_HEADS_RET, dtype=f32)
    ret_decay_logit = jnp.log(2.0 ** (5.0 + heads) - 1.0) + nrm(ks[13], (DEPTH, 2, N_HEADS_RET), 0.01)
    ret_norm_g = 1.0 + nrm(ks[14], (DEPTH, HEAD_DIM), 0.05)
    w_out = nrm(ks[15], (DEPTH, MIX_WIDTH, D_MODEL), MIX_WIDTH ** -0.5)
    w_ffn_in = nrm(ks[16], (DEPTH, D_MODEL, 2 * D_FF), D_MODEL ** -0.5)
    w_ffn_out = nrm(ks[17], (DEPTH, D_FF, D_MODEL), D_FF ** -0.5)
    final_g = 1.0 + nrm(ks[18], (D_MODEL,), 0.05)
    return {"x": x, "c": c, "ctx": ctx, "c_ctx": c_ctx, "ada_w": ada_w, "ada_b": ada_b,
            "norm_mix_g": norm_mix_g, "norm_ffn_g": norm_ffn_g, "w_in": w_in, "conv_w": conv_w,
            "gdn_a_log": gdn_a_log, "gdn_dt_bias": gdn_dt_bias, "gdn_norm_g": gdn_norm_g,
            "ret_decay_logit": ret_decay_logit, "ret_norm_g": ret_norm_g, "w_out": w_out,
            "w_ffn_in": w_ffn_in, "w_ffn_out": w_ffn_out, "final_g": final_g}


def reference(x, c, ctx, c_ctx, ada_w, ada_b, norm_mix_g, norm_ffn_g, w_in, conv_w,
              gdn_a_log, gdn_dt_bias, gdn_norm_g, ret_decay_logit, ret_norm_g, w_out,
              w_ffn_in, w_ffn_out, final_g):
    n_lat = x.shape[1]
    rows = n_lat // GRID_W
    cos, sin = rope_tables(rows)
    x_ctx = ctx
    for layer in range(DEPTH):
        sh1, sc1, g1, sh2, sc2, g2 = adaln(c, ada_w[layer], ada_b[layer])
        csh1, csc1, cg1, csh2, csc2, cg2 = adaln(c_ctx[None, :], ada_w[layer], ada_b[layer])
        h_lat = modulate(rms_norm(x, norm_mix_g[layer]), sh1, sc1)
        h_ctx = modulate(rms_norm(x_ctx, norm_mix_g[layer]), csh1, csc1)
        y = hybrid_mixer(h_ctx, h_lat, w_in[layer], conv_w[layer], gdn_a_log[layer],
                         gdn_dt_bias[layer], gdn_norm_g[layer], ret_decay_logit[layer],
                         ret_norm_g[layer], cos, sin)
        x = x + g1 * (y[:, CTX_LEN:] @ w_out[layer])
        x = x + g2 * swiglu(modulate(rms_norm(x, norm_ffn_g[layer]), sh2, sc2),
                            w_ffn_in[layer], w_ffn_out[layer])
        if layer < DEPTH - 1:
            x_ctx = x_ctx + cg1 * (y[:, :CTX_LEN] @ w_out[layer])
            x_ctx = x_ctx + cg2 * swiglu(modulate(rms_norm(x_ctx, norm_ffn_g[layer]), csh2, csc2),
                                         w_ffn_in[layer], w_ffn_out[layer])
    return rms_norm(x, final_g)
```

```cpp
#include <hip/hip_runtime.h>
#include <hip/hip_cooperative_groups.h>
#include <cstdio>
namespace cg = cooperative_groups;
namespace pg8 {
#define PG8_LAS __attribute__((address_space(3)))
typedef unsigned short bf16_t;
typedef short bf16x8 __attribute__((ext_vector_type(8)));
typedef float f32x4 __attribute__((ext_vector_type(4)));
typedef unsigned u32x4 __attribute__((ext_vector_type(4)));
constexpr int BM = 256, BK = 64, HALF = 128, HTB = HALF * BK * 2  , STAGE_BYTES = 8 * HTB, NXCD = 8, WGM = 8;

__host__ __device__ __forceinline__ int lds_byte(int r, int c) { const int st = (r >> 4) * 2 + (c >> 5), rr = r & 15, cc = c & 31, ob = rr * 64 + cc * 2; return st * 1024 + (ob ^ (((ob >> 9) & 1) << 5)); }
__host__ __device__ __forceinline__ void stage_rc(int b, int& R, int& C) { const int st = b / 1024, sb = b % 1024, swz = sb ^ (((sb >> 9) & 1) << 5); R = (st >> 1) * 16 + swz / 64; C = (st & 1) * 32 + (swz % 64) / 2; }
__host__ __device__ __forceinline__ int perm32(int rho) { const int n = rho >> 4, i = rho & 15; return 8 * (i >> 2) + 4 * n + (i & 3); }

struct Unit { int pm, pn; };
struct Gemm { const bf16_t* A; const bf16_t* Bt; int M, N, K; };

struct StaticOrder {
    int nM, nN, nwg, G, c;
    __host__ __device__ void init(int M, int N, int G_, int c_) { nM = M / BM; nN = N / BM; nwg = nM * nN; G = G_; c = c_; }
    __host__ __device__ bool next(int i, Unit& u) const {
        const long L = (long)i * G + c; if (L >= nwg) return false;
        int wgid = (int)L; { const int q = nwg / NXCD, r = nwg % NXCD, xcd = wgid % NXCD, off = wgid / NXCD; wgid = (xcd < r ? xcd * (q + 1) : r * (q + 1) + (xcd - r) * q) + off; }
        const int nig = WGM * nN, gid = wgid / nig, fm = gid * WGM, gsz = (nM - fm) < WGM ? (nM - fm) : WGM;
        u.pm = fm + ((wgid % nig) % gsz); u.pn = (wgid % nig) / gsz; return true;
    }
    __device__ __forceinline__ void a_ready(const Unit&) const {}
    __device__ __forceinline__ void done(const Unit&) const {}
};

__device__ __forceinline__ unsigned cvt_pk_bf16(float lo, float hi) { unsigned r; asm volatile("v_cvt_pk_bf16_f32 %0, %1, %2" : "=v"(r) : "v"(lo), "v"(hi)); return r; }
template <class Epi, class Sched, bool ALIGN_EPI = false, bool SP2 = false>
__device__ __forceinline__ void gemm_phase(PG8_LAS unsigned char* lds, const Gemm g, const Sched& S, const Epi& E) {
    const int tid = threadIdx.x, wid = __builtin_amdgcn_readfirstlane(tid >> 6), lane = tid & 63, wr = wid >> 2, wc = wid & 3, fr = lane & 15, fq = lane >> 4;
    const int K = g.K, nt = K / BK;
    unsigned voffA[2], voffB[2];
#pragma unroll
    for (int i = 0; i < 2; ++i) { int R, C; stage_rc(tid * 16 + i * 8192, R, C); const int Rb = Epi::PERM ? ((R & ~31) + perm32(R & 31)) : R;
        voffA[i] = (unsigned)(R * K + C) * 2u; voffB[i] = (unsigned)(Rb * K + C) * 2u; }
    const size_t kstep = (size_t)(BK * 2);
    const size_t hstep = (size_t)HALF * K * 2;
    const size_t tstep = 2 * hstep;
    const unsigned ldsw = (unsigned)wid * 1024u;
    const int aoff = lds_byte(wr * 64 + fr, fq * 8), boff = lds_byte(wc * 32 + fr, fq * 8);
#define PG8_SA(b, h) (((b) * 2 + (h)) * HTB)
#define PG8_SB(b, h) ((4 + (b) * 2 + (h)) * HTB)
#define PG8_STAGE(bufoff, gbase, voff) do { _Pragma("unroll") for (int _i = 0; _i < 2; ++_i) \
        __builtin_amdgcn_global_load_lds((const unsigned*)((const char*)(gbase) + (voff)[_i]), (PG8_LAS unsigned*)(lds + (bufoff) + ldsw + _i * 8192), 16, 0, 0); } while (0)
#define PG8_LDA(dst, b, h) do { _Pragma("unroll") for (int m = 0; m < 4; ++m) _Pragma("unroll") for (int k = 0; k < 2; ++k) dst[m][k] = *(const PG8_LAS bf16x8*)(lds + PG8_SA(b, h) + aoff + m * 2048 + k * 1024); } while (0)
#define PG8_LDB(dst, b, h) do { _Pragma("unroll") for (int n = 0; n < 2; ++n) _Pragma("unroll") for (int k = 0; k < 2; ++k) dst[n][k] = *(const PG8_LAS bf16x8*)(lds + PG8_SB(b, h) + boff + n * 2048 + k * 1024); } while (0)
#define PG8_MMA(ai, bj, At, Bt) do { __builtin_amdgcn_s_setprio(1); _Pragma("unroll") for (int m = 0; m < 4; ++m) _Pragma("unroll") for (int n = 0; n < 2; ++n) _Pragma("unroll") for (int k = 0; k < 2; ++k) \
        acc[ai][bj][m][n] = __builtin_amdgcn_mfma_f32_16x16x32_bf16(Bt[n][k], At[m][k], acc[ai][bj][m][n], 0, 0, 0); __builtin_amdgcn_s_setprio(0); } while (0)
#define PG8_WAIT_V(n) asm volatile("s_waitcnt vmcnt(" #n ")" ::: "memory")
#define PG8_WAIT_L(n) asm volatile("s_waitcnt lgkmcnt(" #n ")" ::: "memory")
#define PG8_BAR __builtin_amdgcn_s_barrier()
#define PG8_SCHED __builtin_amdgcn_sched_barrier(0)
    Unit cur, nxt; int ui = 0;
    if (!S.next(0, cur)) return;
    f32x4 acc[2][2][4][2];
#pragma unroll
    for (int a = 0; a < 2; ++a)
#pragma unroll
        for (int b = 0; b < 2; ++b)
#pragma unroll
            for (int m = 0; m < 4; ++m)
#pragma unroll
                for (int n = 0; n < 2; ++n) acc[a][b][m][n] = (f32x4){0.f, 0.f, 0.f, 0.f};
    bf16x8 At[4][2], B0[2][2], B1[2][2];
    const char* cA = (const char*)g.A + (size_t)cur.pm * tstep; const char* cB = (const char*)g.Bt + (size_t)cur.pn * tstep;
    S.a_ready(cur);
    if constexpr (SP2) {
        PG8_STAGE(PG8_SB(0, 0), cB, voffB); PG8_STAGE(PG8_SB(0, 1), cB + hstep, voffB); PG8_STAGE(PG8_SA(0, 0), cA, voffA); PG8_STAGE(PG8_SA(0, 1), cA + hstep, voffA);
        if (wr == 1) PG8_BAR;
        PG8_WAIT_V(2); PG8_BAR;
        PG8_STAGE(PG8_SB(1, 0), cB + kstep, voffB); PG8_STAGE(PG8_SA(1, 0), cA + kstep, voffA); PG8_STAGE(PG8_SB(1, 1), cB + hstep + kstep, voffB);
        PG8_WAIT_V(6); PG8_BAR;
    } else {
        PG8_STAGE(PG8_SB(0, 0), cB, voffB); PG8_STAGE(PG8_SA(0, 0), cA, voffA); PG8_STAGE(PG8_SB(0, 1), cB + hstep, voffB); PG8_STAGE(PG8_SA(0, 1), cA + hstep, voffA);
        if (wr == 1) PG8_BAR;
        PG8_WAIT_V(4); PG8_BAR;
        PG8_STAGE(PG8_SB(1, 0), cB + kstep, voffB); PG8_STAGE(PG8_SA(1, 0), cA + kstep, voffA); PG8_STAGE(PG8_SB(1, 1), cB + hstep + kstep, voffB);
        PG8_WAIT_V(6); PG8_BAR;
    }
    for (;;) {
        const bool has_next = S.next(ui + 1, nxt);
        const char* nA = has_next ? (const char*)g.A + (size_t)nxt.pm * tstep : cA; const char* nB = has_next ? (const char*)g.Bt + (size_t)nxt.pn * tstep : cB;
        for (int t = 0; t < nt; t += 2) {
            const bool last = (t == nt - 2);
            const char* a1 = cA + (size_t)(t + 1) * kstep;
            const char* a2 = last ? nA : cA + (size_t)(t + 2) * kstep; const char* b2 = last ? nB : cB + (size_t)(t + 2) * kstep;
            const char* a3 = a2 + kstep; const char* b3 = b2 + kstep;
            if (last && has_next) S.a_ready(nxt);
            if constexpr (SP2) {
            PG8_LDB(B0, 0, 0); PG8_LDB(B1, 0, 1); PG8_SCHED; PG8_LDA(At, 0, 0); PG8_STAGE(PG8_SA(1, 1), a1 + hstep, voffA);
            PG8_WAIT_V(8); PG8_WAIT_L(0); PG8_BAR; PG8_MMA(0, 0, At, B0); PG8_MMA(0, 1, At, B1); PG8_BAR; PG8_SCHED;
            PG8_LDA(At, 0, 1); PG8_STAGE(PG8_SB(0, 0), b2, voffB); PG8_STAGE(PG8_SB(0, 1), b2 + hstep, voffB); PG8_STAGE(PG8_SA(0, 0), a2, voffA);
            PG8_WAIT_V(8); PG8_WAIT_L(0); PG8_BAR; PG8_MMA(1, 0, At, B0); PG8_MMA(1, 1, At, B1); PG8_BAR; PG8_SCHED;
            PG8_LDB(B0, 1, 0); PG8_LDB(B1, 1, 1); PG8_SCHED; PG8_LDA(At, 1, 0); PG8_STAGE(PG8_SA(0, 1), a2 + hstep, voffA);
            PG8_WAIT_V(8); PG8_WAIT_L(0); PG8_BAR; PG8_MMA(0, 0, At, B0); PG8_MMA(0, 1, At, B1); PG8_BAR; PG8_SCHED;
            PG8_LDA(At, 1, 1); PG8_STAGE(PG8_SB(1, 0), b3, voffB); PG8_STAGE(PG8_SB(1, 1), b3 + hstep, voffB); PG8_STAGE(PG8_SA(1, 0), a3, voffA);
            PG8_WAIT_V(8); PG8_WAIT_L(0); PG8_BAR; PG8_MMA(1, 0, At, B0); PG8_MMA(1, 1, At, B1); PG8_BAR; PG8_SCHED;
            } else {
            PG8_LDB(B0, 0, 0); PG8_SCHED; PG8_LDA(At, 0, 0); PG8_STAGE(PG8_SA(1, 1), a1 + hstep, voffA);
            PG8_WAIT_L(8); PG8_BAR; PG8_WAIT_L(0); PG8_MMA(0, 0, At, B0); PG8_BAR; PG8_SCHED;
            PG8_LDB(B1, 0, 1); PG8_STAGE(PG8_SB(0, 0), b2, voffB);
            PG8_BAR; PG8_WAIT_L(0); PG8_MMA(0, 1, At, B1); PG8_BAR;
            PG8_LDA(At, 0, 1); PG8_STAGE(PG8_SA(0, 0), a2, voffA);
            PG8_BAR; PG8_WAIT_L(0); PG8_MMA(1, 0, At, B0); PG8_BAR; PG8_SCHED;
            PG8_STAGE(PG8_SB(0, 1), b2 + hstep, voffB);
            PG8_WAIT_V(6); PG8_BAR; PG8_MMA(1, 1, At, B1); PG8_BAR;
            PG8_LDB(B0, 1, 0); PG8_SCHED; PG8_LDA(At, 1, 0); PG8_STAGE(PG8_SA(0, 1), a2 + hstep, voffA);
            PG8_WAIT_L(8); PG8_BAR; PG8_WAIT_L(0); PG8_MMA(0, 0, At, B0); PG8_BAR; PG8_SCHED;
            PG8_LDB(B1, 1, 1); PG8_STAGE(PG8_SB(1, 0), b3, voffB);
            PG8_BAR; PG8_WAIT_L(0); PG8_MMA(0, 1, At, B1); PG8_BAR;
            PG8_LDA(At, 1, 1); PG8_STAGE(PG8_SA(1, 0), a3, voffA);
            PG8_BAR; PG8_WAIT_L(0); PG8_MMA(1, 0, At, B0); PG8_BAR; PG8_SCHED;
            PG8_STAGE(PG8_SB(1, 1), b3 + hstep, voffB);
            PG8_WAIT_V(6); PG8_BAR; PG8_MMA(1, 1, At, B1); PG8_BAR;
            }
        }
        if constexpr (ALIGN_EPI) { if (wr == 0) PG8_BAR; }
        if constexpr (!Epi::AFTER_DRAIN) { E(acc, cur, wr, wc, fr, fq); S.done(cur); }
        if (!has_next) break;
#pragma unroll
        for (int a = 0; a < 2; ++a)
#pragma unroll
            for (int b = 0; b < 2; ++b)
#pragma unroll
                for (int m = 0; m < 4; ++m)
#pragma unroll
                    for (int n = 0; n < 2; ++n) acc[a][b][m][n] = (f32x4){0.f, 0.f, 0.f, 0.f};
        cur = nxt; cA = nA; cB = nB; ++ui;
        if constexpr (ALIGN_EPI) { if (wr == 1) PG8_BAR; }
    }
    PG8_WAIT_V(0);
    if constexpr (!ALIGN_EPI) { if (wr == 0) PG8_BAR; }
    PG8_BAR;
    if constexpr (Epi::AFTER_DRAIN) { E.fused(acc, cur, wr, wc, fr, fq, lds, wid, lane); S.done(cur); }
#undef PG8_SA
#undef PG8_SB
#undef PG8_STAGE
#undef PG8_LDA
#undef PG8_LDB
#undef PG8_MMA
#undef PG8_WAIT_V
#undef PG8_WAIT_L
#undef PG8_BAR
#undef PG8_SCHED
}
}

#define DI __device__ __forceinline__
#define LAS __attribute__((address_space(3)))
typedef LAS unsigned char* ldsp;
typedef unsigned short bf16_t;
typedef short bf16x8 __attribute__((ext_vector_type(8)));
typedef float f32x4 __attribute__((ext_vector_type(4)));
typedef unsigned u32x4 __attribute__((ext_vector_type(4)));
typedef unsigned u32x2 __attribute__((ext_vector_type(2)));
#define MFMA16(a, b, c) __builtin_amdgcn_mfma_f32_16x16x32_bf16((a), (b), (c), 0, 0, 0)

constexpr int NT = 512;
constexpr int TT = 4352, MROWS = 17408, LROWS = 16384;
constexpr size_t MiB = (size_t)1 << 20;
constexpr size_t PBUF = 17 * MiB;
constexpr int LDS_BYTES = 149504;
constexpr size_t WS_MOD = 0, WS_GATES = 256 * 1024, WS_SS = 2 * MiB, WS_BIAS2 = 2 * MiB + 256 * 1024, WS_SSF = 2 * MiB + 512 * 1024, WS_BAR = 3 * MiB;
constexpr size_t WS_WINT = 3 * MiB + 512 * 1024, WS_A1 = 12 * MiB, WS_P = 46 * MiB;
constexpr int N1 = 4352;
constexpr size_t WS_QP = WS_P, WS_KP = WS_P + PBUF, WS_VP = WS_P + 2 * PBUF, WS_Z = WS_P + 3 * PBUF, WS_RQ = WS_P + 4 * PBUF, WS_RK = WS_P + 5 * PBUF, WS_RV = WS_P + 6 * PBUF, WS_RG = WS_P + 7 * PBUF;
constexpr size_t WS_QC = 4 * MiB, WS_KC = 21 * MiB, WS_VC = 182 * MiB;
constexpr size_t WS_WF = 46 * MiB, WS_UF = 63 * MiB, WS_QF = 80 * MiB, WS_WB = 199 * MiB, WS_UB = 216 * MiB, WS_QB = 233 * MiB;
constexpr size_t WS_DEC = 250 * MiB;
constexpr size_t WS_Y = 199 * MiB, WS_WOUTT = 38 * MiB, WS_WFOT = 40 * MiB, WS_WFIT = 49 * MiB;
constexpr size_t WS_X1B = 4 * MiB;
constexpr size_t WS_OGB = 4 * MiB, WS_ORB = 182 * MiB;
constexpr size_t WS_X1 = 182 * MiB, WS_A3 = 60 * MiB, WS_H = 92 * MiB;

struct Params {
    const float *x, *c, *ctx, *c_ctx, *ada_w, *ada_b, *norm_mix_g, *norm_ffn_g, *w_in, *conv_w, *a_log, *dt_bias, *gdn_norm_g, *ret_logit, *ret_norm_g, *w_out, *w_ffn_in, *w_ffn_out, *final_g;
    float* out; unsigned char* ws; int ph_lo, ph_hi, dry, pad;
};

DI unsigned short f2bf(float f) { unsigned u = __float_as_uint(f); return (unsigned short)((u + 0x7fffu + ((u >> 16) & 1u)) >> 16); }
DI float bf2f(unsigned v) { return __uint_as_float(v << 16); }
typedef float f32x2_t __attribute__((ext_vector_type(2)));
typedef __bf16 bf16x2_t __attribute__((ext_vector_type(2)));
DI unsigned pk2(float lo, float hi) { const f32x2_t v = {lo, hi}; const bf16x2_t b = __builtin_convertvector(v, bf16x2_t); return __builtin_bit_cast(unsigned, b); }
DI float bflo(unsigned v) { return __uint_as_float(v << 16); }
DI float bfhi(unsigned v) { return __uint_as_float(v & 0xffff0000u); }
DI float silu_f(float x) { return x * __builtin_amdgcn_rcpf(1.f + __expf(-x)); }
DI float sigm_f(float x) { return __builtin_amdgcn_rcpf(1.f + __expf(-x)); }
DI float softplus_f(float x) { return fmaxf(x, 0.f) + log1pf(__expf(-fabsf(x))); }
DI float wave_sum(float v) { for (int o = 32; o; o >>= 1) v += __shfl_xor(v, o); return v; }
DI bf16x8 lds16(ldsp p) { return *(const LAS bf16x8*)p; }
DI void lds_barrier() { asm volatile("s_waitcnt lgkmcnt(0)\n\ts_barrier" ::: "memory"); }

DI void transpose_item(const float* W, int ldw, int k0, int srccol0, bf16_t* WT, int Kdim, int nout0, ldsp L) {
    const int tid = threadIdx.x;
    LAS float* scr = (LAS float*)L;
    for (int e = tid; e < 4096; e += NT) { const int kk = e >> 6, cc = e & 63; scr[kk * 65 + cc] = __builtin_nontemporal_load(W + (size_t)(k0 + kk) * ldw + srccol0 + cc); }
    __syncthreads();
    { const int n = tid >> 3, k8 = (tid & 7) * 8; u32x4 o;
      o.x = pk2(scr[(k8 + 0) * 65 + n], scr[(k8 + 1) * 65 + n]); o.y = pk2(scr[(k8 + 2) * 65 + n], scr[(k8 + 3) * 65 + n]);
      o.z = pk2(scr[(k8 + 4) * 65 + n], scr[(k8 + 5) * 65 + n]); o.w = pk2(scr[(k8 + 6) * 65 + n], scr[(k8 + 7) * 65 + n]);
      *(u32x4*)(WT + (size_t)(nout0 + n) * Kdim + k0 + k8) = o; }
    __syncthreads();
}

DI void phase0(const Params& p, ldsp L) {
    const int tid = threadIdx.x;
    float* MOD = (float*)(p.ws + WS_MOD);
    if (blockIdx.x < 192) {
        LAS float* sc = (LAS float*)L; LAS float* red = sc + 5120;
        for (int e = tid; e < 5120; e += NT) { const int r = e >> 10, k = e & 1023; const float v = r < 4 ? p.c[r * 1024 + k] : p.c_ctx[k]; sc[e] = silu_f(v); }
        __syncthreads();
        for (int it = blockIdx.x; it < 192; it += gridDim.x) {
            const int cl = tid & 31, kg = tid >> 5, col = it * 32 + cl;
            float a0 = 0, a1 = 0, a2 = 0, a3 = 0, a4 = 0;
#pragma unroll 64
            for (int k = kg * 64; k < kg * 64 + 64; ++k) { const float w = __builtin_nontemporal_load(p.ada_w + (size_t)k * 6144 + col); a0 += sc[k] * w; a1 += sc[1024 + k] * w; a2 += sc[2048 + k] * w; a3 += sc[3072 + k] * w; a4 += sc[4096 + k] * w; }
            red[(kg * 5 + 0) * 32 + cl] = a0; red[(kg * 5 + 1) * 32 + cl] = a1; red[(kg * 5 + 2) * 32 + cl] = a2; red[(kg * 5 + 3) * 32 + cl] = a3; red[(kg * 5 + 4) * 32 + cl] = a4;
            __syncthreads();
            if (tid < 160) { const int r = tid >> 5; float s = 0; for (int g = 0; g < 16; ++g) s += red[(g * 5 + r) * 32 + cl]; MOD[r * 6144 + col] = s + p.ada_b[col]; }
            __syncthreads();
        }
    }
    { unsigned* zw = (unsigned*)(p.ws + WS_WINT + (size_t)4160 * 2048); for (int e = blockIdx.x * NT + tid; e < 192 * 512; e += gridDim.x * NT) zw[e] = 0u; }
    { float* zs = (float*)(p.ws + WS_SS); float* zf = (float*)(p.ws + WS_SSF); for (int e = blockIdx.x * NT + tid; e < 16384; e += gridDim.x * NT) { zs[e] = 0.f; zf[e] = 0.f; }
      float* zb = (float*)(p.ws + WS_BIAS2); for (int e = blockIdx.x * NT + tid; e < 4 * 5632; e += gridDim.x * NT) zb[e] = 0.f; }
}

DI void phase1(const Params& p, ldsp L) {
    const int tid = threadIdx.x, lane = tid & 63, w = tid >> 6;
    const float* MOD = (const float*)(p.ws + WS_MOD);
    bf16_t* A1 = (bf16_t*)(p.ws + WS_A1);
    const int nwv = gridDim.x * 8;
    for (int R0 = blockIdx.x * 8 + w; R0 < MROWS; R0 += 2 * nwv) {
        f32x4 v[2][4]; const float* mod[2]; int Rr[2]; bool ok[2];
#pragma unroll
        for (int u = 0; u < 2; ++u) { const int R = R0 + u * nwv; ok[u] = R < MROWS; const int Rc = ok[u] ? R : R0; Rr[u] = Rc; const int b = Rc / TT, t = Rc % TT;
            const float* src = t < 256 ? p.ctx + ((size_t)b * 256 + t) * 1024 : p.x + ((size_t)b * 4096 + (t - 256)) * 1024; mod[u] = MOD + (t < 256 ? 4 : b) * 6144;
#pragma unroll
            for (int i = 0; i < 4; ++i) v[u][i] = __builtin_nontemporal_load((const f32x4*)(src + (lane + 64 * i) * 4)); }
        float ss[2];
#pragma unroll
        for (int u = 0; u < 2; ++u) { ss[u] = 0;
#pragma unroll
            for (int i = 0; i < 4; ++i) ss[u] += v[u][i].x * v[u][i].x + v[u][i].y * v[u][i].y + v[u][i].z * v[u][i].z + v[u][i].w * v[u][i].w; }
        for (int o = 32; o; o >>= 1) { ss[0] += __shfl_xor(ss[0], o); ss[1] += __shfl_xor(ss[1], o); }
#pragma unroll
        for (int u = 0; u < 2; ++u) { const float rstd = rsqrtf(ss[u] * (1.f / 1024.f) + 1e-6f);
#pragma unroll
            for (int i = 0; i < 4; ++i) { const int k = (lane + 64 * i) * 4;
                const f32x4 g = *(const f32x4*)(p.norm_mix_g + k), sh = *(const f32x4*)(mod[u] + k), sc = *(const f32x4*)(mod[u] + 1024 + k);
                v[u][i] = v[u][i] * rstd * g * (sc + 1.f) + sh;
                u32x2 o; o.x = pk2(v[u][i].x, v[u][i].y); o.y = pk2(v[u][i].z, v[u][i].w); if (ok[u]) *(u32x2*)(A1 + (size_t)Rr[u] * 1024 + k) = o; } }
    }
    { float* BIAS2 = (float*)(p.ws + WS_BIAS2);
      for (int it = blockIdx.x; it < 176; it += gridDim.x) { const int n = (it % 11) * 512 + tid, k0 = (it / 11) * 64; float a0 = 0, a1 = 0, a2 = 0, a3 = 0;
#pragma unroll 16
          for (int k = k0; k < k0 + 64; ++k) { const float wv = p.w_ffn_in[(size_t)k * 5632 + n]; a0 += MOD[3072 + k] * wv; a1 += MOD[6144 + 3072 + k] * wv; a2 += MOD[2 * 6144 + 3072 + k] * wv; a3 += MOD[3 * 6144 + 3072 + k] * wv; }
          unsafeAtomicAdd(BIAS2 + n, a0); unsafeAtomicAdd(BIAS2 + 5632 + n, a1); unsafeAtomicAdd(BIAS2 + 2 * 5632 + n, a2); unsafeAtomicAdd(BIAS2 + 3 * 5632 + n, a3); } }
    { bf16_t* WinT = (bf16_t*)(p.ws + WS_WINT);
      for (int j = blockIdx.x; j < 1040; j += gridDim.x) { const int kt = j & 15, nt = j >> 4, n0 = nt * 64;
          transpose_item(p.w_in, 4112, kt * 64, nt == 64 ? 2048 : (n0 < 2048 ? n0 : n0 + 16), WinT, 1024, n0, L); } }
}

struct EpiP {
    static constexpr bool PERM = true, AFTER_DRAIN = false;
    bf16_t* O; float* gates;
    DI void operator()(const f32x4 (&acc)[2][2][4][2], const pg8::Unit& u, int wr, int wc, int fr, int fq) const {
        if (u.pn == 16) {
            if (wc == 0 && fq < 2) { const int r0 = u.pm * 256 + wr * 64 + fr;
#pragma unroll
                for (int ai = 0; ai < 2; ++ai)
#pragma unroll
                    for (int m = 0; m < 4; ++m)
#pragma unroll
                        for (int n = 0; n < 2; ++n) *(f32x4*)(gates + (size_t)(r0 + ai * 128 + m * 16) * 16 + 8 * fq + 4 * n) = acc[ai][0][m][n]; }
            return; }
        const int row0 = u.pm * 256 + wr * 64 + fr; int colt = u.pn * 256; const int t = colt >> 9; bf16_t* base = O + (size_t)t * (PBUF / 2); colt -= t * 512;
        const int col0 = colt + wc * 32 + 8 * fq;
#pragma unroll
        for (int ai = 0; ai < 2; ++ai)
#pragma unroll
            for (int m = 0; m < 4; ++m) { bf16_t* rowp = base + (size_t)(row0 + ai * 128 + m * 16) * 512 + col0;
#pragma unroll
                for (int bj = 0; bj < 2; ++bj) { const f32x4 v0 = acc[ai][bj][m][0], v1 = acc[ai][bj][m][1]; u32x4 o;
                    o.x = pg8::cvt_pk_bf16(v0[0], v0[1]); o.y = pg8::cvt_pk_bf16(v0[2], v0[3]); o.z = pg8::cvt_pk_bf16(v1[0], v1[1]); o.w = pg8::cvt_pk_bf16(v1[2], v1[3]);
                    *(u32x4*)(rowp + bj * 128) = o; } }
    }
};
struct EpiRes {
    static constexpr bool PERM = false, AFTER_DRAIN = false;
    float* out; const float* res; const float* gate;
    DI void operator()(const f32x4 (&acc)[2][2][4][2], const pg8::Unit& u, int wr, int wc, int fr, int fq) const {
        const int row0 = u.pm * 256 + wr * 64 + fr, col0 = u.pn * 256 + wc * 32 + 4 * fq;
        const float* gp = gate + (size_t)(row0 >> 12) * 6144 + col0;
        f32x4 gv[2][2];
#pragma unroll
        for (int bj = 0; bj < 2; ++bj)
#pragma unroll
            for (int n = 0; n < 2; ++n) gv[bj][n] = *(const f32x4*)(gp + bj * 128 + n * 16);
#pragma unroll
        for (int ai = 0; ai < 2; ++ai)
#pragma unroll
            for (int m = 0; m < 4; ++m) { const size_t ro = (size_t)(row0 + ai * 128 + m * 16) * 1024 + col0;
#pragma unroll
                for (int bj = 0; bj < 2; ++bj)
#pragma unroll
                    for (int n = 0; n < 2; ++n) { const f32x4 r = *(const f32x4*)(res + ro + bj * 128 + n * 16); *(f32x4*)(out + ro + bj * 128 + n * 16) = r + gv[bj][n] * acc[ai][bj][m][n]; } }
    }
};
struct EpiGLU {
    static constexpr bool PERM = true, AFTER_DRAIN = false;
    bf16_t* H;
    DI void operator()(const f32x4 (&acc)[2][2][4][2], const pg8::Unit& u, int wr, int wc, int fr, int fq) const {
        const int row0 = u.pm * 256 + wr * 64 + fr, col0 = u.pn * 128 + wc * 32 + 8 * fq;
#pragma unroll
        for (int ai = 0; ai < 2; ++ai)
#pragma unroll
            for (int m = 0; m < 4; ++m) { bf16_t* rowp = H + (size_t)(row0 + ai * 128 + m * 16) * 2816 + col0;
                const f32x4 g0 = acc[ai][0][m][0], g1 = acc[ai][0][m][1], u0 = acc[ai][1][m][0], u1 = acc[ai][1][m][1]; u32x4 o;
                o.x = pg8::cvt_pk_bf16(silu_f(g0[0]) * u0[0], silu_f(g0[1]) * u0[1]); o.y = pg8::cvt_pk_bf16(silu_f(g0[2]) * u0[2], silu_f(g0[3]) * u0[3]);
                o.z = pg8::cvt_pk_bf16(silu_f(g1[0]) * u1[0], silu_f(g1[1]) * u1[1]); o.w = pg8::cvt_pk_bf16(silu_f(g1[2]) * u1[2], silu_f(g1[3]) * u1[3]);
                *(u32x4*)rowp = o; }
    }
};

struct EpiRes2 {
    static constexpr bool PERM = false, AFTER_DRAIN = false;
    bf16_t* out; const float* res; const float* mod; const float* gffn; bf16_t* A3; float* SS;
    DI void operator()(const f32x4 (&acc)[2][2][4][2], const pg8::Unit& u, int wr, int wc, int fr, int fq) const {
        const int row0 = u.pm * 256 + wr * 64 + fr, col0 = u.pn * 256 + wc * 32 + 4 * fq;
        const float* mp = mod + (size_t)(row0 >> 12) * 6144 + col0;
        f32x4 gv[2][2], gs[2][2];
#pragma unroll
        for (int bj = 0; bj < 2; ++bj)
#pragma unroll
            for (int n = 0; n < 2; ++n) { gv[bj][n] = *(const f32x4*)(mp + 2048 + bj * 128 + n * 16); gs[bj][n] = *(const f32x4*)(gffn + col0 + bj * 128 + n * 16) * (*(const f32x4*)(mp + 4096 + bj * 128 + n * 16) + 1.f); }
#pragma unroll
        for (int ai = 0; ai < 2; ++ai)
#pragma unroll
            for (int m = 0; m < 4; ++m) { const int row = row0 + ai * 128 + m * 16; const size_t ro = (size_t)row * 1024 + col0; float ssq = 0.f;
#pragma unroll
                for (int bj = 0; bj < 2; ++bj)
#pragma unroll
                    for (int n = 0; n < 2; ++n) { const f32x4 r = __builtin_nontemporal_load((const f32x4*)(res + ro + bj * 128 + n * 16)); const f32x4 x1 = r + gv[bj][n] * acc[ai][bj][m][n];
                        { u32x2 xo; xo.x = pk2(x1.x, x1.y); xo.y = pk2(x1.z, x1.w); *(u32x2*)(out + ro + bj * 128 + n * 16) = xo; } ssq += x1.x * x1.x + x1.y * x1.y + x1.z * x1.z + x1.w * x1.w;
                        const f32x4 a = x1 * gs[bj][n]; u32x2 o; o.x = pk2(a.x, a.y); o.y = pk2(a.z, a.w); *(u32x2*)(A3 + ro + bj * 128 + n * 16) = o; }
                ssq += __shfl_xor(ssq, 16); ssq += __shfl_xor(ssq, 32);
                if (fq == 0) unsafeAtomicAdd(SS + row, ssq); }
    }
};
struct EpiGLU2 {
    static constexpr bool PERM = true, AFTER_DRAIN = false;
    bf16_t* H; const float* SS; const float* bias;
    DI void operator()(const f32x4 (&acc)[2][2][4][2], const pg8::Unit& u, int wr, int wc, int fr, int fq) const {
        const int row0 = u.pm * 256 + wr * 64 + fr, col0 = u.pn * 128 + wc * 32 + 8 * fq;
        const float* bp = bias + (size_t)(row0 >> 12) * 5632 + col0;
        const f32x4 bg0 = *(const f32x4*)bp, bg1 = *(const f32x4*)(bp + 4), bu0 = *(const f32x4*)(bp + 2816), bu1 = *(const f32x4*)(bp + 2816 + 4);
#pragma unroll
        for (int ai = 0; ai < 2; ++ai)
#pragma unroll
            for (int m = 0; m < 4; ++m) { const int row = row0 + ai * 128 + m * 16; bf16_t* rowp = H + (size_t)row * 2816 + col0;
                const float rstd = rsqrtf(SS[row] * (1.f / 1024.f) + 1e-6f);
                const f32x4 g0 = acc[ai][0][m][0] * rstd + bg0, g1 = acc[ai][0][m][1] * rstd + bg1, u0 = acc[ai][1][m][0] * rstd + bu0, u1 = acc[ai][1][m][1] * rstd + bu1; u32x4 o;
                o.x = pk2(silu_f(g0[0]) * u0[0], silu_f(g0[1]) * u0[1]); o.y = pk2(silu_f(g0[2]) * u0[2], silu_f(g0[3]) * u0[3]);
                o.z = pk2(silu_f(g1[0]) * u1[0], silu_f(g1[1]) * u1[1]); o.w = pk2(silu_f(g1[2]) * u1[2], silu_f(g1[3]) * u1[3]);
                *(u32x4*)rowp = o; }
    }
};

struct EpiRes3 {
    static constexpr bool PERM = false, AFTER_DRAIN = false;
    float* out; const bf16_t* res; const float* gate; float* SSF;
    DI void operator()(const f32x4 (&acc)[2][2][4][2], const pg8::Unit& u, int wr, int wc, int fr, int fq) const {
        const int row0 = u.pm * 256 + wr * 64 + fr, col0 = u.pn * 256 + wc * 32 + 4 * fq;
        const float* gp = gate + (size_t)(row0 >> 12) * 6144 + col0;
        f32x4 gv[2][2];
#pragma unroll
        for (int bj = 0; bj < 2; ++bj)
#pragma unroll
            for (int n = 0; n < 2; ++n) gv[bj][n] = *(const f32x4*)(gp + bj * 128 + n * 16);
#pragma unroll
        for (int ai = 0; ai < 2; ++ai)
#pragma unroll
            for (int m = 0; m < 4; ++m) { const int row = row0 + ai * 128 + m * 16; const size_t ro = (size_t)row * 1024 + col0; float ssq = 0.f;
#pragma unroll
                for (int bj = 0; bj < 2; ++bj)
#pragma unroll
                    for (int n = 0; n < 2; ++n) { const u32x2 rb = __builtin_nontemporal_load((const u32x2*)(res + ro + bj * 128 + n * 16)); const f32x4 r = {bflo(rb.x), bfhi(rb.x), bflo(rb.y), bfhi(rb.y)}; const f32x4 x2 = r + gv[bj][n] * acc[ai][bj][m][n];
                        *(f32x4*)(out + ro + bj * 128 + n * 16) = x2; ssq += x2.x * x2.x + x2.y * x2.y + x2.z * x2.z + x2.w * x2.w; }
                ssq += __shfl_xor(ssq, 16); ssq += __shfl_xor(ssq, 32);
                if (fq == 0) unsafeAtomicAdd(SSF + row, ssq); }
    }
};

DI void phase_conv(const Params& p) {
    const int tid = threadIdx.x;
    const int tensor = blockIdx.x % 3, g = blockIdx.x / 3, Gt = (gridDim.x - tensor + 2) / 3;
    const bf16_t* __restrict__ src = (const bf16_t*)(p.ws + WS_QP + (size_t)tensor * PBUF);
    bf16_t* __restrict__ dst = (bf16_t*)(p.ws + (tensor == 0 ? WS_QC : tensor == 1 ? WS_KC : WS_VC));
    const int colb = (tid & 63) * 8, cwb = tensor * 512 + colb, rq = (tid >> 6) * 4;
    float cw[5][8];
#pragma unroll
    for (int i = 0; i < 5; ++i) { const f32x4 a = *(const f32x4*)(p.conv_w + i * 1536 + cwb), bq = *(const f32x4*)(p.conv_w + i * 1536 + cwb + 4);
        cw[i][0] = a.x; cw[i][1] = a.y; cw[i][2] = a.z; cw[i][3] = a.w; cw[i][4] = bq.x; cw[i][5] = bq.y; cw[i][6] = bq.z; cw[i][7] = bq.w; }
    u32x4 in[8], nx[8];
#define CONV_LOAD(dstv, j_) do { const int cr_ = (j_) >> 1, b_ = cr_ / 68, n_ = cr_ % 68, t0_ = n_ * 64 + ((j_) & 1) * 32 + rq; const int lo_ = n_ < 4 ? 0 : 256, hi_ = n_ < 4 ? 256 : TT; \
        _Pragma("unroll") for (int i = 0; i < 8; ++i) { const int tt = t0_ + i - 2; dstv[i] = (u32x4){0u, 0u, 0u, 0u}; if (tt >= lo_ && tt < hi_) dstv[i] = *(const u32x4*)(src + ((size_t)b_ * TT + tt) * 512 + colb); } } while (0)
    if (g < 544) CONV_LOAD(in, g);
#pragma unroll 1
    for (int j = g; j < 544; j += Gt) {
        if (j + Gt < 544) CONV_LOAD(nx, j + Gt);
        const int cr = j >> 1, b = cr / 68, n = cr % 68, t0 = n * 64 + (j & 1) * 32 + rq;
#pragma unroll
        for (int u = 0; u < 4; ++u) {
            float acc[8];
#pragma unroll
            for (int e = 0; e < 8; ++e) acc[e] = 0.f;
#pragma unroll
            for (int i = 0; i < 5; ++i) { const u32x4 v = in[u + i];
                acc[0] += bflo(v.x) * cw[i][0]; acc[1] += bfhi(v.x) * cw[i][1]; acc[2] += bflo(v.y) * cw[i][2]; acc[3] += bfhi(v.y) * cw[i][3];
                acc[4] += bflo(v.z) * cw[i][4]; acc[5] += bfhi(v.z) * cw[i][5]; acc[6] += bflo(v.w) * cw[i][6]; acc[7] += bfhi(v.w) * cw[i][7]; }
            float ss = 0;
#pragma unroll
            for (int e = 0; e < 8; ++e) { acc[e] = silu_f(acc[e]); ss += acc[e] * acc[e]; }
            if (tensor < 2) { ss += __shfl_xor(ss, 1); ss += __shfl_xor(ss, 2); ss += __shfl_xor(ss, 4); ss += __shfl_xor(ss, 8);
                const float sc = rsqrtf(ss + 1e-6f) * (tensor == 0 ? 0.08838834764831845f : 1.f);
#pragma unroll
                for (int e = 0; e < 8; ++e) acc[e] *= sc; }
            u32x4 o; o.x = pk2(acc[0], acc[1]); o.y = pk2(acc[2], acc[3]); o.z = pk2(acc[4], acc[5]); o.w = pk2(acc[6], acc[7]);
            *(u32x4*)(dst + ((size_t)b * TT + t0 + u) * 512 + colb) = o;
        }
#pragma unroll
        for (int i = 0; i < 8; ++i) in[i] = nx[i];
    }
#undef CONV_LOAD
}

constexpr int L_QS = 0, L_KS = 17408, L_WT = 0, L_UT = 18432, L_KT = 36864, L_VT = 55296, L_AA = 73728, L_QKF = 91136, L_QKB = 100352,
              L_TWF = 109568, L_TUF = 118784, L_TWB = 128000, L_TUB = 137216, L_VEC = 146432;
static_assert(L_VEC + 1024 <= LDS_BYTES, "lds");

DI void rot4(unsigned (&a)[4], int sft) {
    if (sft & 1) { const unsigned t = a[0]; a[0] = a[1]; a[1] = a[2]; a[2] = a[3]; a[3] = t; }
    if (sft & 2) { const unsigned t0 = a[0], t1 = a[1]; a[0] = a[2]; a[1] = a[3]; a[2] = t0; a[3] = t1; }
}
#define MFMA4F(a, b, c) __builtin_amdgcn_mfma_f32_16x16x4f32((a), (b), (c), 0, 0, 0)
constexpr int L_DS = 0;
DI void solve_diag(ldsp L, int w, int lane) {
    const int dir = w >> 2, k = w & 3, c = lane & 15;
    const LAS float* AA = (const LAS float*)(L + L_AA); const LAS float* VEC = (const LAS float*)(L + L_VEC);
    const int sg = dir ? -1 : 1, o0 = dir ? 63 : 0;
    const LAS float* Ab = AA + (o0 + sg * 16 * k) * 68 + (o0 + sg * 16 * k);
    float D[16];
#pragma unroll
    for (int i = 0; i < 16; ++i) { float s0 = (c == i) ? 1.f : 0.f;
#pragma unroll
        for (int j = 0; j < i; ++j) s0 -= Ab[sg * (i * 68 + j)] * D[j];
        D[i] = s0; }
    const int Cc = o0 + sg * (16 * k + c);
    const float beta = VEC[(dir ? 192 : 128) + Cc], cw = beta * __expf(VEC[(dir ? 64 : 0) + Cc]);
    ldsp TW = L + (dir ? L_TWB : L_TWF), TU = L + (dir ? L_TUB : L_TUF);
    if (lane < 16) {
#pragma unroll
        for (int i = 0; i < 16; ++i) { *(LAS float*)(L + L_DS + ((w * 16 + i) * 20 + c) * 4) = D[i];
            const int R = o0 + sg * (16 * k + i);
            *(LAS unsigned short*)(TW + R * 144 + Cc * 2) = f2bf(D[i] * cw); *(LAS unsigned short*)(TU + R * 144 + Cc * 2) = f2bf(D[i] * beta); } }
}
template <int KB> DI void solve_offdiag(ldsp L, int dir, int lane) {
    const int fr = lane & 15, fq = lane >> 4;
    const LAS float* AA = (const LAS float*)(L + L_AA); const LAS float* VEC = (const LAS float*)(L + L_VEC);
    const LAS float* DS = (const LAS float*)(L + L_DS) + dir * 4 * 320;
    const int sg = dir ? -1 : 1, o0 = dir ? 63 : 0;
    const int Cc = o0 + sg * (16 * KB + fr);
    const float beta = VEC[(dir ? 192 : 128) + Cc], cw = beta * __expf(VEC[(dir ? 64 : 0) + Cc]);
    ldsp TW = L + (dir ? L_TWB : L_TWF), TU = L + (dir ? L_TUB : L_TUF);
    f32x4 Tb[4];
#pragma unroll
    for (int r = 0; r < 4; ++r) Tb[KB][r] = DS[KB * 320 + (4 * fq + r) * 20 + fr];
#pragma unroll
    for (int i = KB + 1; i < 4; ++i) {
        f32x4 P = {0.f, 0.f, 0.f, 0.f};
#pragma unroll
        for (int j = KB; j < i; ++j) {
            const int row = o0 + sg * (16 * i + fr);
            f32x4 a;
            if (dir == 0) a = *(const LAS f32x4*)(AA + row * 68 + 16 * j + 4 * fq);
            else { const f32x4 t = *(const LAS f32x4*)(AA + row * 68 + 60 - 16 * j - 4 * fq); a = (f32x4){t.w, t.z, t.y, t.x}; }
#pragma unroll
            for (int r = 0; r < 4; ++r) P = MFMA4F(a[r], Tb[j][r], P);
        }
        const f32x4 d = *(const LAS f32x4*)(DS + i * 320 + fr * 20 + 4 * fq);
        f32x4 Z = {0.f, 0.f, 0.f, 0.f};
#pragma unroll
        for (int r = 0; r < 4; ++r) Z = MFMA4F(d[r], P[r], Z);
        Tb[i] = -Z;
#pragma unroll
        for (int r = 0; r < 4; ++r) { const int R = o0 + sg * (16 * i + 4 * fq + r);
            *(LAS unsigned short*)(TW + R * 144 + Cc * 2) = f2bf(Tb[i][r] * cw); *(LAS unsigned short*)(TU + R * 144 + Cc * 2) = f2bf(Tb[i][r] * beta); }
    }
}

DI void prep_gdn(const Params& p, ldsp L, int it, bool dry) {
    const int tid = threadIdx.x, lane = tid & 63, w = __builtin_amdgcn_readfirstlane(tid >> 6), fr = lane & 15, fq = lane >> 4;
    const int cr = it >> 2, h = it & 3, b = cr / 68, n = cr % 68;
    const size_t row0 = (size_t)b * TT + n * 64;
    const bf16_t* QC = (const bf16_t*)(p.ws + WS_QC); bf16_t* KC = (bf16_t*)(p.ws + WS_KC); const bf16_t* VC = (const bf16_t*)(p.ws + WS_VC);
    float* OG = p.out;
    LAS float* VEC = (LAS float*)(L + L_VEC);
#pragma unroll
    for (int u = 0; u < 2; ++u) { const int cid = w * 2 + u, r = (cid & 3) * 16 + fr, c8 = ((cid >> 2) * 4 + fq) * 8;
        const size_t g = (row0 + r) * 512 + h * 128 + c8;
        const u32x4 q = *(const u32x4*)(QC + g), k = __builtin_nontemporal_load((const u32x4*)(KC + g)), v = __builtin_nontemporal_load((const u32x4*)(VC + g));
        *(LAS u32x4*)(L + L_QS + r * 272 + c8 * 2) = q; *(LAS u32x4*)(L + L_KS + r * 272 + c8 * 2) = k;
        unsigned kk[4] = {k.x, k.y, k.z, k.w}, vv[4] = {v.x, v.y, v.z, v.w};
        rot4(kk, fq); rot4(vv, fq);
#pragma unroll
        for (int e = 0; e < 4; ++e) { const int row = c8 + 2 * ((e + fq) & 3);
            *(LAS unsigned short*)(L + L_KT + row * 144 + r * 2) = (unsigned short)(kk[e] & 0xffff); *(LAS unsigned short*)(L + L_KT + (row + 1) * 144 + r * 2) = (unsigned short)(kk[e] >> 16);
            *(LAS unsigned short*)(L + L_VT + row * 144 + r * 2) = (unsigned short)(vv[e] & 0xffff); *(LAS unsigned short*)(L + L_VT + (row + 1) * 144 + r * 2) = (unsigned short)(vv[e] >> 16); } }
    for (int e = tid; e < 9216; e += NT) *(LAS unsigned*)(L + L_TWF + e * 4) = 0u;
    if (tid < 64) {
        const float* gp = (const float*)(p.ws + WS_GATES) + (row0 + tid) * 16;
        const float gf = -__expf(p.a_log[h]) * softplus_f(gp[h] + p.dt_bias[h]);
        const float gb = -__expf(p.a_log[4 + h]) * softplus_f(gp[4 + h] + p.dt_bias[4 + h]);
        float pf = gf, pb = gb;
        for (int o = 1; o < 64; o <<= 1) { const float a = __shfl_up(pf, o), c = __shfl_up(pb, o); if (lane >= o) { pf += a; pb += c; } }
        const float totb = __shfl(pb, 63), GfL = __shfl(pf, 63);
        const float Gf = pf, Gb = totb - pb + gb;
        VEC[tid] = Gf; VEC[64 + tid] = Gb; VEC[128 + tid] = sigm_f(gp[8 + h]); VEC[192 + tid] = sigm_f(gp[12 + h]);
        float* dec = (float*)(p.ws + WS_DEC) + (size_t)(it * 2) * 80;
        dec[tid] = __expf(GfL - Gf); dec[80 + tid] = __expf(totb - Gb);
        if (tid == 0) { dec[64] = __expf(GfL); dec[80 + 64] = __expf(totb); }
    }
    lds_barrier();
    { const int mat = w >> 2, tr = w & 3;
      ldsp Ab = L + (mat ? L_QS : L_KS);
      bf16x8 a[4];
#pragma unroll
      for (int kk = 0; kk < 4; ++kk) a[kk] = lds16(Ab + (tr * 16 + fr) * 272 + kk * 64 + fq * 16);
#pragma unroll
      for (int tc = 0; tc < 4; ++tc) {
          f32x4 acc = {0.f, 0.f, 0.f, 0.f};
#pragma unroll
          for (int kk = 0; kk < 4; ++kk) acc = MFMA16(a[kk], lds16(L + L_KS + (tc * 16 + fr) * 272 + kk * 64 + fq * 16), acc);
          const int s = tc * 16 + fr; const float Gfs = VEC[s], Gbs = VEC[64 + s];
#pragma unroll
          for (int j = 0; j < 4; ++j) { const int t = tr * 16 + fq * 4 + j; const float Gft = VEC[t], Gbt = VEC[64 + t];
              if (mat == 0) { float v = 0.f; if (s < t) v = VEC[128 + t] * acc[j] * __expf(Gft - Gfs); else if (s > t) v = VEC[192 + t] * acc[j] * __expf(Gbt - Gbs);
                  *(LAS float*)(L + L_AA + (t * 68 + s) * 4) = v; }
              else { const float vf = (s <= t) ? acc[j] * __expf(Gft - Gfs) : 0.f, vb = (s >= t) ? acc[j] * __expf(Gbt - Gbs) : 0.f;
                  *(LAS unsigned short*)(L + L_QKF + t * 144 + s * 2) = f2bf(vf); *(LAS unsigned short*)(L + L_QKB + t * 144 + s * 2) = f2bf(vb); } } } }
    lds_barrier();
    solve_diag(L, w, lane);
    lds_barrier();
    if (w < 6) { const int dr_ = w >= 3 ? 1 : 0, kb = w - 3 * dr_; if (kb == 0) solve_offdiag<0>(L, dr_, lane); else if (kb == 1) solve_offdiag<1>(L, dr_, lane); else solve_offdiag<2>(L, dr_, lane); }
    lds_barrier();
    f32x4 oacc[8];
#pragma unroll
    for (int i = 0; i < 8; ++i) oacc[i] = (f32x4){0.f, 0.f, 0.f, 0.f};
#pragma unroll 1
    for (int dir = 0; dir < 2; ++dir) {
        ldsp TW = L + (dir ? L_TWB : L_TWF), TU = L + (dir ? L_TUB : L_TUF), QKM = L + (dir ? L_QKB : L_QKF);
        bf16_t* Wg = (bf16_t*)(p.ws + (dir ? WS_WB : WS_WF)) + (size_t)it * 8192;
        bf16_t* Ug = (bf16_t*)(p.ws + (dir ? WS_UB : WS_UF)) + (size_t)it * 8192;
        bf16_t* Qg = (bf16_t*)(p.ws + (dir ? WS_QB : WS_QF)) + (size_t)it * 8192;
        u32x2 qv[8];
        if (w < 4) {
#pragma unroll
            for (int dr = 0; dr < 8; ++dr) qv[dr] = *(const u32x2*)(QC + (row0 + w * 16 + fr) * 512 + h * 128 + dr * 16 + fq * 4);
            const bf16x8 b0 = lds16(TW + (w * 16 + fr) * 144 + fq * 16), b1 = lds16(TW + (w * 16 + fr) * 144 + 64 + fq * 16);
            const int t = w * 16 + fr; const float et = dir ? __expf(VEC[64] - VEC[64 + t]) : __expf(VEC[63] - VEC[t]);
#pragma unroll
            for (int dr = 0; dr < 8; ++dr) { f32x4 acc = {0.f, 0.f, 0.f, 0.f};
                acc = MFMA16(lds16(L + L_KT + (dr * 16 + fr) * 144 + fq * 16), b0, acc); acc = MFMA16(lds16(L + L_KT + (dr * 16 + fr) * 144 + 64 + fq * 16), b1, acc);
                const int d0 = dr * 16 + fq * 4; u32x2 o; o.x = pk2(acc[0], acc[1]); o.y = pk2(acc[2], acc[3]);
                { u32x2 og; og.x = pk2(acc[0] * et, acc[1] * et); og.y = pk2(acc[2] * et, acc[3] * et); *(u32x2*)(Wg + ((w * 4 + (dr >> 1)) * 64 + ((dr & 1) * 2 + (fq >> 1)) * 16 + fr) * 8 + (fq & 1) * 4) = og; }
                *(LAS unsigned short*)(L + L_WT + (d0 + 0) * 144 + t * 2) = (unsigned short)(o.x & 0xffff); *(LAS unsigned short*)(L + L_WT + (d0 + 1) * 144 + t * 2) = (unsigned short)(o.x >> 16);
                *(LAS unsigned short*)(L + L_WT + (d0 + 2) * 144 + t * 2) = (unsigned short)(o.y & 0xffff); *(LAS unsigned short*)(L + L_WT + (d0 + 3) * 144 + t * 2) = (unsigned short)(o.y >> 16); }
        } else {
            const int tw = w - 4;
            const bf16x8 a0 = lds16(TU + (tw * 16 + fr) * 144 + fq * 16), a1 = lds16(TU + (tw * 16 + fr) * 144 + 64 + fq * 16);
            const int t0 = tw * 16 + fq * 4; float eu[4];
#pragma unroll
            for (int j = 0; j < 4; ++j) eu[j] = dir ? __expf(VEC[64] - VEC[64 + t0 + j]) : __expf(VEC[63] - VEC[t0 + j]);
#pragma unroll
            for (int tc = 0; tc < 8; ++tc) { f32x4 acc = {0.f, 0.f, 0.f, 0.f};
                acc = MFMA16(a0, lds16(L + L_VT + (tc * 16 + fr) * 144 + fq * 16), acc); acc = MFMA16(a1, lds16(L + L_VT + (tc * 16 + fr) * 144 + 64 + fq * 16), acc);
                const int c = tc * 16 + fr; u32x2 o; o.x = pk2(acc[0], acc[1]); o.y = pk2(acc[2], acc[3]);
                *(LAS u32x2*)(L + L_UT + c * 144 + t0 * 2) = o; { u32x2 og; og.x = pk2(acc[0] * eu[0], acc[1] * eu[1]); og.y = pk2(acc[2] * eu[2], acc[3] * eu[3]); *(u32x2*)(Ug + c * 64 + t0) = og; } }
        }
        lds_barrier();
        if (w < 4) {
            const bf16x8 b0 = lds16(QKM + (w * 16 + fr) * 144 + fq * 16), b1 = lds16(QKM + (w * 16 + fr) * 144 + 64 + fq * 16);
            const int t = w * 16 + fr; const float eg = __expf(VEC[(dir ? 64 : 0) + t]);
#pragma unroll
            for (int dr = 0; dr < 8; ++dr) { f32x4 acc = {0.f, 0.f, 0.f, 0.f};
                acc = MFMA16(lds16(L + L_WT + (dr * 16 + fr) * 144 + fq * 16), b0, acc); acc = MFMA16(lds16(L + L_WT + (dr * 16 + fr) * 144 + 64 + fq * 16), b1, acc);
                const u32x2 q = qv[dr];
                u32x2 o; o.x = pk2(eg * bflo(q.x) - acc[0], eg * bfhi(q.x) - acc[1]); o.y = pk2(eg * bflo(q.y) - acc[2], eg * bfhi(q.y) - acc[3]);
                *(u32x2*)(Qg + ((w * 4 + (dr >> 1)) * 64 + ((dr & 1) * 2 + (fq >> 1)) * 16 + fr) * 8 + (fq & 1) * 4) = o; }
        } else {
            const int tw = w - 4;
            const bf16x8 b0 = lds16(QKM + (tw * 16 + fr) * 144 + fq * 16), b1 = lds16(QKM + (tw * 16 + fr) * 144 + 64 + fq * 16);
#pragma unroll
            for (int ct = 0; ct < 8; ++ct) { oacc[ct] = MFMA16(lds16(L + L_UT + (ct * 16 + fr) * 144 + fq * 16), b0, oacc[ct]); oacc[ct] = MFMA16(lds16(L + L_UT + (ct * 16 + fr) * 144 + 64 + fq * 16), b1, oacc[ct]); }
        }
        lds_barrier();
    }
    if (w >= 4 && n >= 4) { const int t = (w - 4) * 16 + fr; const size_t lrow = (size_t)b * 4096 + (n - 4) * 64 + t;
#pragma unroll
        for (int ct = 0; ct < 8; ++ct) *(f32x4*)(OG + lrow * 512 + h * 128 + ct * 16 + fq * 4) = oacc[ct]; }
    if (!dry) for (int pc = tid; pc < 1024; pc += NT) { const int d = pc >> 3, t8 = (pc & 7) * 8; const u32x4 v = *(const LAS u32x4*)(L + L_KT + d * 144 + t8 * 2);
        { const int e_ = ((((d >> 4) * 2 + (t8 >> 5)) * 64) + ((t8 >> 3) & 3) * 16 + (d & 15)) * 8; *(u32x4*)(KC + (row0 + (e_ >> 7)) * 512 + h * 128 + (e_ & 127)) = v; } }
    lds_barrier();
}

DI float logsig_f(float x) { return -softplus_f(-x); }

DI void prep_ret(const Params& p, ldsp L, int it, bool dry) {
    const int tid = threadIdx.x, lane = tid & 63, w = __builtin_amdgcn_readfirstlane(tid >> 6), fr = lane & 15, fq = lane >> 4;
    const int cr = it >> 2, h = it & 3, b = cr / 68, n = cr % 68; const bool isctx = n < 4;
    const size_t row0 = (size_t)b * TT + n * 64;
    bf16_t* RQ = (bf16_t*)(p.ws + WS_RQ); bf16_t* RK = (bf16_t*)(p.ws + WS_RK); const bf16_t* RV = (const bf16_t*)(p.ws + WS_RV);
    float* ORp = p.out + (size_t)LROWS * 512;
    constexpr int R_QS = 0, R_KS = 17408, R_KT = 36864, R_VT = 55296, R_QKD = 73728;
    const float lgf2 = logsig_f(p.ret_logit[h]) * 1.4426950408889634f, lgb2 = logsig_f(p.ret_logit[4 + h]) * 1.4426950408889634f;
    u32x4 q1s = {0u, 0u, 0u, 0u}, q2s = {0u, 0u, 0u, 0u};
    { const int r = (w & 3) * 16 + fr, p8 = ((w >> 2) * 4 + fq) * 8, t = n * 64 + r;
      float pos; int i0; float rc;
      if (p8 < 16) { pos = isctx ? (float)t : 256.f; i0 = p8; rc = 1.f / 16.f; }
      else if (p8 < 40) { pos = isctx ? 0.f : (float)((t - 256) >> 6); i0 = p8 - 16; rc = 1.f / 24.f; }
      else { pos = isctx ? 0.f : (float)((t - 256) & 63); i0 = p8 - 40; rc = 1.f / 24.f; }
      float cs[8], sn[8];
#pragma unroll
      for (int e = 0; e < 8; ++e) { const float ang = pos * exp2f(-13.287712379549449f * (float)(i0 + e) * rc); cs[e] = __cosf(ang); sn[e] = __sinf(ang); }
      const size_t g = (row0 + r) * 512 + h * 128 + p8;
      { const u32x4 k1 = __builtin_nontemporal_load((const u32x4*)(RK + g)), k2 = __builtin_nontemporal_load((const u32x4*)(RK + g + 64));
        const unsigned a1[4] = {k1.x, k1.y, k1.z, k1.w}, a2[4] = {k2.x, k2.y, k2.z, k2.w}; unsigned o1[4], o2[4];
#pragma unroll
        for (int e = 0; e < 4; ++e) { const float x0 = bflo(a1[e]), x1 = bfhi(a1[e]), y0 = bflo(a2[e]), y1 = bfhi(a2[e]); const float sc = 0.08838834764831845f;
            o1[e] = pk2((x0 * cs[2 * e] - y0 * sn[2 * e]) * sc, (x1 * cs[2 * e + 1] - y1 * sn[2 * e + 1]) * sc);
            o2[e] = pk2((x0 * sn[2 * e] + y0 * cs[2 * e]) * sc, (x1 * sn[2 * e + 1] + y1 * cs[2 * e + 1]) * sc); }
        *(LAS u32x4*)(L + R_KS + r * 272 + p8 * 2) = (u32x4){o1[0], o1[1], o1[2], o1[3]}; *(LAS u32x4*)(L + R_KS + r * 272 + (64 + p8) * 2) = (u32x4){o2[0], o2[1], o2[2], o2[3]};
rot4(o1, fq); rot4(o2, fq);
#pragma unroll
        for (int e = 0; e < 4; ++e) { const int row = p8 + 2 * ((e + fq) & 3);
            *(LAS unsigned short*)(L + R_KT + row * 144 + r * 2) = (unsigned short)(o1[e] & 0xffff); *(LAS unsigned short*)(L + R_KT + (row + 1) * 144 + r * 2) = (unsigned short)(o1[e] >> 16);
            *(LAS unsigned short*)(L + R_KT + (64 + row) * 144 + r * 2) = (unsigned short)(o2[e] & 0xffff); *(LAS unsigned short*)(L + R_KT + (64 + row + 1) * 144 + r * 2) = (unsigned short)(o2[e] >> 16); } }
      if (!isctx) {
        const u32x4 k1 = __builtin_nontemporal_load((const u32x4*)(RQ + g)), k2 = __builtin_nontemporal_load((const u32x4*)(RQ + g + 64));
        const unsigned a1[4] = {k1.x, k1.y, k1.z, k1.w}, a2[4] = {k2.x, k2.y, k2.z, k2.w}; unsigned o1[4], o2[4];
#pragma unroll
        for (int e = 0; e < 4; ++e) { const float x0 = bflo(a1[e]), x1 = bfhi(a1[e]), y0 = bflo(a2[e]), y1 = bfhi(a2[e]);
            o1[e] = pk2(x0 * cs[2 * e] - y0 * sn[2 * e], x1 * cs[2 * e + 1] - y1 * sn[2 * e + 1]);
            o2[e] = pk2(x0 * sn[2 * e] + y0 * cs[2 * e], x1 * sn[2 * e + 1] + y1 * cs[2 * e + 1]); }
        const u32x4 q1 = {o1[0], o1[1], o1[2], o1[3]}, q2 = {o2[0], o2[1], o2[2], o2[3]};
        *(LAS u32x4*)(L + R_QS + r * 272 + p8 * 2) = q1; *(LAS u32x4*)(L + R_QS + r * 272 + (64 + p8) * 2) = q2;
        q1s = q1; q2s = q2;
#pragma unroll
        for (int u = 0; u < 2; ++u) { const int cid = w * 2 + u, r2 = (cid & 3) * 16 + fr, c8 = ((cid >> 2) * 4 + fq) * 8; const u32x4 v = *(const u32x4*)(RV + (row0 + r2) * 512 + h * 128 + c8);
            unsigned vv[4] = {v.x, v.y, v.z, v.w}; rot4(vv, fq);
#pragma unroll
            for (int e = 0; e < 4; ++e) { const int row = c8 + 2 * ((e + fq) & 3); *(LAS unsigned short*)(L + R_VT + row * 144 + r2 * 2) = (unsigned short)(vv[e] & 0xffff); *(LAS unsigned short*)(L + R_VT + (row + 1) * 144 + r2 * 2) = (unsigned short)(vv[e] >> 16); } }
      }
    }
    lds_barrier();
    if (!dry && !isctx) { const int r = (w & 3) * 16 + fr, p8 = ((w >> 2) * 4 + fq) * 8; const int e1 = ((((r >> 4) * 4 + (p8 >> 5)) * 64) + ((p8 >> 3) & 3) * 16 + (r & 15)) * 8, e2 = e1 + 2 * 64 * 8;
        *(u32x4*)(RQ + (row0 + (e1 >> 7)) * 512 + h * 128 + (e1 & 127)) = q1s; *(u32x4*)(RQ + (row0 + (e2 >> 7)) * 512 + h * 128 + (e2 & 127)) = q2s; }
    if (!dry) for (int pc = tid; pc < 1024; pc += NT) { const int d = pc >> 3, t8 = (pc & 7) * 8; const u32x4 v = *(const LAS u32x4*)(L + R_KT + d * 144 + t8 * 2);
        { const int e_ = ((((d >> 4) * 2 + (t8 >> 5)) * 64) + ((t8 >> 3) & 3) * 16 + (d & 15)) * 8; *(u32x4*)(RK + (row0 + (e_ >> 7)) * 512 + h * 128 + (e_ & 127)) = v; } }
    if (!isctx) {
        { const int tr = w >> 1; bf16x8 a[4];
#pragma unroll
          for (int kk = 0; kk < 4; ++kk) a[kk] = lds16(L + R_QS + (tr * 16 + fr) * 272 + kk * 64 + fq * 16);
#pragma unroll
          for (int x = 0; x < 2; ++x) { const int tc = (w & 1) * 2 + x; f32x4 acc = {0.f, 0.f, 0.f, 0.f};
#pragma unroll
              for (int kk = 0; kk < 4; ++kk) acc = MFMA16(a[kk], lds16(L + R_KS + (tc * 16 + fr) * 272 + kk * 64 + fq * 16), acc);
              const int s = tc * 16 + fr;
#pragma unroll
              for (int j = 0; j < 4; ++j) { const int t = tr * 16 + fq * 4 + j, dt = t - s;
                  const float f = (dt >= 0 ? exp2f((float)dt * lgf2) : 0.f) + (dt <= 0 ? exp2f((float)(-dt) * lgb2) : 0.f);
                  *(LAS unsigned short*)(L + R_QKD + t * 144 + s * 2) = f2bf(acc[j] * f); } } }
        lds_barrier();
        { const int tw = w & 3; const bf16x8 b0 = lds16(L + R_QKD + (tw * 16 + fr) * 144 + fq * 16), b1 = lds16(L + R_QKD + (tw * 16 + fr) * 144 + 64 + fq * 16);
          const int t = tw * 16 + fr; const size_t lrow = (size_t)b * 4096 + (n - 4) * 64 + t;
#pragma unroll
          for (int x = 0; x < 4; ++x) { const int ct = (w >> 2) * 4 + x; f32x4 acc = {0.f, 0.f, 0.f, 0.f};
              acc = MFMA16(lds16(L + R_VT + (ct * 16 + fr) * 144 + fq * 16), b0, acc); acc = MFMA16(lds16(L + R_VT + (ct * 16 + fr) * 144 + 64 + fq * 16), b1, acc);
              *(f32x4*)(ORp + lrow * 512 + h * 128 + ct * 16 + fq * 4) = acc; } }
    }
    lds_barrier();
}

DI int chunk_of(int i, int dir) { return dir == 0 ? i : (i < 4 ? 3 - i : 71 - i); }
constexpr int S_ST = 0, S_VT = 8704;

struct GSet { bf16x8 W[4], Q[4], K[2]; u32x2 U; float gl; f32x4 O; };
struct GCtx { const bf16_t *Wb, *Qb, *Ub, *KC; const float* DEC; float* OG; bf16_t* OGB; int b, h, dir, slice, w, fr, fq, tr, tc; unsigned lw, lk, lu, lo; float osc; };
DI void gdn_load(GSet& s, const GCtx& c, int n) {
    const int it = __builtin_amdgcn_readfirstlane((c.b * 68 + n) * 4 + c.h); const size_t r0 = (size_t)c.b * TT + n * 64;
    const char* wp = (const char*)c.Wb + (size_t)it * 16384; const char* qp = (const char*)c.Qb + (size_t)it * 16384;
#pragma unroll
    for (int kk = 0; kk < 4; ++kk) { s.W[kk] = *(const bf16x8*)(wp + (c.lw + kk * 1024)); s.Q[kk] = *(const bf16x8*)(qp + (c.lw + kk * 1024)); }
    const char* kp = (const char*)c.KC + (r0 * 512 + c.h * 128) * 2;
    s.K[0] = *(const bf16x8*)(kp + c.lk); s.K[1] = *(const bf16x8*)(kp + (c.lk + 4 * 512 * 2));
    s.U = *(const u32x2*)((const char*)c.Ub + (size_t)it * 16384 + c.lu);
    s.gl = c.DEC[(size_t)(it * 2 + c.dir) * 80 + 64];
    if (c.dir == 0) { const int nn = n >= 4 ? n - 4 : 0; s.O = *(const f32x4*)((const char*)c.OG + (((size_t)c.b * 4096 + nn * 64) * 512 + c.h * 128 + c.slice * 32) * 4 + c.lo); }
}
DI void gdn_step(const GSet& s, const GCtx& c, ldsp L, f32x4& S0, f32x4& S1, int n) {
    f32x4 X = {0.f, 0.f, 0.f, 0.f}, OX = {0.f, 0.f, 0.f, 0.f};
#pragma unroll
    for (int kk = 0; kk < 4; ++kk) { const bf16x8 sf = lds16(L + S_ST + (c.tc * 16 + c.fr) * 272 + kk * 64 + c.fq * 16); X = MFMA16(s.W[kk], sf, X); OX = MFMA16(sf, s.Q[kk], OX); }
    { u32x2 o; o.x = pk2(bflo(s.U.x) - X[0], bfhi(s.U.x) - X[1]); o.y = pk2(bflo(s.U.y) - X[2], bfhi(s.U.y) - X[3]);
      *(LAS u32x2*)(L + S_VT + (c.tc * 16 + c.fr) * 144 + (c.tr * 16 + c.fq * 4) * 2) = o; }
    { const bool valid = n >= 4; const float sc = valid ? c.osc : 0.f;
      if (c.dir == 0) { const int nn = valid ? n - 4 : 0;
          *(f32x4*)((char*)c.OG + (((size_t)c.b * 4096 + nn * 64) * 512 + c.h * 128 + c.slice * 32) * 4 + c.lo) = s.O + OX * sc; }
      else { const size_t row = valid ? (size_t)c.b * 4096 + (n - 4) * 64 + c.tr * 16 + c.fr : (size_t)LROWS + c.tr * 16 + c.fr;
          u32x2 o; o.x = pk2(OX[0] * sc, OX[1] * sc); o.y = pk2(OX[2] * sc, OX[3] * sc);
          *(u32x2*)(c.OGB + row * 512 + c.h * 128 + c.slice * 32 + c.tc * 16 + c.fq * 4) = o; } }
    lds_barrier();
    { S0 *= s.gl; S1 *= s.gl;
#pragma unroll
      for (int kk = 0; kk < 2; ++kk) { S0 = MFMA16(s.K[kk], lds16(L + S_VT + c.fr * 144 + kk * 64 + c.fq * 16), S0); S1 = MFMA16(s.K[kk], lds16(L + S_VT + (16 + c.fr) * 144 + kk * 64 + c.fq * 16), S1); }
      u32x2 o; o.x = pk2(S0[0], S0[1]); o.y = pk2(S0[2], S0[3]); *(LAS u32x2*)(L + S_ST + c.fr * 272 + (c.w * 16 + c.fq * 4) * 2) = o;
      o.x = pk2(S1[0], S1[1]); o.y = pk2(S1[2], S1[3]); *(LAS u32x2*)(L + S_ST + (16 + c.fr) * 272 + (c.w * 16 + c.fq * 4) * 2) = o; }
    lds_barrier();
}
DI void scan_gdn(const Params& p, ldsp L, int b, int h, int dir, int slice, float osc) {
    const int tid = threadIdx.x, lane = tid & 63, w = __builtin_amdgcn_readfirstlane(tid >> 6);
    GCtx c; c.Wb = (const bf16_t*)(p.ws + (dir ? WS_WB : WS_WF)); c.Ub = (const bf16_t*)(p.ws + (dir ? WS_UB : WS_UF)); c.Qb = (const bf16_t*)(p.ws + (dir ? WS_QB : WS_QF));
    c.KC = (const bf16_t*)(p.ws + WS_KC); c.DEC = (const float*)(p.ws + WS_DEC); c.OG = p.out; c.OGB = (bf16_t*)(p.ws + WS_OGB);
    c.b = b; c.h = h; c.dir = dir; c.slice = slice; c.w = w; c.fr = lane & 15; c.fq = lane >> 4; c.tr = w >> 1; c.tc = w & 1; c.osc = osc;
    c.lw = (unsigned)((c.tr * 256 + c.fq * 16 + c.fr) * 16); c.lk = (unsigned)(((w * 8 + c.fq) * 512 + c.fr * 8) * 2);
    c.lu = (unsigned)(((slice * 32 + c.tc * 16 + c.fr) * 64 + c.tr * 16 + c.fq * 4) * 2); c.lo = (unsigned)(((c.tr * 16 + c.fr) * 512 + c.tc * 16 + c.fq * 4) * 4);
    for (int e = tid; e < (8704 + 4608) / 4; e += NT) ((LAS unsigned*)L)[e] = 0u;
    lds_barrier();
    f32x4 S0 = {0.f, 0.f, 0.f, 0.f}, S1 = {0.f, 0.f, 0.f, 0.f};
    GSet A, B, C;
    gdn_load(A, c, chunk_of(0, dir)); gdn_load(B, c, chunk_of(1, dir));
#pragma unroll 1
    for (int i = 0; i < 66; i += 6) {
        gdn_load(C, c, chunk_of(i + 2, dir)); gdn_step(A, c, L, S0, S1, chunk_of(i, dir));
        gdn_load(A, c, chunk_of(i + 3, dir)); gdn_step(B, c, L, S0, S1, chunk_of(i + 1, dir));
        gdn_load(B, c, chunk_of(i + 4, dir)); gdn_step(C, c, L, S0, S1, chunk_of(i + 2, dir));
        gdn_load(C, c, chunk_of(i + 5, dir)); gdn_step(A, c, L, S0, S1, chunk_of(i + 3, dir));
        gdn_load(A, c, chunk_of(i + 6, dir)); gdn_step(B, c, L, S0, S1, chunk_of(i + 4, dir));
        gdn_load(B, c, chunk_of(i + 7, dir)); gdn_step(C, c, L, S0, S1, chunk_of(i + 5, dir));
    }
    gdn_step(A, c, L, S0, S1, chunk_of(66, dir)); gdn_step(B, c, L, S0, S1, chunk_of(67, dir));
}

struct RSet { bf16x8 Q[4], K[2]; u32x2 V; f32x4 O; };
struct RCtx { const bf16_t *RQ, *RK, *RV; float* ORp; bf16_t* ORB; int b, h, dir, slice, w, fr, fq, tr, tc, vt, vc4; unsigned lq, lk, lv, lo; float osc, gC, zeta, xiT; };
DI void ret_load(RSet& s, const RCtx& c, int n) {
    const size_t r0 = (size_t)c.b * TT + n * 64; const size_t ub = (r0 * 512 + c.h * 128) * 2;
    const char* qp = (const char*)c.RQ + ub;
#pragma unroll
    for (int kk = 0; kk < 4; ++kk) s.Q[kk] = *(const bf16x8*)(qp + (c.lq + kk * 4 * 512 * 2));
    const char* kp = (const char*)c.RK + ub;
    s.K[0] = *(const bf16x8*)(kp + c.lk); s.K[1] = *(const bf16x8*)(kp + (c.lk + 4 * 512 * 2));
    s.V = *(const u32x2*)((const char*)c.RV + ub + c.lv);
    if (c.dir == 0) { const int nn = n >= 4 ? n - 4 : 0; s.O = *(const f32x4*)((const char*)c.ORp + (((size_t)c.b * 4096 + nn * 64) * 512 + c.h * 128 + c.slice * 32) * 4 + c.lo); }
}
DI void ret_step(const RSet& s, const RCtx& c, ldsp L, f32x4& S0, f32x4& S1, int n) {
    { unsigned vz[4] = {f2bf(bflo(s.V.x) * c.zeta), f2bf(bfhi(s.V.x) * c.zeta), f2bf(bflo(s.V.y) * c.zeta), f2bf(bfhi(s.V.y) * c.zeta)};
      const int sft = (c.vc4 >> 3) & 3; rot4(vz, sft);
#pragma unroll
      for (int i = 0; i < 4; ++i) *(LAS unsigned short*)(L + S_VT + (c.vc4 + ((i + sft) & 3)) * 144 + c.vt * 2) = (unsigned short)vz[i]; }
    { f32x4 OX = {0.f, 0.f, 0.f, 0.f};
#pragma unroll
      for (int kk = 0; kk < 4; ++kk) OX = MFMA16(lds16(L + S_ST + (c.tc * 16 + c.fr) * 272 + kk * 64 + c.fq * 16), s.Q[kk], OX);
      const bool valid = n >= 4; const float sc = valid ? c.osc * c.xiT : 0.f;
      if (c.dir == 0) { const int nn = valid ? n - 4 : 0;
          *(f32x4*)((char*)c.ORp + (((size_t)c.b * 4096 + nn * 64) * 512 + c.h * 128 + c.slice * 32) * 4 + c.lo) = s.O + OX * sc; }
      else { const size_t row = valid ? (size_t)c.b * 4096 + (n - 4) * 64 + c.tr * 16 + c.fr : (size_t)LROWS + c.tr * 16 + c.fr;
          u32x2 o; o.x = pk2(OX[0] * sc, OX[1] * sc); o.y = pk2(OX[2] * sc, OX[3] * sc);
          *(u32x2*)(c.ORB + row * 512 + c.h * 128 + c.slice * 32 + c.tc * 16 + c.fq * 4) = o; } }
    lds_barrier();
    { S0 *= c.gC; S1 *= c.gC;
#pragma unroll
      for (int kk = 0; kk < 2; ++kk) { S0 = MFMA16(s.K[kk], lds16(L + S_VT + c.fr * 144 + kk * 64 + c.fq * 16), S0); S1 = MFMA16(s.K[kk], lds16(L + S_VT + (16 + c.fr) * 144 + kk * 64 + c.fq * 16), S1); }
      u32x2 o; o.x = pk2(S0[0], S0[1]); o.y = pk2(S0[2], S0[3]); *(LAS u32x2*)(L + S_ST + c.fr * 272 + (c.w * 16 + c.fq * 4) * 2) = o;
      o.x = pk2(S1[0], S1[1]); o.y = pk2(S1[2], S1[3]); *(LAS u32x2*)(L + S_ST + (16 + c.fr) * 272 + (c.w * 16 + c.fq * 4) * 2) = o; }
    lds_barrier();
}
DI void scan_ret(const Params& p, ldsp L, int b, int h, int dir, int slice, float osc) {
    const int tid = threadIdx.x, lane = tid & 63, w = __builtin_amdgcn_readfirstlane(tid >> 6);
    RCtx c; c.RQ = (const bf16_t*)(p.ws + WS_RQ); c.RK = (const bf16_t*)(p.ws + WS_RK); c.RV = (const bf16_t*)(p.ws + WS_RV); c.ORp = p.out + (size_t)LROWS * 512; c.ORB = (bf16_t*)(p.ws + WS_ORB);
    c.b = b; c.h = h; c.dir = dir; c.slice = slice; c.w = w; c.fr = lane & 15; c.fq = lane >> 4; c.tr = w >> 1; c.tc = w & 1; c.osc = osc; c.vt = tid >> 3; c.vc4 = (tid & 7) * 4;
    c.lq = (unsigned)(((c.tr * 16 + c.fq) * 512 + c.fr * 8) * 2); c.lk = (unsigned)(((w * 8 + c.fq) * 512 + c.fr * 8) * 2); c.lv = (unsigned)((c.vt * 512 + slice * 32 + c.vc4) * 2); c.lo = (unsigned)(((c.tr * 16 + c.fr) * 512 + c.tc * 16 + c.fq * 4) * 4);
    const float lg2 = logsig_f(p.ret_logit[dir * 4 + h]) * 1.4426950408889634f;
    c.gC = exp2f(64.f * lg2); c.zeta = exp2f((float)(dir ? c.vt : 63 - c.vt) * lg2);
    { const int t = c.tr * 16 + c.fr; c.xiT = exp2f((float)(dir ? 64 - t : t + 1) * lg2); }
    for (int e = tid; e < (8704 + 4608) / 4; e += NT) ((LAS unsigned*)L)[e] = 0u;
    lds_barrier();
    f32x4 S0 = {0.f, 0.f, 0.f, 0.f}, S1 = {0.f, 0.f, 0.f, 0.f};
    RSet A, B, C;
    ret_load(A, c, chunk_of(0, dir)); ret_load(B, c, chunk_of(1, dir));
#pragma unroll 1
    for (int i = 0; i < 66; i += 6) {
        ret_load(C, c, chunk_of(i + 2, dir)); ret_step(A, c, L, S0, S1, chunk_of(i, dir));
        ret_load(A, c, chunk_of(i + 3, dir)); ret_step(B, c, L, S0, S1, chunk_of(i + 1, dir));
        ret_load(B, c, chunk_of(i + 4, dir)); ret_step(C, c, L, S0, S1, chunk_of(i + 2, dir));
        ret_load(C, c, chunk_of(i + 5, dir)); ret_step(A, c, L, S0, S1, chunk_of(i + 3, dir));
        ret_load(A, c, chunk_of(i + 6, dir)); ret_step(B, c, L, S0, S1, chunk_of(i + 4, dir));
        ret_load(B, c, chunk_of(i + 7, dir)); ret_step(C, c, L, S0, S1, chunk_of(i + 5, dir));
    }
    ret_step(A, c, L, S0, S1, chunk_of(66, dir)); ret_step(B, c, L, S0, S1, chunk_of(67, dir));
}

DI void phase_postnorm(const Params& p, ldsp L) {
    const int tid = threadIdx.x, lane = tid & 63, w = tid >> 6;
    const float* OG = p.out; const float* ORp = p.out + (size_t)LROWS * 512;
    const bf16_t* Z = (const bf16_t*)(p.ws + WS_Z); const bf16_t* RG = (const bf16_t*)(p.ws + WS_RG);
    const bf16_t* OGB = (const bf16_t*)(p.ws + WS_OGB); const bf16_t* ORB = (const bf16_t*)(p.ws + WS_ORB);
    bf16_t* Y = (bf16_t*)(p.ws + WS_Y);
    const int d0 = (lane & 15) * 8;
    float gg[8], rg_[8];
#pragma unroll
    for (int e = 0; e < 8; ++e) { gg[e] = p.gdn_norm_g[d0 + e]; rg_[e] = p.ret_norm_g[d0 + e]; }
#pragma unroll 2
    for (int R = blockIdx.x * 8 + w; R < LROWS; R += gridDim.x * 8) {
        const size_t prow = (size_t)(R >> 12) * TT + 256 + (R & 4095);
        { const f32x4 a = __builtin_nontemporal_load((const f32x4*)(OG + (size_t)R * 512 + lane * 8)), c = __builtin_nontemporal_load((const f32x4*)(OG + (size_t)R * 512 + lane * 8 + 4));
          const u32x4 sb = __builtin_nontemporal_load((const u32x4*)(OGB + (size_t)R * 512 + lane * 8));
          float v[8] = {a.x + bflo(sb.x), a.y + bfhi(sb.x), a.z + bflo(sb.y), a.w + bfhi(sb.y), c.x + bflo(sb.z), c.y + bfhi(sb.z), c.z + bflo(sb.w), c.w + bfhi(sb.w)}; float ss = 0;
#pragma unroll
          for (int e = 0; e < 8; ++e) ss += v[e] * v[e];
          ss += __shfl_xor(ss, 1); ss += __shfl_xor(ss, 2); ss += __shfl_xor(ss, 4); ss += __shfl_xor(ss, 8);
          const float rs = rsqrtf(ss * (1.f / 128.f) + 1e-6f);
          const u32x4 z = __builtin_nontemporal_load((const u32x4*)(Z + prow * 512 + lane * 8)); const unsigned zz[4] = {z.x, z.y, z.z, z.w}; unsigned o[4];
#pragma unroll
          for (int e = 0; e < 4; ++e) o[e] = pk2(v[2 * e] * rs * gg[2 * e] * silu_f(bflo(zz[e])), v[2 * e + 1] * rs * gg[2 * e + 1] * silu_f(bfhi(zz[e])));
          *(u32x4*)(Y + (size_t)R * 1024 + lane * 8) = (u32x4){o[0], o[1], o[2], o[3]}; }
        { const f32x4 a = __builtin_nontemporal_load((const f32x4*)(ORp + (size_t)R * 512 + lane * 8)), c = __builtin_nontemporal_load((const f32x4*)(ORp + (size_t)R * 512 + lane * 8 + 4));
          const u32x4 sb = __builtin_nontemporal_load((const u32x4*)(ORB + (size_t)R * 512 + lane * 8));
          float v[8] = {a.x + bflo(sb.x), a.y + bfhi(sb.x), a.z + bflo(sb.y), a.w + bfhi(sb.y), c.x + bflo(sb.z), c.y + bfhi(sb.z), c.z + bflo(sb.w), c.w + bfhi(sb.w)}; float s = 0;
#pragma unroll
          for (int e = 0; e < 8; ++e) s += v[e];
          s += __shfl_xor(s, 1); s += __shfl_xor(s, 2); s += __shfl_xor(s, 4); s += __shfl_xor(s, 8);
          const float mu = s * (1.f / 128.f); float ss = 0;
#pragma unroll
          for (int e = 0; e < 8; ++e) { v[e] -= mu; ss += v[e] * v[e]; }
          ss += __shfl_xor(ss, 1); ss += __shfl_xor(ss, 2); ss += __shfl_xor(ss, 4); ss += __shfl_xor(ss, 8);
          const float rs = rsqrtf(ss * (1.f / 128.f) + 1e-6f);
          const u32x4 z = __builtin_nontemporal_load((const u32x4*)(RG + prow * 512 + lane * 8)); const unsigned zz[4] = {z.x, z.y, z.z, z.w}; unsigned o[4];
#pragma unroll
          for (int e = 0; e < 4; ++e) o[e] = pk2(v[2 * e] * rs * rg_[2 * e] * silu_f(bflo(zz[e])), v[2 * e + 1] * rs * rg_[2 * e + 1] * silu_f(bfhi(zz[e])));
          *(u32x4*)(Y + (size_t)R * 1024 + 512 + lane * 8) = (u32x4){o[0], o[1], o[2], o[3]}; }
    }
    __syncthreads();
    bf16_t* WoT = (bf16_t*)(p.ws + WS_WOUTT); bf16_t* WfiT = (bf16_t*)(p.ws + WS_WFIT); bf16_t* WfoT = (bf16_t*)(p.ws + WS_WFOT);
    if (gridDim.x == 256) {
        for (int jj = blockIdx.x; jj < 1408; jj += gridDim.x) { const int kt = jj & 15, nt = jj >> 4, n0 = nt * 64;
            const int pn = n0 >> 8, bj = (n0 >> 7) & 1, i = n0 & 127; transpose_item(p.w_ffn_in, 5632, kt * 64, bj * 2816 + pn * 128 + i, WfiT, 1024, n0, L); }
    } else
    for (int j = blockIdx.x; j < 256 + 1408 + 704; j += gridDim.x) {
        if (j < 256) { const int kt = j & 15, nt = j >> 4; transpose_item(p.w_out, 1024, kt * 64, nt * 64, WoT, 1024, nt * 64, L); }
        else if (j < 256 + 1408) { const int jj = j - 256, kt = jj & 15, nt = jj >> 4, n0 = nt * 64;
            const int pn = n0 >> 8, bj = (n0 >> 7) & 1, i = n0 & 127; transpose_item(p.w_ffn_in, 5632, kt * 64, bj * 2816 + pn * 128 + i, WfiT, 1024, n0, L); }
        else { const int jj = j - 256 - 1408, kt = jj % 44, nt = jj / 44; transpose_item(p.w_ffn_out, 1024, kt * 64, nt * 64, WfoT, 2816, nt * 64, L); }
    }
}

DI void phase_norm2(const Params& p) {
    const int tid = threadIdx.x, lane = tid & 63, w = tid >> 6;
    const float* X1 = (const float*)(p.ws + WS_X1); const float* MOD = (const float*)(p.ws + WS_MOD); bf16_t* A3 = (bf16_t*)(p.ws + WS_A3);
    const int nwv = gridDim.x * 8;
    for (int R0 = blockIdx.x * 8 + w; R0 < LROWS; R0 += 2 * nwv) {
        f32x4 v[2][4]; int Rr[2]; bool ok[2];
#pragma unroll
        for (int u = 0; u < 2; ++u) { const int R = R0 + u * nwv; ok[u] = R < LROWS; Rr[u] = ok[u] ? R : R0; const float* src = X1 + (size_t)Rr[u] * 1024;
#pragma unroll
            for (int i = 0; i < 4; ++i) v[u][i] = *(const f32x4*)(src + (lane + 64 * i) * 4); }
        float ss[2];
#pragma unroll
        for (int u = 0; u < 2; ++u) { ss[u] = 0;
#pragma unroll
            for (int i = 0; i < 4; ++i) ss[u] += v[u][i].x * v[u][i].x + v[u][i].y * v[u][i].y + v[u][i].z * v[u][i].z + v[u][i].w * v[u][i].w; }
        for (int o = 32; o; o >>= 1) { ss[0] += __shfl_xor(ss[0], o); ss[1] += __shfl_xor(ss[1], o); }
#pragma unroll
        for (int u = 0; u < 2; ++u) { const float rstd = rsqrtf(ss[u] * (1.f / 1024.f) + 1e-6f); const float* mod = MOD + (size_t)(Rr[u] >> 12) * 6144;
#pragma unroll
            for (int i = 0; i < 4; ++i) { const int k = (lane + 64 * i) * 4;
                const f32x4 g = *(const f32x4*)(p.norm_ffn_g + k), sh = *(const f32x4*)(mod + 3072 + k), sc = *(const f32x4*)(mod + 4096 + k);
                const f32x4 hh = v[u][i] * rstd * g * (sc + 1.f) + sh;
                u32x2 o; o.x = pk2(hh.x, hh.y); o.y = pk2(hh.z, hh.w); if (ok[u]) *(u32x2*)(A3 + (size_t)Rr[u] * 1024 + k) = o; } }
    }
}
DI void phase_final(const Params& p) {
    const float* SSF = (const float*)(p.ws + WS_SSF);
    const int nth = gridDim.x * NT;
#pragma unroll 1
    for (int c0 = blockIdx.x * NT + threadIdx.x; c0 < LROWS * 256; c0 += 8 * nth) {
        f32x4 v[8]; float rs[8];
#pragma unroll
        for (int u = 0; u < 8; ++u) { const int c = c0 + u * nth; v[u] = __builtin_nontemporal_load((const f32x4*)(p.out + (size_t)c * 4)); rs[u] = SSF[c >> 8]; }
#pragma unroll
        for (int u = 0; u < 8; ++u) { const int c = c0 + u * nth; const f32x4 g = *(const f32x4*)(p.final_g + (c & 255) * 4);
            __builtin_nontemporal_store(v[u] * rsqrtf(rs[u] * (1.f / 1024.f) + 1e-6f) * g, (f32x4*)(p.out + (size_t)c * 4)); }
    }
}

#define XB_TMO      128
#define XB_XCNT(j)  (256  + 64 * (j))
#define XB_XSUB(j)  (1280 + 64 * (j))
#define XB_XGEN(j)  (2304 + 64 * (j))
#define XB_TOP      3328
#define XB_TOPGEN   3392
#define XCD_BAR_WORDS 3456
#define XB_SPIN_CAP (1u << 18)

__device__ __forceinline__ unsigned xb_ld(unsigned* p)              { return __hip_atomic_load(p, __ATOMIC_RELAXED, __HIP_MEMORY_SCOPE_AGENT); }
__device__ __forceinline__ unsigned xb_add(unsigned* p, unsigned v) { return __hip_atomic_fetch_add(p, v, __ATOMIC_RELAXED, __HIP_MEMORY_SCOPE_AGENT); }
__device__ __forceinline__ unsigned xb_xcc_id() { return (unsigned)__builtin_amdgcn_s_getreg((3 << 11) | 20) & 0xFu; }
#define XB_SPIN(cond, bar) do { unsigned _sp = 0; while (cond) { __builtin_amdgcn_s_sleep(1); \
    if ((++_sp & 255u) == 0u) { if (xb_ld(&(bar)[XB_TMO])) break; if (_sp > XB_SPIN_CAP) { atomicAdd(&(bar)[XB_TMO], 1u); break; } } } } while (0)

struct XcdBarrier {
    unsigned* bar; unsigned x;
    volatile LAS unsigned* st;
};

__device__ __forceinline__ XcdBarrier xcd_barrier_post(unsigned* bar, volatile LAS unsigned* st) {
    XcdBarrier b; b.bar = bar; b.x = xb_xcc_id(); b.st = st;
    if (threadIdx.x == 0) (void)xb_add(&bar[XB_XCNT(b.x)], 1u);
    return b;
}
__device__ __forceinline__ void xcd_barrier_complete(unsigned* bar, unsigned x, unsigned& nloc, unsigned& nx) {
    const unsigned G = gridDim.x * gridDim.y * gridDim.z;
    unsigned sum, cnt, mine, sp = 0u;
    for (;;) {
        sum = 0u; cnt = 0u; mine = 0u;
#pragma unroll
        for (unsigned j = 0; j < 16; ++j) { const unsigned c = xb_ld(&bar[XB_XCNT(j)]); sum += c; cnt += (c > 0u) ? 1u : 0u; mine = (j == x) ? c : mine; }
        if (sum == G) break;
        __builtin_amdgcn_s_sleep(1);
        if ((++sp & 255u) == 0u) { if (xb_ld(&bar[XB_TMO])) break; if (sp > XB_SPIN_CAP) { atomicAdd(&bar[XB_TMO], 1u); break; } }
    }
    nloc = mine > 0u ? mine : 1u; nx = cnt > 0u ? cnt : 1u;
}

__device__ __forceinline__ void xcd_barrier(const XcdBarrier& b) {
    asm volatile("s_waitcnt vmcnt(0)" ::: "memory");
    __syncthreads();
    if (threadIdx.x == 0) {
        unsigned* bar = b.bar;
        __builtin_amdgcn_s_waitcnt(0);
        unsigned nloc = b.st[0], nx = b.st[1];
        if (nloc == 0u) { xcd_barrier_complete(bar, b.x, nloc, nx); b.st[0] = nloc; b.st[1] = nx; }
        const unsigned old = xb_add(&bar[XB_XSUB(b.x)], 1u);
        const unsigned gen = old / nloc;
        if (old + 1u == (gen + 1u) * nloc) {
            __builtin_amdgcn_fence(__ATOMIC_RELEASE, "agent");
            asm volatile("s_waitcnt vmcnt(0)" ::: "memory");
            const unsigned og = xb_add(&bar[XB_TOP], 1u);
            const unsigned tg = og / nx;
            if (og + 1u == (tg + 1u) * nx) xb_add(&bar[XB_TOPGEN], 1u);
            else XB_SPIN(xb_ld(&bar[XB_TOPGEN]) == tg, bar);
            __builtin_amdgcn_fence(__ATOMIC_ACQUIRE, "agent");
            xb_add(&bar[XB_XGEN(b.x)], 1u);
            asm volatile("s_waitcnt vmcnt(0)" ::: "memory");
        } else {
            XB_SPIN(xb_ld(&bar[XB_XGEN(b.x)]) == gen, bar);
            __builtin_amdgcn_fence(__ATOMIC_ACQUIRE, "agent");
            asm volatile("s_waitcnt vmcnt(0)" ::: "memory");
        }
    }
    __syncthreads();
}

#ifndef GEMM_ALIGN
#define GEMM_ALIGN true
#endif
#ifndef GEMM_SP2
#define GEMM_SP2 true
#endif
__global__ void __launch_bounds__(NT) mega_fwd(Params p) {
    extern __shared__ __attribute__((aligned(16))) unsigned char lds_raw[];
    ldsp L = (ldsp)lds_raw;
    cg::grid_group grid = cg::this_grid();
    const int lo = p.ph_lo, hi = p.ph_hi;
#ifndef PHMASK
#define PHMASK 0xFFF
#endif
#define IN(k) (((PHMASK >> (k)) & 1) && lo <= (k) && (k) < hi)
    volatile LAS unsigned* xst = (volatile LAS unsigned*)(L + 149000);
    if (threadIdx.x == 0) { xst[0] = 0u; xst[1] = 0u; }
    __syncthreads();
    if (p.pad == 0x5a5a) grid.sync();
    const XcdBarrier xbar = xcd_barrier_post((unsigned*)(p.ws + WS_BAR), xst);
#define SEAM(k) do { if ((k) + 1 < hi) xcd_barrier(xbar); } while (0)
#ifndef DUPMASK
#define DUPMASK 0
#endif
#define NREP(k) (((DUPMASK >> (k)) & 1) ? 2 : 1)
    if (IN(0)) { { phase0(p, L); __syncthreads(); } SEAM(0); }
    if (IN(1)) { { phase1(p, L); __syncthreads(); } SEAM(1); }
    if (IN(2)) { { pg8::Gemm g{(const bf16_t*)(p.ws + WS_A1), (const bf16_t*)(p.ws + WS_WINT), MROWS, N1, 1024}; pg8::StaticOrder S; S.init(MROWS, N1, gridDim.x, blockIdx.x);
        EpiP E{(bf16_t*)(p.ws + WS_P), (float*)(p.ws + WS_GATES)}; pg8::gemm_phase<EpiP, pg8::StaticOrder, GEMM_ALIGN, GEMM_SP2>(L, g, S, E); } SEAM(2); }
    if (IN(3)) { phase_conv(p); SEAM(3); }
    if (IN(4)) { { const bool dry = p.dry != 0;
        if (gridDim.x == 256) {
            const int bx = blockIdx.x;
            for (int it = bx; it < 1088; it += 256) prep_gdn(p, L, it, dry);
            if (bx < 64) { prep_ret(p, L, bx * 2, dry); prep_ret(p, L, bx * 2 + 1, dry); }
            else { for (int j = 0; j < 5; ++j) prep_ret(p, L, 128 + (bx - 64) * 5 + j, dry); }
        } else { for (int it = blockIdx.x; it < 2176; it += gridDim.x) { if (it < 1088) prep_gdn(p, L, it, dry); else prep_ret(p, L, it - 1088, dry); } } } SEAM(4); }
    if (IN(5)) { { const float osc = p.dry ? 0.f : 1.f; for (int bx = blockIdx.x; bx < 256; bx += gridDim.x) { const int xx = bx & 7, yy = bx >> 3, slice = yy & 3, G = (yy >> 2) * 8 + xx;
            const int ty = G >> 5, dir = G & 1, h = (G >> 1) & 3, b = (G >> 3) & 3;
            if (ty == 0) scan_gdn(p, L, b, h, dir, slice, osc); else scan_ret(p, L, b, h, dir, slice, osc); __syncthreads();
            if (ty == 1 && gridDim.x == 256) {
                bf16_t* WoT = (bf16_t*)(p.ws + WS_WOUTT); bf16_t* WfoT = (bf16_t*)(p.ws + WS_WFOT);
                for (int j = bx - 128; j < 960; j += 128) { if (j < 256) { const int kt = j & 15, nt = j >> 4; transpose_item(p.w_out, 1024, kt * 64, nt * 64, WoT, 1024, nt * 64, L); }
                    else { const int jj = j - 256, kt = jj % 44, nt = jj / 44; transpose_item(p.w_ffn_out, 1024, kt * 64, nt * 64, WfoT, 2816, nt * 64, L); } } } } } SEAM(5); }
    if (IN(6)) { { phase_postnorm(p, L); __syncthreads(); } SEAM(6); }
    if (IN(7)) { { pg8::Gemm g{(const bf16_t*)(p.ws + WS_Y), (const bf16_t*)(p.ws + WS_WOUTT), LROWS, 1024, 1024}; pg8::StaticOrder S; S.init(LROWS, 1024, gridDim.x, blockIdx.x);
        EpiRes2 E{(bf16_t*)(p.ws + WS_X1B), p.x, (const float*)(p.ws + WS_MOD), p.norm_ffn_g, (bf16_t*)(p.ws + WS_A3), (float*)(p.ws + WS_SS)}; pg8::gemm_phase<EpiRes2, pg8::StaticOrder, GEMM_ALIGN, GEMM_SP2>(L, g, S, E); } SEAM(7); }
    if (IN(9)) { { pg8::Gemm g{(const bf16_t*)(p.ws + WS_A3), (const bf16_t*)(p.ws + WS_WFIT), LROWS, 5632, 1024}; pg8::StaticOrder S; S.init(LROWS, 5632, gridDim.x, blockIdx.x);
        EpiGLU2 E{(bf16_t*)(p.ws + WS_H), (const float*)(p.ws + WS_SS), (const float*)(p.ws + WS_BIAS2)}; pg8::gemm_phase<EpiGLU2, pg8::StaticOrder, GEMM_ALIGN, GEMM_SP2>(L, g, S, E); } SEAM(9); }
    if (IN(10)) { { pg8::Gemm g{(const bf16_t*)(p.ws + WS_H), (const bf16_t*)(p.ws + WS_WFOT), LROWS, 1024, 2816}; pg8::StaticOrder S; S.init(LROWS, 1024, gridDim.x, blockIdx.x);
        EpiRes3 E{p.out, (const bf16_t*)(p.ws + WS_X1B), (const float*)(p.ws + WS_MOD) + 5120, (float*)(p.ws + WS_SSF)}; pg8::gemm_phase<EpiRes3, pg8::StaticOrder, GEMM_ALIGN, GEMM_SP2>(L, g, S, E); } SEAM(10); }
    if (IN(11)) { phase_final(p); }
}

extern "C" void kernel_launch(void* const* d_in, const int* in_sizes, int n_in, void* d_out, int out_size, void* d_ws, size_t ws_size, hipStream_t stream) {
    static int grid_blocks = 0;
    if (!grid_blocks) {
        int dev = 0, cus = 0, per_cu = 0;
        hipGetDevice(&dev);
        hipDeviceGetAttribute(&cus, hipDeviceAttributeMultiprocessorCount, dev);
        if (hipFuncSetAttribute((const void*)mega_fwd, hipFuncAttributeMaxDynamicSharedMemorySize, LDS_BYTES) != hipSuccess) fprintf(stderr, "hipFuncSetAttribute failed\n");
        hipOccupancyMaxActiveBlocksPerMultiprocessor(&per_cu, (const void*)mega_fwd, NT, LDS_BYTES);
        if (per_cu < 1) per_cu = 1;
        grid_blocks = cus * per_cu;
        if (grid_blocks > 256) grid_blocks = 256;
    }
#ifndef PROBE_SEQ
#define PROBE_SEQ {0, 12, 0}
#endif
    static const int seq[][3] = {PROBE_SEQ};
    hipError_t e = hipSuccess;
    for (unsigned li = 0; li < sizeof(seq) / sizeof(seq[0]); ++li) {
        Params p{};
        const float** f = (const float**)&p;
        for (int i = 0; i < 19; ++i) f[i] = (const float*)d_in[i];
        p.out = (float*)d_out; p.ws = (unsigned char*)d_ws; p.ph_lo = seq[li][0]; p.ph_hi = seq[li][1]; p.dry = seq[li][2]; p.pad = 0;
        void* args[] = {&p};
        if (hipMemsetAsync((unsigned char*)d_ws + WS_BAR, 0, 3456 * 4, stream) != hipSuccess) fprintf(stderr, "barrier memset failed\n");
        e = hipLaunchCooperativeKernel((const void*)mega_fwd, dim3(grid_blocks), dim3(NT), args, LDS_BYTES, stream);
        if (e != hipSuccess) break;
    }
    if (e != hipSuccess) fprintf(stderr, "cooperative launch failed: %s (grid %d)\n", hipGetErrorString(e), grid_blocks);
}
```

```cpp
#include <hip/hip_runtime.h>
#include <hip/hip_cooperative_groups.h>
#include <cstdio>
namespace cg = cooperative_groups;
namespace pg8 {
#define PG8_LAS __attribute__((address_space(3)))
typedef unsigned short bf16_t;
typedef short bf16x8 __attribute__((ext_vector_type(8)));
typedef float f32x4 __attribute__((ext_vector_type(4)));
typedef unsigned u32x4 __attribute__((ext_vector_type(4)));
constexpr int BM = 256, BK = 64, HALF = 128, HTB = HALF * BK * 2  , STAGE_BYTES = 8 * HTB, NXCD = 8, WGM = 8;

__host__ __device__ __forceinline__ int lds_byte(int r, int c) { const int st = (r >> 4) * 2 + (c >> 5), rr = r & 15, cc = c & 31, ob = rr * 64 + cc * 2; return st * 1024 + (ob ^ (((ob >> 9) & 1) << 5)); }
__host__ __device__ __forceinline__ void stage_rc(int b, int& R, int& C) { const int st = b / 1024, sb = b % 1024, swz = sb ^ (((sb >> 9) & 1) << 5); R = (st >> 1) * 16 + swz / 64; C = (st & 1) * 32 + (swz % 64) / 2; }
__host__ __device__ __forceinline__ int perm32(int rho) { const int n = rho >> 4, i = rho & 15; return 8 * (i >> 2) + 4 * n + (i & 3); }

struct Unit { int pm, pn; };
struct Gemm { const bf16_t* A; const bf16_t* Bt; int M, N, K; };

struct StaticOrder {
    int nM, nN, nwg, G, c;
    __host__ __device__ void init(int M, int N, int G_, int c_) { nM = M / BM; nN = N / BM; nwg = nM * nN; G = G_; c = c_; }
    __host__ __device__ bool next(int i, Unit& u) const {
        const long L = (long)i * G + c; if (L >= nwg) return false;
        int wgid = (int)L; { const int q = nwg / NXCD, r = nwg % NXCD, xcd = wgid % NXCD, off = wgid / NXCD; wgid = (xcd < r ? xcd * (q + 1) : r * (q + 1) + (xcd - r) * q) + off; }
        const int nig = WGM * nN, gid = wgid / nig, fm = gid * WGM, gsz = (nM - fm) < WGM ? (nM - fm) : WGM;
        u.pm = fm + ((wgid % nig) % gsz); u.pn = (wgid % nig) / gsz; return true;
    }
    __device__ __forceinline__ void a_ready(const Unit&) const {}
    __device__ __forceinline__ void done(const Unit&) const {}
};

__device__ __forceinline__ unsigned cvt_pk_bf16(float lo, float hi) { unsigned r; asm volatile("v_cvt_pk_bf16_f32 %0, %1, %2" : "=v"(r) : "v"(lo), "v"(hi)); return r; }
template <class Epi, class Sched, bool ALIGN_EPI = false, bool SP2 = false>
__device__ __forceinline__ void gemm_phase(PG8_LAS unsigned char* lds, const Gemm g, const Sched& S, const Epi& E) {
    const int tid = threadIdx.x, wid = __builtin_amdgcn_readfirstlane(tid >> 6), lane = tid & 63, wr = wid >> 2, wc = wid & 3, fr = lane & 15, fq = lane >> 4;
    const int K = g.K, nt = K / BK;
    unsigned voffA[2], voffB[2];
#pragma unroll
    for (int i = 0; i < 2; ++i) { int R, C; stage_rc(tid * 16 + i * 8192, R, C); const int Rb = Epi::PERM ? ((R & ~31) + perm32(R & 31)) : R;
        voffA[i] = (unsigned)(R * K + C) * 2u; voffB[i] = (unsigned)(Rb * K + C) * 2u; }
    const size_t kstep = (size_t)(BK * 2);
    const size_t hstep = (size_t)HALF * K * 2;
    const size_t tstep = 2 * hstep;
    const unsigned ldsw = (unsigned)wid * 1024u;
    const int aoff = lds_byte(wr * 64 + fr, fq * 8), boff = lds_byte(wc * 32 + fr, fq * 8);
#define PG8_SA(b, h) (((b) * 2 + (h)) * HTB)
#define PG8_SB(b, h) ((4 + (b) * 2 + (h)) * HTB)
#define PG8_STAGE(bufoff, gbase, voff) do { _Pragma("unroll") for (int _i = 0; _i < 2; ++_i) \
        __builtin_amdgcn_global_load_lds((const unsigned*)((const char*)(gbase) + (voff)[_i]), (PG8_LAS unsigned*)(lds + (bufoff) + ldsw + _i * 8192), 16, 0, 0); } while (0)
#define PG8_LDA(dst, b, h) do { _Pragma("unroll") for (int m = 0; m < 4; ++m) _Pragma("unroll") for (int k = 0; k < 2; ++k) dst[m][k] = *(const PG8_LAS bf16x8*)(lds + PG8_SA(b, h) + aoff + m * 2048 + k * 1024); } while (0)
#define PG8_LDB(dst, b, h) do { _Pragma("unroll") for (int n = 0; n < 2; ++n) _Pragma("unroll") for (int k = 0; k < 2; ++k) dst[n][k] = *(const PG8_LAS bf16x8*)(lds + PG8_SB(b, h) + boff + n * 2048 + k * 1024); } while (0)
#define PG8_MMA(ai, bj, At, Bt) do { __builtin_amdgcn_s_setprio(1); _Pragma("unroll") for (int m = 0; m < 4; ++m) _Pragma("unroll") for (int n = 0; n < 2; ++n) _Pragma("unroll") for (int k = 0; k < 2; ++k) \
        acc[ai][bj][m][n] = __builtin_amdgcn_mfma_f32_16x16x32_bf16(Bt[n][k], At[m][k], acc[ai][bj][m][n], 0, 0, 0); __builtin_amdgcn_s_setprio(0); } while (0)
#define PG8_WAIT_V(n) asm volatile("s_waitcnt vmcnt(" #n ")" ::: "memory")
#define PG8_WAIT_L(n) asm volatile("s_waitcnt lgkmcnt(" #n ")" ::: "memory")
#define PG8_BAR __builtin_amdgcn_s_barrier()
#define PG8_SCHED __builtin_amdgcn_sched_barrier(0)
    Unit cur, nxt; int ui = 0;
    if (!S.next(0, cur)) return;
    f32x4 acc[2][2][4][2];
#pragma unroll
    for (int a = 0; a < 2; ++a)
#pragma unroll
        for (int b = 0; b < 2; ++b)
#pragma unroll
            for (int m = 0; m < 4; ++m)
#pragma unroll
                for (int n = 0; n < 2; ++n) acc[a][b][m][n] = (f32x4){0.f, 0.f, 0.f, 0.f};
    bf16x8 At[4][2], B0[2][2], B1[2][2];
    const char* cA = (const char*)g.A + (size_t)cur.pm * tstep; const char* cB = (const char*)g.Bt + (size_t)cur.pn * tstep;
    S.a_ready(cur);
    if constexpr (SP2) {
        PG8_STAGE(PG8_SB(0, 0), cB, voffB); PG8_STAGE(PG8_SB(0, 1), cB + hstep, voffB); PG8_STAGE(PG8_SA(0, 0), cA, voffA); PG8_STAGE(PG8_SA(0, 1), cA + hstep, voffA);
        if (wr == 1) PG8_BAR;
        PG8_WAIT_V(2); PG8_BAR;
        PG8_STAGE(PG8_SB(1, 0), cB + kstep, voffB); PG8_STAGE(PG8_SA(1, 0), cA + kstep, voffA); PG8_STAGE(PG8_SB(1, 1), cB + hstep + kstep, voffB);
        PG8_WAIT_V(6); PG8_BAR;
    } else {
        PG8_STAGE(PG8_SB(0, 0), cB, voffB); PG8_STAGE(PG8_SA(0, 0), cA, voffA); PG8_STAGE(PG8_SB(0, 1), cB + hstep, voffB); PG8_STAGE(PG8_SA(0, 1), cA + hstep, voffA);
        if (wr == 1) PG8_BAR;
        PG8_WAIT_V(4); PG8_BAR;
        PG8_STAGE(PG8_SB(1, 0), cB + kstep, voffB); PG8_STAGE(PG8_SA(1, 0), cA + kstep, voffA); PG8_STAGE(PG8_SB(1, 1), cB + hstep + kstep, voffB);
        PG8_WAIT_V(6); PG8_BAR;
    }
    for (;;) {
        const bool has_next = S.next(ui + 1, nxt);
        const char* nA = has_next ? (const char*)g.A + (size_t)nxt.pm * tstep : cA; const char* nB = has_next ? (const char*)g.Bt + (size_t)nxt.pn * tstep : cB;
        for (int t = 0; t < nt; t += 2) {
            const bool last = (t == nt - 2);
            const char* a1 = cA + (size_t)(t + 1) * kstep;
            const char* a2 = last ? nA : cA + (size_t)(t + 2) * kstep; const char* b2 = last ? nB : cB + (size_t)(t + 2) * kstep;
            const char* a3 = a2 + kstep; const char* b3 = b2 + kstep;
            if (last && has_next) S.a_ready(nxt);
            if constexpr (SP2) {
            PG8_LDB(B0, 0, 0); PG8_LDB(B1, 0, 1); PG8_SCHED; PG8_LDA(At, 0, 0); PG8_STAGE(PG8_SA(1, 1), a1 + hstep, voffA);
            PG8_WAIT_V(8); PG8_WAIT_L(0); PG8_BAR; PG8_MMA(0, 0, At, B0); PG8_MMA(0, 1, At, B1); PG8_BAR; PG8_SCHED;
            PG8_LDA(At, 0, 1); PG8_STAGE(PG8_SB(0, 0), b2, voffB); PG8_STAGE(PG8_SB(0, 1), b2 + hstep, voffB); PG8_STAGE(PG8_SA(0, 0), a2, voffA);
            PG8_WAIT_V(8); PG8_WAIT_L(0); PG8_BAR; PG8_MMA(1, 0, At, B0); PG8_MMA(1, 1, At, B1); PG8_BAR; PG8_SCHED;
            PG8_LDB(B0, 1, 0); PG8_LDB(B1, 1, 1); PG8_SCHED; PG8_LDA(At, 1, 0); PG8_STAGE(PG8_SA(0, 1), a2 + hstep, voffA);
            PG8_WAIT_V(8); PG8_WAIT_L(0); PG8_BAR; PG8_MMA(0, 0, At, B0); PG8_MMA(0, 1, At, B1); PG8_BAR; PG8_SCHED;
            PG8_LDA(At, 1, 1); PG8_STAGE(PG8_SB(1, 0), b3, voffB); PG8_STAGE(PG8_SB(1, 1), b3 + hstep, voffB); PG8_STAGE(PG8_SA(1, 0), a3, voffA);
            PG8_WAIT_V(8); PG8_WAIT_L(0); PG8_BAR; PG8_MMA(1, 0, At, B0); PG8_MMA(1, 1, At, B1); PG8_BAR; PG8_SCHED;
            } else {
            PG8_LDB(B0, 0, 0); PG8_SCHED; PG8_LDA(At, 0, 0); PG8_STAGE(PG8_SA(1, 1), a1 + hstep, voffA);
            PG8_WAIT_L(8); PG8_BAR; PG8_WAIT_L(0); PG8_MMA(0, 0, At, B0); PG8_BAR; PG8_SCHED;
            PG8_LDB(B1, 0, 1); PG8_STAGE(PG8_SB(0, 0), b2, voffB);
            PG8_BAR; PG8_WAIT_L(0); PG8_MMA(0, 1, At, B1); PG8_BAR;
            PG8_LDA(At, 0, 1); PG8_STAGE(PG8_SA(0, 0), a2, voffA);
            PG8_BAR; PG8_WAIT_L(0); PG8_MMA(1, 0, At, B0); PG8_BAR; PG8_SCHED;
            PG8_STAGE(PG8_SB(0, 1), b2 + hstep, voffB);
            PG8_WAIT_V(6); PG8_BAR; PG8_MMA(1, 1, At, B1); PG8_BAR;
            PG8_LDB(B0, 1, 0); PG8_SCHED; PG8_LDA(At, 1, 0); PG8_STAGE(PG8_SA(0, 1), a2 + hstep, voffA);
            PG8_WAIT_L(8); PG8_BAR; PG8_WAIT_L(0); PG8_MMA(0, 0, At, B0); PG8_BAR; PG8_SCHED;
            PG8_LDB(B1, 1, 1); PG8_STAGE(PG8_SB(1, 0), b3, voffB);
            PG8_BAR; PG8_WAIT_L(0); PG8_MMA(0, 1, At, B1); PG8_BAR;
            PG8_LDA(At, 1, 1); PG8_STAGE(PG8_SA(1, 0), a3, voffA);
            PG8_BAR; PG8_WAIT_L(0); PG8_MMA(1, 0, At, B0); PG8_BAR; PG8_SCHED;
            PG8_STAGE(PG8_SB(1, 1), b3 + hstep, voffB);
            PG8_WAIT_V(6); PG8_BAR; PG8_MMA(1, 1, At, B1); PG8_BAR;
            }
        }
        if constexpr (ALIGN_EPI) { if (wr == 0) PG8_BAR; }
        if constexpr (!Epi::AFTER_DRAIN) { E(acc, cur, wr, wc, fr, fq); S.done(cur); }
        if (!has_next) break;
#pragma unroll
        for (int a = 0; a < 2; ++a)
#pragma unroll
            for (int b = 0; b < 2; ++b)
#pragma unroll
                for (int m = 0; m < 4; ++m)
#pragma unroll
                    for (int n = 0; n < 2; ++n) acc[a][b][m][n] = (f32x4){0.f, 0.f, 0.f, 0.f};
        cur = nxt; cA = nA; cB = nB; ++ui;
        if constexpr (ALIGN_EPI) { if (wr == 1) PG8_BAR; }
    }
    PG8_WAIT_V(0);
    if constexpr (!ALIGN_EPI) { if (wr == 0) PG8_BAR; }
    PG8_BAR;
    if constexpr (Epi::AFTER_DRAIN) { E.fused(acc, cur, wr, wc, fr, fq, lds, wid, lane); S.done(cur); }
#undef PG8_SA
#undef PG8_SB
#undef PG8_STAGE
#undef PG8_LDA
#undef PG8_LDB
#undef PG8_MMA
#undef PG8_WAIT_V
#undef PG8_WAIT_L
#undef PG8_BAR
#undef PG8_SCHED
}
}

#define DI __device__ __forceinline__
#define LAS __attribute__((address_space(3)))
typedef LAS unsigned char* ldsp;
typedef unsigned short bf16_t;
typedef short bf16x8 __attribute__((ext_vector_type(8)));
typedef float f32x4 __attribute__((ext_vector_type(4)));
typedef unsigned u32x4 __attribute__((ext_vector_type(4)));
typedef unsigned u32x2 __attribute__((ext_vector_type(2)));
#define MFMA16(a, b, c) __builtin_amdgcn_mfma_f32_16x16x32_bf16((a), (b), (c), 0, 0, 0)

constexpr int NT = 512;
constexpr int TT = 4352, MROWS = 17408, LROWS = 16384;
constexpr size_t MiB = (size_t)1 << 20;
constexpr size_t PBUF = 17 * MiB;
constexpr int LDS_BYTES = 149504;
constexpr size_t WS_MOD = 0, WS_GATES = 256 * 1024, WS_SS = 2 * MiB, WS_BIAS2 = 2 * MiB + 256 * 1024, WS_SSF = 2 * MiB + 512 * 1024, WS_BAR = 3 * MiB;
constexpr size_t WS_WINT = 3 * MiB + 512 * 1024, WS_A1 = 12 * MiB, WS_P = 46 * MiB;
constexpr int N1 = 4352;
constexpr size_t WS_QP = WS_P, WS_KP = WS_P + PBUF, WS_VP = WS_P + 2 * PBUF, WS_Z = WS_P + 3 * PBUF, WS_RQ = WS_P + 4 * PBUF, WS_RK = WS_P + 5 * PBUF, WS_RV = WS_P + 6 * PBUF, WS_RG = WS_P + 7 * PBUF;
constexpr size_t WS_QC = 4 * MiB, WS_KC = 21 * MiB, WS_VC = 182 * MiB;
constexpr size_t WS_WF = 46 * MiB, WS_UF = 63 * MiB, WS_QF = 80 * MiB, WS_WB = 199 * MiB, WS_UB = 216 * MiB, WS_QB = 233 * MiB;
constexpr size_t WS_DEC = 250 * MiB;
constexpr size_t WS_Y = 199 * MiB, WS_WOUTT = 38 * MiB, WS_WFOT = 40 * MiB, WS_WFIT = 49 * MiB;
constexpr size_t WS_X1B = 4 * MiB;
constexpr size_t WS_OGB = 4 * MiB, WS_ORB = 182 * MiB;
constexpr size_t WS_X1 = 182 * MiB, WS_A3 = 60 * MiB, WS_H = 92 * MiB;

struct Params {
    const float *x, *c, *ctx, *c_ctx, *ada_w, *ada_b, *norm_mix_g, *norm_ffn_g, *w_in, *conv_w, *a_log, *dt_bias, *gdn_norm_g, *ret_logit, *ret_norm_g, *w_out, *w_ffn_in, *w_ffn_out, *final_g;
    float* out; unsigned char* ws; int ph_lo, ph_hi, dry, pad;
};

DI unsigned short f2bf(float f) { unsigned u = __float_as_uint(f); return (unsigned short)((u + 0x7fffu + ((u >> 16) & 1u)) >> 16); }
DI float bf2f(unsigned v) { return __uint_as_float(v << 16); }
typedef float f32x2_t __attribute__((ext_vector_type(2)));
typedef __bf16 bf16x2_t __attribute__((ext_vector_type(2)));
DI unsigned pk2(float lo, float hi) { const f32x2_t v = {lo, hi}; const bf16x2_t b = __builtin_convertvector(v, bf16x2_t); return __builtin_bit_cast(unsigned, b); }
DI float bflo(unsigned v) { return __uint_as_float(v << 16); }
DI float bfhi(unsigned v) { return __uint_as_float(v & 0xffff0000u); }
DI float silu_f(float x) { return x * __builtin_amdgcn_rcpf(1.f + __expf(-x)); }
DI float sigm_f(float x) { return __builtin_amdgcn_rcpf(1.f + __expf(-x)); }
DI float softplus_f(float x) { return fmaxf(x, 0.f) + log1pf(__expf(-fabsf(x))); }
DI float wave_sum(float v) { for (int o = 32; o; o >>= 1) v += __shfl_xor(v, o); return v; }
DI bf16x8 lds16(ldsp p) { return *(const LAS bf16x8*)p; }
DI void lds_barrier() { asm volatile("s_waitcnt lgkmcnt(0)\n\ts_barrier" ::: "memory"); }

DI void transpose_item(const float* W, int ldw, int k0, int srccol0, bf16_t* WT, int Kdim, int nout0, ldsp L) {
    const int tid = threadIdx.x;
    LAS float* scr = (LAS float*)L;
    for (int e = tid; e < 4096; e += NT) { const int kk = e >> 6, cc = e & 63; scr[kk * 65 + cc] = W[(size_t)(k0 + kk) * ldw + srccol0 + cc]; }
    __syncthreads();
    { const int n = tid >> 3, k8 = (tid & 7) * 8; u32x4 o;
      o.x = pk2(scr[(k8 + 0) * 65 + n], scr[(k8 + 1) * 65 + n]); o.y = pk2(scr[(k8 + 2) * 65 + n], scr[(k8 + 3) * 65 + n]);
      o.z = pk2(scr[(k8 + 4) * 65 + n], scr[(k8 + 5) * 65 + n]); o.w = pk2(scr[(k8 + 6) * 65 + n], scr[(k8 + 7) * 65 + n]);
      *(u32x4*)(WT + (size_t)(nout0 + n) * Kdim + k0 + k8) = o; }
    __syncthreads();
}

struct TD { const float* W; int ldw, k0, src; bf16_t* WT; int Kd, n0; bool on; };
DI void transpose2(const TD a, const TD b, ldsp L) {
    const int tid = threadIdx.x;
    LAS float* sa = (LAS float*)L; LAS float* sb = sa + 64 * 65;
    float va[8], vb[8];
#pragma unroll
    for (int i = 0; i < 8; ++i) { const int e = tid + i * NT, kk = e >> 6, cc = e & 63;
        va[i] = a.W[(size_t)(a.k0 + kk) * a.ldw + a.src + cc]; vb[i] = b.on ? b.W[(size_t)(b.k0 + kk) * b.ldw + b.src + cc] : 0.f; }
#pragma unroll
    for (int i = 0; i < 8; ++i) { const int e = tid + i * NT, kk = e >> 6, cc = e & 63; sa[kk * 65 + cc] = va[i]; sb[kk * 65 + cc] = vb[i]; }
    __syncthreads();
    { const int n = tid >> 3, k8 = (tid & 7) * 8; u32x4 o;
      o.x = pk2(sa[(k8 + 0) * 65 + n], sa[(k8 + 1) * 65 + n]); o.y = pk2(sa[(k8 + 2) * 65 + n], sa[(k8 + 3) * 65 + n]); o.z = pk2(sa[(k8 + 4) * 65 + n], sa[(k8 + 5) * 65 + n]); o.w = pk2(sa[(k8 + 6) * 65 + n], sa[(k8 + 7) * 65 + n]);
      *(u32x4*)(a.WT + (size_t)(a.n0 + n) * a.Kd + a.k0 + k8) = o;
      if (b.on) { o.x = pk2(sb[(k8 + 0) * 65 + n], sb[(k8 + 1) * 65 + n]); o.y = pk2(sb[(k8 + 2) * 65 + n], sb[(k8 + 3) * 65 + n]); o.z = pk2(sb[(k8 + 4) * 65 + n], sb[(k8 + 5) * 65 + n]); o.w = pk2(sb[(k8 + 6) * 65 + n], sb[(k8 + 7) * 65 + n]);
          *(u32x4*)(b.WT + (size_t)(b.n0 + n) * b.Kd + b.k0 + k8) = o; } }
    __syncthreads();
}
DI void phase0(const Params& p, ldsp L) {
    const int tid = threadIdx.x;
    float* MOD = (float*)(p.ws + WS_MOD);
    if (blockIdx.x < 192) {
        LAS float* sc = (LAS float*)L; LAS float* red = sc + 5120;
        for (int e = tid; e < 5120; e += NT) { const int r = e >> 10, k = e & 1023; const float v = r < 4 ? p.c[r * 1024 + k] : p.c_ctx[k]; sc[e] = silu_f(v); }
        __syncthreads();
        for (int it = blockIdx.x; it < 192; it += gridDim.x) {
            const int cl = tid & 31, kg = tid >> 5, col = it * 32 + cl;
            float a0 = 0, a1 = 0, a2 = 0, a3 = 0, a4 = 0;
#pragma unroll 64
            for (int k = kg * 64; k < kg * 64 + 64; ++k) { const float w = p.ada_w[(size_t)k * 6144 + col]; a0 += sc[k] * w; a1 += sc[1024 + k] * w; a2 += sc[2048 + k] * w; a3 += sc[3072 + k] * w; a4 += sc[4096 + k] * w; }
            red[(kg * 5 + 0) * 32 + cl] = a0; red[(kg * 5 + 1) * 32 + cl] = a1; red[(kg * 5 + 2) * 32 + cl] = a2; red[(kg * 5 + 3) * 32 + cl] = a3; red[(kg * 5 + 4) * 32 + cl] = a4;
            __syncthreads();
            if (tid < 160) { const int r = tid >> 5; float s = 0; for (int g = 0; g < 16; ++g) s += red[(g * 5 + r) * 32 + cl]; MOD[r * 6144 + col] = s + p.ada_b[col]; }
            __syncthreads();
        }
    }
    { unsigned* zw = (unsigned*)(p.ws + WS_WINT + (size_t)4160 * 2048); for (int e = blockIdx.x * NT + tid; e < 192 * 512; e += gridDim.x * NT) zw[e] = 0u; }
    { float* zs = (float*)(p.ws + WS_SS); float* zf = (float*)(p.ws + WS_SSF); for (int e = blockIdx.x * NT + tid; e < 16384; e += gridDim.x * NT) { zs[e] = 0.f; zf[e] = 0.f; }
      float* zb = (float*)(p.ws + WS_BIAS2); for (int e = blockIdx.x * NT + tid; e < 4 * 5632; e += gridDim.x * NT) zb[e] = 0.f; }
}

DI void phase1(const Params& p, ldsp L) {
    const int tid = threadIdx.x, lane = tid & 63, w = tid >> 6;
    const float* MOD = (const float*)(p.ws + WS_MOD);
    bf16_t* A1 = (bf16_t*)(p.ws + WS_A1);
    const int nwv = gridDim.x * 8;
    for (int R0 = blockIdx.x * 8 + w; R0 < MROWS; R0 += 2 * nwv) {
        f32x4 v[2][4]; const float* mod[2]; int Rr[2]; bool ok[2];
#pragma unroll
        for (int u = 0; u < 2; ++u) { const int R = R0 + u * nwv; ok[u] = R < MROWS; const int Rc = ok[u] ? R : R0; Rr[u] = Rc; const int b = Rc / TT, t = Rc % TT;
            const float* src = t < 256 ? p.ctx + ((size_t)b * 256 + t) * 1024 : p.x + ((size_t)b * 4096 + (t - 256)) * 1024; mod[u] = MOD + (t < 256 ? 4 : b) * 6144;
#pragma unroll
            for (int i = 0; i < 4; ++i) v[u][i] = __builtin_nontemporal_load((const f32x4*)(src + (lane + 64 * i) * 4)); }
        float ss[2];
#pragma unroll
        for (int u = 0; u < 2; ++u) { ss[u] = 0;
#pragma unroll
            for (int i = 0; i < 4; ++i) ss[u] += v[u][i].x * v[u][i].x + v[u][i].y * v[u][i].y + v[u][i].z * v[u][i].z + v[u][i].w * v[u][i].w; }
        for (int o = 32; o; o >>= 1) { ss[0] += __shfl_xor(ss[0], o); ss[1] += __shfl_xor(ss[1], o); }
#pragma unroll
        for (int u = 0; u < 2; ++u) { const float rstd = rsqrtf(ss[u] * (1.f / 1024.f) + 1e-6f);
#pragma unroll
            for (int i = 0; i < 4; ++i) { const int k = (lane + 64 * i) * 4;
                const f32x4 g = *(const f32x4*)(p.norm_mix_g + k), sh = *(const f32x4*)(mod[u] + k), sc = *(const f32x4*)(mod[u] + 1024 + k);
                v[u][i] = v[u][i] * rstd * g * (sc + 1.f) + sh;
                u32x2 o; o.x = pk2(v[u][i].x, v[u][i].y); o.y = pk2(v[u][i].z, v[u][i].w); if (ok[u]) *(u32x2*)(A1 + (size_t)Rr[u] * 1024 + k) = o; } }
    }
    { float* BIAS2 = (float*)(p.ws + WS_BIAS2);
      for (int it = blockIdx.x; it < 176; it += gridDim.x) { const int n = (it % 11) * 512 + tid, k0 = (it / 11) * 64; float a0 = 0, a1 = 0, a2 = 0, a3 = 0;
#pragma unroll 16
          for (int k = k0; k < k0 + 64; ++k) { const float wv = p.w_ffn_in[(size_t)k * 5632 + n]; a0 += MOD[3072 + k] * wv; a1 += MOD[6144 + 3072 + k] * wv; a2 += MOD[2 * 6144 + 3072 + k] * wv; a3 += MOD[3 * 6144 + 3072 + k] * wv; }
          unsafeAtomicAdd(BIAS2 + n, a0); unsafeAtomicAdd(BIAS2 + 5632 + n, a1); unsafeAtomicAdd(BIAS2 + 2 * 5632 + n, a2); unsafeAtomicAdd(BIAS2 + 3 * 5632 + n, a3); } }
    { bf16_t* WinT = (bf16_t*)(p.ws + WS_WINT);
      for (int j = blockIdx.x; j < 1040; j += 2 * gridDim.x) { TD d[2];
#pragma unroll
          for (int u = 0; u < 2; ++u) { const int jj = j + u * gridDim.x, jc = jj < 1040 ? jj : j, kt = jc & 15, nt = jc >> 4, n0 = nt * 64;
              d[u] = TD{p.w_in, 4112, kt * 64, nt == 64 ? 2048 : (n0 < 2048 ? n0 : n0 + 16), WinT, 1024, n0, jj < 1040}; }
          transpose2(d[0], d[1], L); } }
}

struct EpiP {
    static constexpr bool PERM = true, AFTER_DRAIN = false;
    bf16_t* O; float* gates;
    DI void operator()(const f32x4 (&acc)[2][2][4][2], const pg8::Unit& u, int wr, int wc, int fr, int fq) const {
        if (u.pn == 16) {
            if (wc == 0 && fq < 2) { const int r0 = u.pm * 256 + wr * 64 + fr;
#pragma unroll
                for (int ai = 0; ai < 2; ++ai)
#pragma unroll
                    for (int m = 0; m < 4; ++m)
#pragma unroll
                        for (int n = 0; n < 2; ++n) *(f32x4*)(gates + (size_t)(r0 + ai * 128 + m * 16) * 16 + 8 * fq + 4 * n) = acc[ai][0][m][n]; }
            return; }
        const int row0 = u.pm * 256 + wr * 64 + fr; int colt = u.pn * 256; const int t = colt >> 9; bf16_t* base = O + (size_t)t * (PBUF / 2); colt -= t * 512;
        const int col0 = colt + wc * 32 + 8 * fq;
#pragma unroll
        for (int ai = 0; ai < 2; ++ai)
#pragma unroll
            for (int m = 0; m < 4; ++m) { bf16_t* rowp = base + (size_t)(row0 + ai * 128 + m * 16) * 512 + col0;
#pragma unroll
                for (int bj = 0; bj < 2; ++bj) { const f32x4 v0 = acc[ai][bj][m][0], v1 = acc[ai][bj][m][1]; u32x4 o;
                    o.x = pg8::cvt_pk_bf16(v0[0], v0[1]); o.y = pg8::cvt_pk_bf16(v0[2], v0[3]); o.z = pg8::cvt_pk_bf16(v1[0], v1[1]); o.w = pg8::cvt_pk_bf16(v1[2], v1[3]);
                    *(u32x4*)(rowp + bj * 128) = o; } }
    }
};
struct EpiRes {
    static constexpr bool PERM = false, AFTER_DRAIN = false;
    float* out; const float* res; const float* gate;
    DI void operator()(const f32x4 (&acc)[2][2][4][2], const pg8::Unit& u, int wr, int wc, int fr, int fq) const {
        const int row0 = u.pm * 256 + wr * 64 + fr, col0 = u.pn * 256 + wc * 32 + 4 * fq;
        const float* gp = gate + (size_t)(row0 >> 12) * 6144 + col0;
        f32x4 gv[2][2];
#pragma unroll
        for (int bj = 0; bj < 2; ++bj)
#pragma unroll
            for (int n = 0; n < 2; ++n) gv[bj][n] = *(const f32x4*)(gp + bj * 128 + n * 16);
#pragma unroll
        for (int ai = 0; ai < 2; ++ai)
#pragma unroll
            for (int m = 0; m < 4; ++m) { const size_t ro = (size_t)(row0 + ai * 128 + m * 16) * 1024 + col0;
#pragma unroll
                for (int bj = 0; bj < 2; ++bj)
#pragma unroll
                    for (int n = 0; n < 2; ++n) { const f32x4 r = *(const f32x4*)(res + ro + bj * 128 + n * 16); *(f32x4*)(out + ro + bj * 128 + n * 16) = r + gv[bj][n] * acc[ai][bj][m][n]; } }
    }
};
struct EpiGLU {
    static constexpr bool PERM = true, AFTER_DRAIN = false;
    bf16_t* H;
    DI void operator()(const f32x4 (&acc)[2][2][4][2], const pg8::Unit& u, int wr, int wc, int fr, int fq) const {
        const int row0 = u.pm * 256 + wr * 64 + fr, col0 = u.pn * 128 + wc * 32 + 8 * fq;
#pragma unroll
        for (int ai = 0; ai < 2; ++ai)
#pragma unroll
            for (int m = 0; m < 4; ++m) { bf16_t* rowp = H + (size_t)(row0 + ai * 128 + m * 16) * 2816 + col0;
                const f32x4 g0 = acc[ai][0][m][0], g1 = acc[ai][0][m][1], u0 = acc[ai][1][m][0], u1 = acc[ai][1][m][1]; u32x4 o;
                o.x = pg8::cvt_pk_bf16(silu_f(g0[0]) * u0[0], silu_f(g0[1]) * u0[1]); o.y = pg8::cvt_pk_bf16(silu_f(g0[2]) * u0[2], silu_f(g0[3]) * u0[3]);
                o.z = pg8::cvt_pk_bf16(silu_f(g1[0]) * u1[0], silu_f(g1[1]) * u1[1]); o.w = pg8::cvt_pk_bf16(silu_f(g1[2]) * u1[2], silu_f(g1[3]) * u1[3]);
                *(u32x4*)rowp = o; }
    }
};

struct EpiRes2 {
    static constexpr bool PERM = false, AFTER_DRAIN = false;
    bf16_t* out; const float* res; const float* mod; const float* gffn; bf16_t* A3; float* SS;
    DI void operator()(const f32x4 (&acc)[2][2][4][2], const pg8::Unit& u, int wr, int wc, int fr, int fq) const {
        const int row0 = u.pm * 256 + wr * 64 + fr, col0 = u.pn * 256 + wc * 32 + 4 * fq;
        const float* mp = mod + (size_t)(row0 >> 12) * 6144 + col0;
        f32x4 gv[2][2], gs[2][2];
#pragma unroll
        for (int bj = 0; bj < 2; ++bj)
#pragma unroll
            for (int n = 0; n < 2; ++n) { gv[bj][n] = *(const f32x4*)(mp + 2048 + bj * 128 + n * 16); gs[bj][n] = *(const f32x4*)(gffn + col0 + bj * 128 + n * 16) * (*(const f32x4*)(mp + 4096 + bj * 128 + n * 16) + 1.f); }
#pragma unroll
        for (int ai = 0; ai < 2; ++ai)
#pragma unroll
            for (int m = 0; m < 4; ++m) { const int row = row0 + ai * 128 + m * 16; const size_t ro = (size_t)row * 1024 + col0; float ssq = 0.f;
#pragma unroll
                for (int bj = 0; bj < 2; ++bj)
#pragma unroll
                    for (int n = 0; n < 2; ++n) { const f32x4 r = *(const f32x4*)(res + ro + bj * 128 + n * 16); const f32x4 x1 = r + gv[bj][n] * acc[ai][bj][m][n];
                        { u32x2 xo; xo.x = pk2(x1.x, x1.y); xo.y = pk2(x1.z, x1.w); *(u32x2*)(out + ro + bj * 128 + n * 16) = xo; } ssq += x1.x * x1.x + x1.y * x1.y + x1.z * x1.z + x1.w * x1.w;
                        const f32x4 a = x1 * gs[bj][n]; u32x2 o; o.x = pk2(a.x, a.y); o.y = pk2(a.z, a.w); *(u32x2*)(A3 + ro + bj * 128 + n * 16) = o; }
                ssq += __shfl_xor(ssq, 16); ssq += __shfl_xor(ssq, 32);
                if (fq == 0) unsafeAtomicAdd(SS + row, ssq); }
    }
};
struct EpiGLU2 {
    static constexpr bool PERM = true, AFTER_DRAIN = false;
    bf16_t* H; const float* SS; const float* bias;
    DI void operator()(const f32x4 (&acc)[2][2][4][2], const pg8::Unit& u, int wr, int wc, int fr, int fq) const {
        const int row0 = u.pm * 256 + wr * 64 + fr, col0 = u.pn * 128 + wc * 32 + 8 * fq;
        const float* bp = bias + (size_t)(row0 >> 12) * 5632 + col0;
        const f32x4 bg0 = *(const f32x4*)bp, bg1 = *(const f32x4*)(bp + 4), bu0 = *(const f32x4*)(bp + 2816), bu1 = *(const f32x4*)(bp + 2816 + 4);
#pragma unroll
        for (int ai = 0; ai < 2; ++ai)
#pragma unroll
            for (int m = 0; m < 4; ++m) { const int row = row0 + ai * 128 + m * 16; bf16_t* rowp = H + (size_t)row * 2816 + col0;
                const float rstd = rsqrtf(SS[row] * (1.f / 1024.f) + 1e-6f);
                const f32x4 g0 = acc[ai][0][m][0] * rstd + bg0, g1 = acc[ai][0][m][1] * rstd + bg1, u0 = acc[ai][1][m][0] * rstd + bu0, u1 = acc[ai][1][m][1] * rstd + bu1; u32x4 o;
                o.x = pk2(silu_f(g0[0]) * u0[0], silu_f(g0[1]) * u0[1]); o.y = pk2(silu_f(g0[2]) * u0[2], silu_f(g0[3]) * u0[3]);
                o.z = pk2(silu_f(g1[0]) * u1[0], silu_f(g1[1]) * u1[1]); o.w = pk2(silu_f(g1[2]) * u1[2], silu_f(g1[3]) * u1[3]);
                *(u32x4*)rowp = o; }
    }
};

struct EpiRes3 {
    static constexpr bool PERM = false, AFTER_DRAIN = false;
    float* out; const bf16_t* res; const float* gate; float* SSF;
    DI void operator()(const f32x4 (&acc)[2][2][4][2], const pg8::Unit& u, int wr, int wc, int fr, int fq) const {
        const int row0 = u.pm * 256 + wr * 64 + fr, col0 = u.pn * 256 + wc * 32 + 4 * fq;
        const float* gp = gate + (size_t)(row0 >> 12) * 6144 + col0;
        f32x4 gv[2][2];
#pragma unroll
        for (int bj = 0; bj < 2; ++bj)
#pragma unroll
            for (int n = 0; n < 2; ++n) gv[bj][n] = *(const f32x4*)(gp + bj * 128 + n * 16);
#pragma unroll
        for (int ai = 0; ai < 2; ++ai)
#pragma unroll
            for (int m = 0; m < 4; ++m) { const int row = row0 + ai * 128 + m * 16; const size_t ro = (size_t)row * 1024 + col0; float ssq = 0.f;
#pragma unroll
                for (int bj = 0; bj < 2; ++bj)
#pragma unroll
                    for (int n = 0; n < 2; ++n) { const u32x2 rb = *(const u32x2*)(res + ro + bj * 128 + n * 16); const f32x4 r = {bflo(rb.x), bfhi(rb.x), bflo(rb.y), bfhi(rb.y)}; const f32x4 x2 = r + gv[bj][n] * acc[ai][bj][m][n];
                        *(f32x4*)(out + ro + bj * 128 + n * 16) = x2; ssq += x2.x * x2.x + x2.y * x2.y + x2.z * x2.z + x2.w * x2.w; }
                ssq += __shfl_xor(ssq, 16); ssq += __shfl_xor(ssq, 32);
                if (fq == 0) unsafeAtomicAdd(SSF + row, ssq); }
    }
};

DI void phase_conv(const Params& p) {
    const int tid = threadIdx.x;
    const int tensor = blockIdx.x % 3, g = blockIdx.x / 3, Gt = (gridDim.x - tensor + 2) / 3;
    const bf16_t* __restrict__ src = (const bf16_t*)(p.ws + WS_QP + (size_t)tensor * PBUF);
    bf16_t* __restrict__ dst = (bf16_t*)(p.ws + (tensor == 0 ? WS_QC : tensor == 1 ? WS_KC : WS_VC));
    const int colb = (tid & 63) * 8, cwb = tensor * 512 + colb, rq = (tid >> 6) * 4;
    float cw[5][8];
#pragma unroll
    for (int i = 0; i < 5; ++i) { const f32x4 a = *(const f32x4*)(p.conv_w + i * 1536 + cwb), bq = *(const f32x4*)(p.conv_w + i * 1536 + cwb + 4);
        cw[i][0] = a.x; cw[i][1] = a.y; cw[i][2] = a.z; cw[i][3] = a.w; cw[i][4] = bq.x; cw[i][5] = bq.y; cw[i][6] = bq.z; cw[i][7] = bq.w; }
    u32x4 in[8], nx[8];
#define CONV_LOAD(dstv, j_) do { const int cr_ = (j_) >> 1, b_ = cr_ / 68, n_ = cr_ % 68, t0_ = n_ * 64 + ((j_) & 1) * 32 + rq; const int lo_ = n_ < 4 ? 0 : 256, hi_ = n_ < 4 ? 256 : TT; \
        _Pragma("unroll") for (int i = 0; i < 8; ++i) { const int tt = t0_ + i - 2; dstv[i] = (u32x4){0u, 0u, 0u, 0u}; if (tt >= lo_ && tt < hi_) dstv[i] = *(const u32x4*)(src + ((size_t)b_ * TT + tt) * 512 + colb); } } while (0)
    if (g < 544) CONV_LOAD(in, g);
#pragma unroll 1
    for (int j = g; j < 544; j += Gt) {
        if (j + Gt < 544) CONV_LOAD(nx, j + Gt);
        const int cr = j >> 1, b = cr / 68, n = cr % 68, t0 = n * 64 + (j & 1) * 32 + rq;
#pragma unroll
        for (int u = 0; u < 4; ++u) {
            float acc[8];
#pragma unroll
            for (int e = 0; e < 8; ++e) acc[e] = 0.f;
#pragma unroll
            for (int i = 0; i < 5; ++i) { const u32x4 v = in[u + i];
                acc[0] += bflo(v.x) * cw[i][0]; acc[1] += bfhi(v.x) * cw[i][1]; acc[2] += bflo(v.y) * cw[i][2]; acc[3] += bfhi(v.y) * cw[i][3];
                acc[4] += bflo(v.z) * cw[i][4]; acc[5] += bfhi(v.z) * cw[i][5]; acc[6] += bflo(v.w) * cw[i][6]; acc[7] += bfhi(v.w) * cw[i][7]; }
            float ss = 0;
#pragma unroll
            for (int e = 0; e < 8; ++e) { acc[e] = silu_f(acc[e]); ss += acc[e] * acc[e]; }
            if (tensor < 2) { ss += __shfl_xor(ss, 1); ss += __shfl_xor(ss, 2); ss += __shfl_xor(ss, 4); ss += __shfl_xor(ss, 8);
                const float sc = rsqrtf(ss + 1e-6f) * (tensor == 0 ? 0.08838834764831845f : 1.f);
#pragma unroll
                for (int e = 0; e < 8; ++e) acc[e] *= sc; }
            u32x4 o; o.x = pk2(acc[0], acc[1]); o.y = pk2(acc[2], acc[3]); o.z = pk2(acc[4], acc[5]); o.w = pk2(acc[6], acc[7]);
            *(u32x4*)(dst + ((size_t)b * TT + t0 + u) * 512 + colb) = o;
        }
#pragma unroll
        for (int i = 0; i < 8; ++i) in[i] = nx[i];
    }
#undef CONV_LOAD
}

constexpr int L_QS = 0, L_KS = 17408, L_WT = 0, L_UT = 18432, L_KT = 36864, L_VT = 55296, L_AA = 73728, L_QKF = 91136, L_QKB = 100352,
              L_TWF = 109568, L_TUF = 118784, L_TWB = 128000, L_TUB = 137216, L_VEC = 146432;
static_assert(L_VEC + 1024 <= LDS_BYTES, "lds");

DI void rot4(unsigned (&a)[4], int sft) {
    if (sft & 1) { const unsigned t = a[0]; a[0] = a[1]; a[1] = a[2]; a[2] = a[3]; a[3] = t; }
    if (sft & 2) { const unsigned t0 = a[0], t1 = a[1]; a[0] = a[2]; a[1] = a[3]; a[2] = t0; a[3] = t1; }
}
#define MFMA4F(a, b, c) __builtin_amdgcn_mfma_f32_16x16x4f32((a), (b), (c), 0, 0, 0)
constexpr int L_DS = 0;
DI void solve_diag(ldsp L, int w, int lane) {
    const int dir = w >> 2, k = w & 3, c = lane & 15;
    const LAS float* AA = (const LAS float*)(L + L_AA); const LAS float* VEC = (const LAS float*)(L + L_VEC);
    const int sg = dir ? -1 : 1, o0 = dir ? 63 : 0;
    const LAS float* Ab = AA + (o0 + sg * 16 * k) * 68 + (o0 + sg * 16 * k);
    float D[16];
#pragma unroll
    for (int i = 0; i < 16; ++i) { float s0 = (c == i) ? 1.f : 0.f;
#pragma unroll
        for (int j = 0; j < i; ++j) s0 -= Ab[sg * (i * 68 + j)] * D[j];
        D[i] = s0; }
    const int Cc = o0 + sg * (16 * k + c);
    const float beta = VEC[(dir ? 192 : 128) + Cc], cw = beta * __expf(VEC[(dir ? 64 : 0) + Cc]);
    ldsp TW = L + (dir ? L_TWB : L_TWF), TU = L + (dir ? L_TUB : L_TUF);
    if (lane < 16) {
#pragma unroll
        for (int i = 0; i < 16; ++i) { *(LAS float*)(L + L_DS + ((w * 16 + i) * 20 + c) * 4) = D[i];
            const int R = o0 + sg * (16 * k + i);
            *(LAS unsigned short*)(TW + R * 144 + Cc * 2) = f2bf(D[i] * cw); *(LAS unsigned short*)(TU + R * 144 + Cc * 2) = f2bf(D[i] * beta); } }
}
template <int KB> DI void solve_offdiag(ldsp L, int dir, int lane) {
    const int fr = lane & 15, fq = lane >> 4;
    const LAS float* AA = (const LAS float*)(L + L_AA); const LAS float* VEC = (const LAS float*)(L + L_VEC);
    const LAS float* DS = (const LAS float*)(L + L_DS) + dir * 4 * 320;
    const int sg = dir ? -1 : 1, o0 = dir ? 63 : 0;
    const int Cc = o0 + sg * (16 * KB + fr);
    const float beta = VEC[(dir ? 192 : 128) + Cc], cw = beta * __expf(VEC[(dir ? 64 : 0) + Cc]);
    ldsp TW = L + (dir ? L_TWB : L_TWF), TU = L + (dir ? L_TUB : L_TUF);
    f32x4 Tb[4];
#pragma unroll
    for (int r = 0; r < 4; ++r) Tb[KB][r] = DS[KB * 320 + (4 * fq + r) * 20 + fr];
#pragma unroll
    for (int i = KB + 1; i < 4; ++i) {
        f32x4 P = {0.f, 0.f, 0.f, 0.f};
#pragma unroll
        for (int j = KB; j < i; ++j) {
            const int row = o0 + sg * (16 * i + fr);
            f32x4 a;
            if (dir == 0) a = *(const LAS f32x4*)(AA + row * 68 + 16 * j + 4 * fq);
            else { const f32x4 t = *(const LAS f32x4*)(AA + row * 68 + 60 - 16 * j - 4 * fq); a = (f32x4){t.w, t.z, t.y, t.x}; }
#pragma unroll
            for (int r = 0; r < 4; ++r) P = MFMA4F(a[r], Tb[j][r], P);
        }
        const f32x4 d = *(const LAS f32x4*)(DS + i * 320 + fr * 20 + 4 * fq);
        f32x4 Z = {0.f, 0.f, 0.f, 0.f};
#pragma unroll
        for (int r = 0; r < 4; ++r) Z = MFMA4F(d[r], P[r], Z);
        Tb[i] = -Z;
#pragma unroll
        for (int r = 0; r < 4; ++r) { const int R = o0 + sg * (16 * i + 4 * fq + r);
            *(LAS unsigned short*)(TW + R * 144 + Cc * 2) = f2bf(Tb[i][r] * cw); *(LAS unsigned short*)(TU + R * 144 + Cc * 2) = f2bf(Tb[i][r] * beta); }
    }
}

DI void prep_gdn(const Params& p, ldsp L, int it, bool dry) {
    const int tid = threadIdx.x, lane = tid & 63, w = __builtin_amdgcn_readfirstlane(tid >> 6), fr = lane & 15, fq = lane >> 4;
    const int cr = it >> 2, h = it & 3, b = cr / 68, n = cr % 68;
    const size_t row0 = (size_t)b * TT + n * 64;
    const bf16_t* QC = (const bf16_t*)(p.ws + WS_QC); bf16_t* KC = (bf16_t*)(p.ws + WS_KC); const bf16_t* VC = (const bf16_t*)(p.ws + WS_VC);
    float* OG = p.out;
    LAS float* VEC = (LAS float*)(L + L_VEC);
#pragma unroll
    for (int u = 0; u < 2; ++u) { const int cid = w * 2 + u, r = (cid & 3) * 16 + fr, c8 = ((cid >> 2) * 4 + fq) * 8;
        const size_t g = (row0 + r) * 512 + h * 128 + c8;
        const u32x4 q = *(const u32x4*)(QC + g), k = *(const u32x4*)(KC + g), v = *(const u32x4*)(VC + g);
        *(LAS u32x4*)(L + L_QS + r * 272 + c8 * 2) = q; *(LAS u32x4*)(L + L_KS + r * 272 + c8 * 2) = k;
        unsigned kk[4] = {k.x, k.y, k.z, k.w}, vv[4] = {v.x, v.y, v.z, v.w};
        rot4(kk, fq); rot4(vv, fq);
#pragma unroll
        for (int e = 0; e < 4; ++e) { const int row = c8 + 2 * ((e + fq) & 3);
            *(LAS unsigned short*)(L + L_KT + row * 144 + r * 2) = (unsigned short)(kk[e] & 0xffff); *(LAS unsigned short*)(L + L_KT + (row + 1) * 144 + r * 2) = (unsigned short)(kk[e] >> 16);
            *(LAS unsigned short*)(L + L_VT + row * 144 + r * 2) = (unsigned short)(vv[e] & 0xffff); *(LAS unsigned short*)(L + L_VT + (row + 1) * 144 + r * 2) = (unsigned short)(vv[e] >> 16); } }
    for (int e = tid; e < 9216; e += NT) *(LAS unsigned*)(L + L_TWF + e * 4) = 0u;
    if (tid < 64) {
        const float* gp = (const float*)(p.ws + WS_GATES) + (row0 + tid) * 16;
        const float gf = -__expf(p.a_log[h]) * softplus_f(gp[h] + p.dt_bias[h]);
        const float gb = -__expf(p.a_log[4 + h]) * softplus_f(gp[4 + h] + p.dt_bias[4 + h]);
        float pf = gf, pb = gb;
        for (int o = 1; o < 64; o <<= 1) { const float a = __shfl_up(pf, o), c = __shfl_up(pb, o); if (lane >= o) { pf += a; pb += c; } }
        const float totb = __shfl(pb, 63), GfL = __shfl(pf, 63);
        const float Gf = pf, Gb = totb - pb + gb;
        VEC[tid] = Gf; VEC[64 + tid] = Gb; VEC[128 + tid] = sigm_f(gp[8 + h]); VEC[192 + tid] = sigm_f(gp[12 + h]);
        float* dec = (float*)(p.ws + WS_DEC) + (size_t)(it * 2) * 80;
        dec[tid] = __expf(GfL - Gf); dec[80 + tid] = __expf(totb - Gb);
        if (tid == 0) { dec[64] = __expf(GfL); dec[80 + 64] = __expf(totb); }
    }
    lds_barrier();
    { const int mat = w >> 2, tr = w & 3;
      ldsp Ab = L + (mat ? L_QS : L_KS);
      bf16x8 a[4];
#pragma unroll
      for (int kk = 0; kk < 4; ++kk) a[kk] = lds16(Ab + (tr * 16 + fr) * 272 + kk * 64 + fq * 16);
#pragma unroll
      for (int tc = 0; tc < 4; ++tc) {
          f32x4 acc = {0.f, 0.f, 0.f, 0.f};
#pragma unroll
          for (int kk = 0; kk < 4; ++kk) acc = MFMA16(a[kk], lds16(L + L_KS + (tc * 16 + fr) * 272 + kk * 64 + fq * 16), acc);
          const int s = tc * 16 + fr; const float Gfs = VEC[s], Gbs = VEC[64 + s];
#pragma unroll
          for (int j = 0; j < 4; ++j) { const int t = tr * 16 + fq * 4 + j; const float Gft = VEC[t], Gbt = VEC[64 + t];
              if (mat == 0) { float v = 0.f; if (s < t) v = VEC[128 + t] * acc[j] * __expf(Gft - Gfs); else if (s > t) v = VEC[192 + t] * acc[j] * __expf(Gbt - Gbs);
                  *(LAS float*)(L + L_AA + (t * 68 + s) * 4) = v; }
              else { const float vf = (s <= t) ? acc[j] * __expf(Gft - Gfs) : 0.f, vb = (s >= t) ? acc[j] * __expf(Gbt - Gbs) : 0.f;
                  *(LAS unsigned short*)(L + L_QKF + t * 144 + s * 2) = f2bf(vf); *(LAS unsigned short*)(L + L_QKB + t * 144 + s * 2) = f2bf(vb); } } } }
    lds_barrier();
    solve_diag(L, w, lane);
    lds_barrier();
    if (w < 6) { const int dr_ = w >= 3 ? 1 : 0, kb = w - 3 * dr_; if (kb == 0) solve_offdiag<0>(L, dr_, lane); else if (kb == 1) solve_offdiag<1>(L, dr_, lane); else solve_offdiag<2>(L, dr_, lane); }
    lds_barrier();
    f32x4 oacc[8];
#pragma unroll
    for (int i = 0; i < 8; ++i) oacc[i] = (f32x4){0.f, 0.f, 0.f, 0.f};
#pragma unroll 1
    for (int dir = 0; dir < 2; ++dir) {
        ldsp TW = L + (dir ? L_TWB : L_TWF), TU = L + (dir ? L_TUB : L_TUF), QKM = L + (dir ? L_QKB : L_QKF);
        bf16_t* Wg = (bf16_t*)(p.ws + (dir ? WS_WB : WS_WF)) + (size_t)it * 8192;
        bf16_t* Ug = (bf16_t*)(p.ws + (dir ? WS_UB : WS_UF)) + (size_t)it * 8192;
        bf16_t* Qg = (bf16_t*)(p.ws + (dir ? WS_QB : WS_QF)) + (size_t)it * 8192;
        u32x2 qv[8];
        if (w < 4) {
#pragma unroll
            for (int dr = 0; dr < 8; ++dr) qv[dr] = *(const u32x2*)(QC + (row0 + w * 16 + fr) * 512 + h * 128 + dr * 16 + fq * 4);
            const bf16x8 b0 = lds16(TW + (w * 16 + fr) * 144 + fq * 16), b1 = lds16(TW + (w * 16 + fr) * 144 + 64 + fq * 16);
            const int t = w * 16 + fr; const float et = dir ? __expf(VEC[64] - VEC[64 + t]) : __expf(VEC[63] - VEC[t]);
#pragma unroll
            for (int dr = 0; dr < 8; ++dr) { f32x4 acc = {0.f, 0.f, 0.f, 0.f};
                acc = MFMA16(lds16(L + L_KT + (dr * 16 + fr) * 144 + fq * 16), b0, acc); acc = MFMA16(lds16(L + L_KT + (dr * 16 + fr) * 144 + 64 + fq * 16), b1, acc);
                const int d0 = dr * 16 + fq * 4; u32x2 o; o.x = pk2(acc[0], acc[1]); o.y = pk2(acc[2], acc[3]);
                { u32x2 og; og.x = pk2(acc[0] * et, acc[1] * et); og.y = pk2(acc[2] * et, acc[3] * et); *(u32x2*)(Wg + ((w * 4 + (dr >> 1)) * 64 + ((dr & 1) * 2 + (fq >> 1)) * 16 + fr) * 8 + (fq & 1) * 4) = og; }
                *(LAS unsigned short*)(L + L_WT + (d0 + 0) * 144 + t * 2) = (unsigned short)(o.x & 0xffff); *(LAS unsigned short*)(L + L_WT + (d0 + 1) * 144 + t * 2) = (unsigned short)(o.x >> 16);
                *(LAS unsigned short*)(L + L_WT + (d0 + 2) * 144 + t * 2) = (unsigned short)(o.y & 0xffff); *(LAS unsigned short*)(L + L_WT + (d0 + 3) * 144 + t * 2) = (unsigned short)(o.y >> 16); }
        } else {
            const int tw = w - 4;
            const bf16x8 a0 = lds16(TU + (tw * 16 + fr) * 144 + fq * 16), a1 = lds16(TU + (tw * 16 + fr) * 144 + 64 + fq * 16);
            const int t0 = tw * 16 + fq * 4; float eu[4];
#pragma unroll
            for (int j = 0; j < 4; ++j) eu[j] = dir ? __expf(VEC[64] - VEC[64 + t0 + j]) : __expf(VEC[63] - VEC[t0 + j]);
#pragma unroll
            for (int tc = 0; tc < 8; ++tc) { f32x4 acc = {0.f, 0.f, 0.f, 0.f};
                acc = MFMA16(a0, lds16(L + L_VT + (tc * 16 + fr) * 144 + fq * 16), acc); acc = MFMA16(a1, lds16(L + L_VT + (tc * 16 + fr) * 144 + 64 + fq * 16), acc);
                const int c = tc * 16 + fr; u32x2 o; o.x = pk2(acc[0], acc[1]); o.y = pk2(acc[2], acc[3]);
                *(LAS u32x2*)(L + L_UT + c * 144 + t0 * 2) = o; { u32x2 og; og.x = pk2(acc[0] * eu[0], acc[1] * eu[1]); og.y = pk2(acc[2] * eu[2], acc[3] * eu[3]); *(u32x2*)(Ug + c * 64 + t0) = og; } }
        }
        lds_barrier();
        if (w < 4) {
            const bf16x8 b0 = lds16(QKM + (w * 16 + fr) * 144 + fq * 16), b1 = lds16(QKM + (w * 16 + fr) * 144 + 64 + fq * 16);
            const int t = w * 16 + fr; const float eg = __expf(VEC[(dir ? 64 : 0) + t]);
#pragma unroll
            for (int dr = 0; dr < 8; ++dr) { f32x4 acc = {0.f, 0.f, 0.f, 0.f};
                acc = MFMA16(lds16(L + L_WT + (dr * 16 + fr) * 144 + fq * 16), b0, acc); acc = MFMA16(lds16(L + L_WT + (dr * 16 + fr) * 144 + 64 + fq * 16), b1, acc);
                const u32x2 q = qv[dr];
                u32x2 o; o.x = pk2(eg * bflo(q.x) - acc[0], eg * bfhi(q.x) - acc[1]); o.y = pk2(eg * bflo(q.y) - acc[2], eg * bfhi(q.y) - acc[3]);
                *(u32x2*)(Qg + ((w * 4 + (dr >> 1)) * 64 + ((dr & 1) * 2 + (fq >> 1)) * 16 + fr) * 8 + (fq & 1) * 4) = o; }
        } else {
            const int tw = w - 4;
            const bf16x8 b0 = lds16(QKM + (tw * 16 + fr) * 144 + fq * 16), b1 = lds16(QKM + (tw * 16 + fr) * 144 + 64 + fq * 16);
#pragma unroll
            for (int ct = 0; ct < 8; ++ct) { oacc[ct] = MFMA16(lds16(L + L_UT + (ct * 16 + fr) * 144 + fq * 16), b0, oacc[ct]); oacc[ct] = MFMA16(lds16(L + L_UT + (ct * 16 + fr) * 144 + 64 + fq * 16), b1, oacc[ct]); }
        }
        lds_barrier();
    }
    if (w >= 4 && n >= 4) { const int t = (w - 4) * 16 + fr; const size_t lrow = (size_t)b * 4096 + (n - 4) * 64 + t;
#pragma unroll
        for (int ct = 0; ct < 8; ++ct) *(f32x4*)(OG + lrow * 512 + h * 128 + ct * 16 + fq * 4) = oacc[ct]; }
    if (!dry) for (int pc = tid; pc < 1024; pc += NT) { const int d = pc >> 3, t8 = (pc & 7) * 8; const u32x4 v = *(const LAS u32x4*)(L + L_KT + d * 144 + t8 * 2);
        { const int e_ = ((((d >> 4) * 2 + (t8 >> 5)) * 64) + ((t8 >> 3) & 3) * 16 + (d & 15)) * 8; *(u32x4*)(KC + (row0 + (e_ >> 7)) * 512 + h * 128 + (e_ & 127)) = v; } }
    lds_barrier();
}

DI float logsig_f(float x) { return -softplus_f(-x); }

DI void prep_ret(const Params& p, ldsp L, int it, bool dry) {
    const int tid = threadIdx.x, lane = tid & 63, w = __builtin_amdgcn_readfirstlane(tid >> 6), fr = lane & 15, fq = lane >> 4;
    const int cr = it >> 2, h = it & 3, b = cr / 68, n = cr % 68; const bool isctx = n < 4;
    const size_t row0 = (size_t)b * TT + n * 64;
    bf16_t* RQ = (bf16_t*)(p.ws + WS_RQ); bf16_t* RK = (bf16_t*)(p.ws + WS_RK); const bf16_t* RV = (const bf16_t*)(p.ws + WS_RV);
    float* ORp = p.out + (size_t)LROWS * 512;
    constexpr int R_QS = 0, R_KS = 17408, R_KT = 36864, R_VT = 55296, R_QKD = 73728;
    const float lgf2 = logsig_f(p.ret_logit[h]) * 1.4426950408889634f, lgb2 = logsig_f(p.ret_logit[4 + h]) * 1.4426950408889634f;
    u32x4 q1s = {0u, 0u, 0u, 0u}, q2s = {0u, 0u, 0u, 0u};
    { const int r = (w & 3) * 16 + fr, p8 = ((w >> 2) * 4 + fq) * 8, t = n * 64 + r;
      float pos; int i0; float rc;
      if (p8 < 16) { pos = isctx ? (float)t : 256.f; i0 = p8; rc = 1.f / 16.f; }
      else if (p8 < 40) { pos = isctx ? 0.f : (float)((t - 256) >> 6); i0 = p8 - 16; rc = 1.f / 24.f; }
      else { pos = isctx ? 0.f : (float)((t - 256) & 63); i0 = p8 - 40; rc = 1.f / 24.f; }
      float cs[8], sn[8];
#pragma unroll
      for (int e = 0; e < 8; ++e) { const float ang = pos * exp2f(-13.287712379549449f * (float)(i0 + e) * rc); cs[e] = __cosf(ang); sn[e] = __sinf(ang); }
      const size_t g = (row0 + r) * 512 + h * 128 + p8;
      { const u32x4 k1 = *(const u32x4*)(RK + g), k2 = *(const u32x4*)(RK + g + 64);
        const unsigned a1[4] = {k1.x, k1.y, k1.z, k1.w}, a2[4] = {k2.x, k2.y, k2.z, k2.w}; unsigned o1[4], o2[4];
#pragma unroll
        for (int e = 0; e < 4; ++e) { const float x0 = bflo(a1[e]), x1 = bfhi(a1[e]), y0 = bflo(a2[e]), y1 = bfhi(a2[e]); const float sc = 0.08838834764831845f;
            o1[e] = pk2((x0 * cs[2 * e] - y0 * sn[2 * e]) * sc, (x1 * cs[2 * e + 1] - y1 * sn[2 * e + 1]) * sc);
            o2[e] = pk2((x0 * sn[2 * e] + y0 * cs[2 * e]) * sc, (x1 * sn[2 * e + 1] + y1 * cs[2 * e + 1]) * sc); }
        *(LAS u32x4*)(L + R_KS + r * 272 + p8 * 2) = (u32x4){o1[0], o1[1], o1[2], o1[3]}; *(LAS u32x4*)(L + R_KS + r * 272 + (64 + p8) * 2) = (u32x4){o2[0], o2[1], o2[2], o2[3]};
rot4(o1, fq); rot4(o2, fq);
#pragma unroll
        for (int e = 0; e < 4; ++e) { const int row = p8 + 2 * ((e + fq) & 3);
            *(LAS unsigned short*)(L + R_KT + row * 144 + r * 2) = (unsigned short)(o1[e] & 0xffff); *(LAS unsigned short*)(L + R_KT + (row + 1) * 144 + r * 2) = (unsigned short)(o1[e] >> 16);
            *(LAS unsigned short*)(L + R_KT + (64 + row) * 144 + r * 2) = (unsigned short)(o2[e] & 0xffff); *(LAS unsigned short*)(L + R_KT + (64 + row + 1) * 144 + r * 2) = (unsigned short)(o2[e] >> 16); } }
      if (!isctx) {
        const u32x4 k1 = *(const u32x4*)(RQ + g), k2 = *(const u32x4*)(RQ + g + 64);
        const unsigned a1[4] = {k1.x, k1.y, k1.z, k1.w}, a2[4] = {k2.x, k2.y, k2.z, k2.w}; unsigned o1[4], o2[4];
#pragma unroll
        for (int e = 0; e < 4; ++e) { const float x0 = bflo(a1[e]), x1 = bfhi(a1[e]), y0 = bflo(a2[e]), y1 = bfhi(a2[e]);
            o1[e] = pk2(x0 * cs[2 * e] - y0 * sn[2 * e], x1 * cs[2 * e + 1] - y1 * sn[2 * e + 1]);
            o2[e] = pk2(x0 * sn[2 * e] + y0 * cs[2 * e], x1 * sn[2 * e + 1] + y1 * cs[2 * e + 1]); }
        const u32x4 q1 = {o1[0], o1[1], o1[2], o1[3]}, q2 = {o2[0], o2[1], o2[2], o2[3]};
        *(LAS u32x4*)(L + R_QS + r * 272 + p8 * 2) = q1; *(LAS u32x4*)(L + R_QS + r * 272 + (64 + p8) * 2) = q2;
        q1s = q1; q2s = q2;
#pragma unroll
        for (int u = 0; u < 2; ++u) { const int cid = w * 2 + u, r2 = (cid & 3) * 16 + fr, c8 = ((cid >> 2) * 4 + fq) * 8; const u32x4 v = *(const u32x4*)(RV + (row0 + r2) * 512 + h * 128 + c8);
            unsigned vv[4] = {v.x, v.y, v.z, v.w}; rot4(vv, fq);
#pragma unroll
            for (int e = 0; e < 4; ++e) { const int row = c8 + 2 * ((e + fq) & 3); *(LAS unsigned short*)(L + R_VT + row * 144 + r2 * 2) = (unsigned short)(vv[e] & 0xffff); *(LAS unsigned short*)(L + R_VT + (row + 1) * 144 + r2 * 2) = (unsigned short)(vv[e] >> 16); } }
      }
    }
    lds_barrier();
    if (!dry && !isctx) { const int r = (w & 3) * 16 + fr, p8 = ((w >> 2) * 4 + fq) * 8; const int e1 = ((((r >> 4) * 4 + (p8 >> 5)) * 64) + ((p8 >> 3) & 3) * 16 + (r & 15)) * 8, e2 = e1 + 2 * 64 * 8;
        *(u32x4*)(RQ + (row0 + (e1 >> 7)) * 512 + h * 128 + (e1 & 127)) = q1s; *(u32x4*)(RQ + (row0 + (e2 >> 7)) * 512 + h * 128 + (e2 & 127)) = q2s; }
    if (!dry) for (int pc = tid; pc < 1024; pc += NT) { const int d = pc >> 3, t8 = (pc & 7) * 8; const u32x4 v = *(const LAS u32x4*)(L + R_KT + d * 144 + t8 * 2);
        { const int e_ = ((((d >> 4) * 2 + (t8 >> 5)) * 64) + ((t8 >> 3) & 3) * 16 + (d & 15)) * 8; *(u32x4*)(RK + (row0 + (e_ >> 7)) * 512 + h * 128 + (e_ & 127)) = v; } }
    if (!isctx) {
        { const int tr = w >> 1; bf16x8 a[4];
#pragma unroll
          for (int kk = 0; kk < 4; ++kk) a[kk] = lds16(L + R_QS + (tr * 16 + fr) * 272 + kk * 64 + fq * 16);
#pragma unroll
          for (int x = 0; x < 2; ++x) { const int tc = (w & 1) * 2 + x; f32x4 acc = {0.f, 0.f, 0.f, 0.f};
#pragma unroll
              for (int kk = 0; kk < 4; ++kk) acc = MFMA16(a[kk], lds16(L + R_KS + (tc * 16 + fr) * 272 + kk * 64 + fq * 16), acc);
              const int s = tc * 16 + fr;
#pragma unroll
              for (int j = 0; j < 4; ++j) { const int t = tr * 16 + fq * 4 + j, dt = t - s;
                  const float f = (dt >= 0 ? exp2f((float)dt * lgf2) : 0.f) + (dt <= 0 ? exp2f((float)(-dt) * lgb2) : 0.f);
                  *(LAS unsigned short*)(L + R_QKD + t * 144 + s * 2) = f2bf(acc[j] * f); } } }
        lds_barrier();
        { const int tw = w & 3; const bf16x8 b0 = lds16(L + R_QKD + (tw * 16 + fr) * 144 + fq * 16), b1 = lds16(L + R_QKD + (tw * 16 + fr) * 144 + 64 + fq * 16);
          const int t = tw * 16 + fr; const size_t lrow = (size_t)b * 4096 + (n - 4) * 64 + t;
#pragma unroll
          for (int x = 0; x < 4; ++x) { const int ct = (w >> 2) * 4 + x; f32x4 acc = {0.f, 0.f, 0.f, 0.f};
              acc = MFMA16(lds16(L + R_VT + (ct * 16 + fr) * 144 + fq * 16), b0, acc); acc = MFMA16(lds16(L + R_VT + (ct * 16 + fr) * 144 + 64 + fq * 16), b1, acc);
              *(f32x4*)(ORp + lrow * 512 + h * 128 + ct * 16 + fq * 4) = acc; } }
    }
    lds_barrier();
}

DI int chunk_of(int i, int dir) { return dir == 0 ? i : (i < 4 ? 3 - i : 71 - i); }
constexpr int S_ST = 0, S_VT = 8704;

struct GSet { bf16x8 W[4], Q[4], K[2]; u32x2 U; float gl; f32x4 O; };
struct GCtx { const bf16_t *Wb, *Qb, *Ub, *KC; const float* DEC; float* OG; bf16_t* OGB; int b, h, dir, slice, w, fr, fq, tr, tc; unsigned lw, lk, lu, lo; float osc; };
DI void gdn_load(GSet& s, const GCtx& c, int n) {
    const int it = __builtin_amdgcn_readfirstlane((c.b * 68 + n) * 4 + c.h); const size_t r0 = (size_t)c.b * TT + n * 64;
    const char* wp = (const char*)c.Wb + (size_t)it * 16384; const char* qp = (const char*)c.Qb + (size_t)it * 16384;
#pragma unroll
    for (int kk = 0; kk < 4; ++kk) { s.W[kk] = *(const bf16x8*)(wp + (c.lw + kk * 1024)); s.Q[kk] = *(const bf16x8*)(qp + (c.lw + kk * 1024)); }
    const char* kp = (const char*)c.KC + (r0 * 512 + c.h * 128) * 2;
    s.K[0] = *(const bf16x8*)(kp + c.lk); s.K[1] = *(const bf16x8*)(kp + (c.lk + 4 * 512 * 2));
    s.U = *(const u32x2*)((const char*)c.Ub + (size_t)it * 16384 + c.lu);
    s.gl = c.DEC[(size_t)(it * 2 + c.dir) * 80 + 64];
    if (c.dir == 0) { const int nn = n >= 4 ? n - 4 : 0; s.O = *(const f32x4*)((const char*)c.OG + (((size_t)c.b * 4096 + nn * 64) * 512 + c.h * 128 + c.slice * 32) * 4 + c.lo); }
}
DI void gdn_step(const GSet& s, const GCtx& c, ldsp L, f32x4& S0, f32x4& S1, int n) {
    f32x4 X = {0.f, 0.f, 0.f, 0.f}, OX = {0.f, 0.f, 0.f, 0.f};
#pragma unroll
    for (int kk = 0; kk < 4; ++kk) { const bf16x8 sf = lds16(L + S_ST + (c.tc * 16 + c.fr) * 272 + kk * 64 + c.fq * 16); X = MFMA16(s.W[kk], sf, X); OX = MFMA16(sf, s.Q[kk], OX); }
    { u32x2 o; o.x = pk2(bflo(s.U.x) - X[0], bfhi(s.U.x) - X[1]); o.y = pk2(bflo(s.U.y) - X[2], bfhi(s.U.y) - X[3]);
      *(LAS u32x2*)(L + S_VT + (c.tc * 16 + c.fr) * 144 + (c.tr * 16 + c.fq * 4) * 2) = o; }
    { const bool valid = n >= 4; const float sc = valid ? c.osc : 0.f;
      if (c.dir == 0) { const int nn = valid ? n - 4 : 0;
          *(f32x4*)((char*)c.OG + (((size_t)c.b * 4096 + nn * 64) * 512 + c.h * 128 + c.slice * 32) * 4 + c.lo) = s.O + OX * sc; }
      else { const size_t row = valid ? (size_t)c.b * 4096 + (n - 4) * 64 + c.tr * 16 + c.fr : (size_t)LROWS + c.tr * 16 + c.fr;
          u32x2 o; o.x = pk2(OX[0] * sc, OX[1] * sc); o.y = pk2(OX[2] * sc, OX[3] * sc);
          *(u32x2*)(c.OGB + row * 512 + c.h * 128 + c.slice * 32 + c.tc * 16 + c.fq * 4) = o; } }
    lds_barrier();
    { S0 *= s.gl; S1 *= s.gl;
#pragma unroll
      for (int kk = 0; kk < 2; ++kk) { S0 = MFMA16(s.K[kk], lds16(L + S_VT + c.fr * 144 + kk * 64 + c.fq * 16), S0); S1 = MFMA16(s.K[kk], lds16(L + S_VT + (16 + c.fr) * 144 + kk * 64 + c.fq * 16), S1); }
      u32x2 o; o.x = pk2(S0[0], S0[1]); o.y = pk2(S0[2], S0[3]); *(LAS u32x2*)(L + S_ST + c.fr * 272 + (c.w * 16 + c.fq * 4) * 2) = o;
      o.x = pk2(S1[0], S1[1]); o.y = pk2(S1[2], S1[3]); *(LAS u32x2*)(L + S_ST + (16 + c.fr) * 272 + (c.w * 16 + c.fq * 4) * 2) = o; }
    lds_barrier();
}
DI void scan_gdn(const Params& p, ldsp L, int b, int h, int dir, int slice, float osc) {
    const int tid = threadIdx.x, lane = tid & 63, w = __builtin_amdgcn_readfirstlane(tid >> 6);
    GCtx c; c.Wb = (const bf16_t*)(p.ws + (dir ? WS_WB : WS_WF)); c.Ub = (const bf16_t*)(p.ws + (dir ? WS_UB : WS_UF)); c.Qb = (const bf16_t*)(p.ws + (dir ? WS_QB : WS_QF));
    c.KC = (const bf16_t*)(p.ws + WS_KC); c.DEC = (const float*)(p.ws + WS_DEC); c.OG = p.out; c.OGB = (bf16_t*)(p.ws + WS_OGB);
    c.b = b; c.h = h; c.dir = dir; c.slice = slice; c.w = w; c.fr = lane & 15; c.fq = lane >> 4; c.tr = w >> 1; c.tc = w & 1; c.osc = osc;
    c.lw = (unsigned)((c.tr * 256 + c.fq * 16 + c.fr) * 16); c.lk = (unsigned)(((w * 8 + c.fq) * 512 + c.fr * 8) * 2);
    c.lu = (unsigned)(((slice * 32 + c.tc * 16 + c.fr) * 64 + c.tr * 16 + c.fq * 4) * 2); c.lo = (unsigned)(((c.tr * 16 + c.fr) * 512 + c.tc * 16 + c.fq * 4) * 4);
    for (int e = tid; e < (8704 + 4608) / 4; e += NT) ((LAS unsigned*)L)[e] = 0u;
    lds_barrier();
    f32x4 S0 = {0.f, 0.f, 0.f, 0.f}, S1 = {0.f, 0.f, 0.f, 0.f};
    GSet A, B, C;
    gdn_load(A, c, chunk_of(0, dir)); gdn_load(B, c, chunk_of(1, dir));
#pragma unroll 1
    for (int i = 0; i < 66; i += 6) {
        gdn_load(C, c, chunk_of(i + 2, dir)); gdn_step(A, c, L, S0, S1, chunk_of(i, dir));
        gdn_load(A, c, chunk_of(i + 3, dir)); gdn_step(B, c, L, S0, S1, chunk_of(i + 1, dir));
        gdn_load(B, c, chunk_of(i + 4, dir)); gdn_step(C, c, L, S0, S1, chunk_of(i + 2, dir));
        gdn_load(C, c, chunk_of(i + 5, dir)); gdn_step(A, c, L, S0, S1, chunk_of(i + 3, dir));
        gdn_load(A, c, chunk_of(i + 6, dir)); gdn_step(B, c, L, S0, S1, chunk_of(i + 4, dir));
        gdn_load(B, c, chunk_of(i + 7, dir)); gdn_step(C, c, L, S0, S1, chunk_of(i + 5, dir));
    }
    gdn_step(A, c, L, S0, S1, chunk_of(66, dir)); gdn_step(B, c, L, S0, S1, chunk_of(67, dir));
}

struct RSet { bf16x8 Q[4], K[2]; u32x2 V; f32x4 O; };
struct RCtx { const bf16_t *RQ, *RK, *RV; float* ORp; bf16_t* ORB; int b, h, dir, slice, w, fr, fq, tr, tc, vt, vc4; unsigned lq, lk, lv, lo; float osc, gC, zeta, xiT; };
DI void ret_load(RSet& s, const RCtx& c, int n) {
    const size_t r0 = (size_t)c.b * TT + n * 64; const size_t ub = (r0 * 512 + c.h * 128) * 2;
    const char* qp = (const char*)c.RQ + ub;
#pragma unroll
    for (int kk = 0; kk < 4; ++kk) s.Q[kk] = *(const bf16x8*)(qp + (c.lq + kk * 4 * 512 * 2));
    const char* kp = (const char*)c.RK + ub;
    s.K[0] = *(const bf16x8*)(kp + c.lk); s.K[1] = *(const bf16x8*)(kp + (c.lk + 4 * 512 * 2));
    s.V = *(const u32x2*)((const char*)c.RV + ub + c.lv);
    if (c.dir == 0) { const int nn = n >= 4 ? n - 4 : 0; s.O = *(const f32x4*)((const char*)c.ORp + (((size_t)c.b * 4096 + nn * 64) * 512 + c.h * 128 + c.slice * 32) * 4 + c.lo); }
}
DI void ret_step(const RSet& s, const RCtx& c, ldsp L, f32x4& S0, f32x4& S1, int n) {
    { unsigned vz[4] = {f2bf(bflo(s.V.x) * c.zeta), f2bf(bfhi(s.V.x) * c.zeta), f2bf(bflo(s.V.y) * c.zeta), f2bf(bfhi(s.V.y) * c.zeta)};
      const int sft = (c.vc4 >> 3) & 3; rot4(vz, sft);
#pragma unroll
      for (int i = 0; i < 4; ++i) *(LAS unsigned short*)(L + S_VT + (c.vc4 + ((i + sft) & 3)) * 144 + c.vt * 2) = (unsigned short)vz[i]; }
    { f32x4 OX = {0.f, 0.f, 0.f, 0.f};
#pragma unroll
      for (int kk = 0; kk < 4; ++kk) OX = MFMA16(lds16(L + S_ST + (c.tc * 16 + c.fr) * 272 + kk * 64 + c.fq * 16), s.Q[kk], OX);
      const bool valid = n >= 4; const float sc = valid ? c.osc * c.xiT : 0.f;
      if (c.dir == 0) { const int nn = valid ? n - 4 : 0;
          *(f32x4*)((char*)c.ORp + (((size_t)c.b * 4096 + nn * 64) * 512 + c.h * 128 + c.slice * 32) * 4 + c.lo) = s.O + OX * sc; }
      else { const size_t row = valid ? (size_t)c.b * 4096 + (n - 4) * 64 + c.tr * 16 + c.fr : (size_t)LROWS + c.tr * 16 + c.fr;
          u32x2 o; o.x = pk2(OX[0] * sc, OX[1] * sc); o.y = pk2(OX[2] * sc, OX[3] * sc);
          *(u32x2*)(c.ORB + row * 512 + c.h * 128 + c.slice * 32 + c.tc * 16 + c.fq * 4) = o; } }
    lds_barrier();
    { S0 *= c.gC; S1 *= c.gC;
#pragma unroll
      for (int kk = 0; kk < 2; ++kk) { S0 = MFMA16(s.K[kk], lds16(L + S_VT + c.fr * 144 + kk * 64 + c.fq * 16), S0); S1 = MFMA16(s.K[kk], lds16(L + S_VT + (16 + c.fr) * 144 + kk * 64 + c.fq * 16), S1); }
      u32x2 o; o.x = pk2(S0[0], S0[1]); o.y = pk2(S0[2], S0[3]); *(LAS u32x2*)(L + S_ST + c.fr * 272 + (c.w * 16 + c.fq * 4) * 2) = o;
      o.x = pk2(S1[0], S1[1]); o.y = pk2(S1[2], S1[3]); *(LAS u32x2*)(L + S_ST + (16 + c.fr) * 272 + (c.w * 16 + c.fq * 4) * 2) = o; }
    lds_barrier();
}
DI void scan_ret(const Params& p, ldsp L, int b, int h, int dir, int slice, float osc) {
    const int tid = threadIdx.x, lane = tid & 63, w = __builtin_amdgcn_readfirstlane(tid >> 6);
    RCtx c; c.RQ = (const bf16_t*)(p.ws + WS_RQ); c.RK = (const bf16_t*)(p.ws + WS_RK); c.RV = (const bf16_t*)(p.ws + WS_RV); c.ORp = p.out + (size_t)LROWS * 512; c.ORB = (bf16_t*)(p.ws + WS_ORB);
    c.b = b; c.h = h; c.dir = dir; c.slice = slice; c.w = w; c.fr = lane & 15; c.fq = lane >> 4; c.tr = w >> 1; c.tc = w & 1; c.osc = osc; c.vt = tid >> 3; c.vc4 = (tid & 7) * 4;
    c.lq = (unsigned)(((c.tr * 16 + c.fq) * 512 + c.fr * 8) * 2); c.lk = (unsigned)(((w * 8 + c.fq) * 512 + c.fr * 8) * 2); c.lv = (unsigned)((c.vt * 512 + slice * 32 + c.vc4) * 2); c.lo = (unsigned)(((c.tr * 16 + c.fr) * 512 + c.tc * 16 + c.fq * 4) * 4);
    const float lg2 = logsig_f(p.ret_logit[dir * 4 + h]) * 1.4426950408889634f;
    c.gC = exp2f(64.f * lg2); c.zeta = exp2f((float)(dir ? c.vt : 63 - c.vt) * lg2);
    { const int t = c.tr * 16 + c.fr; c.xiT = exp2f((float)(dir ? 64 - t : t + 1) * lg2); }
    for (int e = tid; e < (8704 + 4608) / 4; e += NT) ((LAS unsigned*)L)[e] = 0u;
    lds_barrier();
    f32x4 S0 = {0.f, 0.f, 0.f, 0.f}, S1 = {0.f, 0.f, 0.f, 0.f};
    RSet A, B, C;
    ret_load(A, c, chunk_of(0, dir)); ret_load(B, c, chunk_of(1, dir));
#pragma unroll 1
    for (int i = 0; i < 66; i += 6) {
        ret_load(C, c, chunk_of(i + 2, dir)); ret_step(A, c, L, S0, S1, chunk_of(i, dir));
        ret_load(A, c, chunk_of(i + 3, dir)); ret_step(B, c, L, S0, S1, chunk_of(i + 1, dir));
        ret_load(B, c, chunk_of(i + 4, dir)); ret_step(C, c, L, S0, S1, chunk_of(i + 2, dir));
        ret_load(C, c, chunk_of(i + 5, dir)); ret_step(A, c, L, S0, S1, chunk_of(i + 3, dir));
        ret_load(A, c, chunk_of(i + 6, dir)); ret_step(B, c, L, S0, S1, chunk_of(i + 4, dir));
        ret_load(B, c, chunk_of(i + 7, dir)); ret_step(C, c, L, S0, S1, chunk_of(i + 5, dir));
    }
    ret_step(A, c, L, S0, S1, chunk_of(66, dir)); ret_step(B, c, L, S0, S1, chunk_of(67, dir));
}

DI void phase_postnorm(const Params& p, ldsp L) {
    const int tid = threadIdx.x, lane = tid & 63, w = tid >> 6;
    const float* OG = p.out; const float* ORp = p.out + (size_t)LROWS * 512;
    const bf16_t* Z = (const bf16_t*)(p.ws + WS_Z); const bf16_t* RG = (const bf16_t*)(p.ws + WS_RG);
    const bf16_t* OGB = (const bf16_t*)(p.ws + WS_OGB); const bf16_t* ORB = (const bf16_t*)(p.ws + WS_ORB);
    bf16_t* Y = (bf16_t*)(p.ws + WS_Y);
    const int d0 = (lane & 15) * 8;
    float gg[8], rg_[8];
#pragma unroll
    for (int e = 0; e < 8; ++e) { gg[e] = p.gdn_norm_g[d0 + e]; rg_[e] = p.ret_norm_g[d0 + e]; }
#pragma unroll 2
    for (int R = blockIdx.x * 8 + w; R < LROWS; R += gridDim.x * 8) {
        const size_t prow = (size_t)(R >> 12) * TT + 256 + (R & 4095);
        { const f32x4 a = __builtin_nontemporal_load((const f32x4*)(OG + (size_t)R * 512 + lane * 8)), c = __builtin_nontemporal_load((const f32x4*)(OG + (size_t)R * 512 + lane * 8 + 4));
          const u32x4 sb = __builtin_nontemporal_load((const u32x4*)(OGB + (size_t)R * 512 + lane * 8));
          float v[8] = {a.x + bflo(sb.x), a.y + bfhi(sb.x), a.z + bflo(sb.y), a.w + bfhi(sb.y), c.x + bflo(sb.z), c.y + bfhi(sb.z), c.z + bflo(sb.w), c.w + bfhi(sb.w)}; float ss = 0;
#pragma unroll
          for (int e = 0; e < 8; ++e) ss += v[e] * v[e];
          ss += __shfl_xor(ss, 1); ss += __shfl_xor(ss, 2); ss += __shfl_xor(ss, 4); ss += __shfl_xor(ss, 8);
          const float rs = rsqrtf(ss * (1.f / 128.f) + 1e-6f);
          const u32x4 z = __builtin_nontemporal_load((const u32x4*)(Z + prow * 512 + lane * 8)); const unsigned zz[4] = {z.x, z.y, z.z, z.w}; unsigned o[4];
#pragma unroll
          for (int e = 0; e < 4; ++e) o[e] = pk2(v[2 * e] * rs * gg[2 * e] * silu_f(bflo(zz[e])), v[2 * e + 1] * rs * gg[2 * e + 1] * silu_f(bfhi(zz[e])));
          *(u32x4*)(Y + (size_t)R * 1024 + lane * 8) = (u32x4){o[0], o[1], o[2], o[3]}; }
        { const f32x4 a = __builtin_nontemporal_load((const f32x4*)(ORp + (size_t)R * 512 + lane * 8)), c = __builtin_nontemporal_load((const f32x4*)(ORp + (size_t)R * 512 + lane * 8 + 4));
          const u32x4 sb = __builtin_nontemporal_load((const u32x4*)(ORB + (size_t)R * 512 + lane * 8));
          float v[8] = {a.x + bflo(sb.x), a.y + bfhi(sb.x), a.z + bflo(sb.y), a.w + bfhi(sb.y), c.x + bflo(sb.z), c.y + bfhi(sb.z), c.z + bflo(sb.w), c.w + bfhi(sb.w)}; float s = 0;
#pragma unroll
          for (int e = 0; e < 8; ++e) s += v[e];
          s += __shfl_xor(s, 1); s += __shfl_xor(s, 2); s += __shfl_xor(s, 4); s += __shfl_xor(s, 8);
          const float mu = s * (1.f / 128.f); float ss = 0;
#pragma unroll
          for (int e = 0; e < 8; ++e) { v[e] -= mu; ss += v[e] * v[e]; }
          ss += __shfl_xor(ss, 1); ss += __shfl_xor(ss, 2); ss += __shfl_xor(ss, 4); ss += __shfl_xor(ss, 8);
          const float rs = rsqrtf(ss * (1.f / 128.f) + 1e-6f);
          const u32x4 z = __builtin_nontemporal_load((const u32x4*)(RG + prow * 512 + lane * 8)); const unsigned zz[4] = {z.x, z.y, z.z, z.w}; unsigned o[4];
#pragma unroll
          for (int e = 0; e < 4; ++e) o[e] = pk2(v[2 * e] * rs * rg_[2 * e] * silu_f(bflo(zz[e])), v[2 * e + 1] * rs * rg_[2 * e + 1] * silu_f(bfhi(zz[e])));
          *(u32x4*)(Y + (size_t)R * 1024 + 512 + lane * 8) = (u32x4){o[0], o[1], o[2], o[3]}; }
    }
    __syncthreads();
    bf16_t* WoT = (bf16_t*)(p.ws + WS_WOUTT); bf16_t* WfiT = (bf16_t*)(p.ws + WS_WFIT); bf16_t* WfoT = (bf16_t*)(p.ws + WS_WFOT);
    if (gridDim.x == 256) {
        for (int j = blockIdx.x; j < 1408; j += 2 * gridDim.x) { TD d[2];
#pragma unroll
            for (int u = 0; u < 2; ++u) { const int jj = j + u * gridDim.x, jc = jj < 1408 ? jj : j, kt = jc & 15, nt = jc >> 4, n0 = nt * 64, pn = n0 >> 8, bj = (n0 >> 7) & 1, i = n0 & 127;
                d[u] = TD{p.w_ffn_in, 5632, kt * 64, bj * 2816 + pn * 128 + i, WfiT, 1024, n0, jj < 1408}; }
            transpose2(d[0], d[1], L); }
    } else
    for (int j = blockIdx.x; j < 256 + 1408 + 704; j += gridDim.x) {
        if (j < 256) { const int kt = j & 15, nt = j >> 4; transpose_item(p.w_out, 1024, kt * 64, nt * 64, WoT, 1024, nt * 64, L); }
        else if (j < 256 + 1408) { const int jj = j - 256, kt = jj & 15, nt = jj >> 4, n0 = nt * 64;
            const int pn = n0 >> 8, bj = (n0 >> 7) & 1, i = n0 & 127; transpose_item(p.w_ffn_in, 5632, kt * 64, bj * 2816 + pn * 128 + i, WfiT, 1024, n0, L); }
        else { const int jj = j - 256 - 1408, kt = jj % 44, nt = jj / 44; transpose_item(p.w_ffn_out, 1024, kt * 64, nt * 64, WfoT, 2816, nt * 64, L); }
    }
}

DI void phase_norm2(const Params& p) {
    const int tid = threadIdx.x, lane = tid & 63, w = tid >> 6;
    const float* X1 = (const float*)(p.ws + WS_X1); const float* MOD = (const float*)(p.ws + WS_MOD); bf16_t* A3 = (bf16_t*)(p.ws + WS_A3);
    const int nwv = gridDim.x * 8;
    for (int R0 = blockIdx.x * 8 + w; R0 < LROWS; R0 += 2 * nwv) {
        f32x4 v[2][4]; int Rr[2]; bool ok[2];
#pragma unroll
        for (int u = 0; u < 2; ++u) { const int R = R0 + u * nwv; ok[u] = R < LROWS; Rr[u] = ok[u] ? R : R0; const float* src = X1 + (size_t)Rr[u] * 1024;
#pragma unroll
            for (int i = 0; i < 4; ++i) v[u][i] = *(const f32x4*)(src + (lane + 64 * i) * 4); }
        float ss[2];
#pragma unroll
        for (int u = 0; u < 2; ++u) { ss[u] = 0;
#pragma unroll
            for (int i = 0; i < 4; ++i) ss[u] += v[u][i].x * v[u][i].x + v[u][i].y * v[u][i].y + v[u][i].z * v[u][i].z + v[u][i].w * v[u][i].w; }
        for (int o = 32; o; o >>= 1) { ss[0] += __shfl_xor(ss[0], o); ss[1] += __shfl_xor(ss[1], o); }
#pragma unroll
        for (int u = 0; u < 2; ++u) { const float rstd = rsqrtf(ss[u] * (1.f / 1024.f) + 1e-6f); const float* mod = MOD + (size_t)(Rr[u] >> 12) * 6144;
#pragma unroll
            for (int i = 0; i < 4; ++i) { const int k = (lane + 64 * i) * 4;
                const f32x4 g = *(const f32x4*)(p.norm_ffn_g + k), sh = *(const f32x4*)(mod + 3072 + k), sc = *(const f32x4*)(mod + 4096 + k);
                const f32x4 hh = v[u][i] * rstd * g * (sc + 1.f) + sh;
                u32x2 o; o.x = pk2(hh.x, hh.y); o.y = pk2(hh.z, hh.w); if (ok[u]) *(u32x2*)(A3 + (size_t)Rr[u] * 1024 + k) = o; } }
    }
}
DI void phase_final(const Params& p) {
    const float* SSF = (const float*)(p.ws + WS_SSF);
    const int nth = gridDim.x * NT;
#pragma unroll 1
    for (int c0 = blockIdx.x * NT + threadIdx.x; c0 < LROWS * 256; c0 += 8 * nth) {
        f32x4 v[8]; float rs[8];
#pragma unroll
        for (int u = 0; u < 8; ++u) { const int c = c0 + u * nth; v[u] = __builtin_nontemporal_load((const f32x4*)(p.out + (size_t)c * 4)); rs[u] = SSF[c >> 8]; }
#pragma unroll
        for (int u = 0; u < 8; ++u) { const int c = c0 + u * nth; const f32x4 g = *(const f32x4*)(p.final_g + (c & 255) * 4);
            __builtin_nontemporal_store(v[u] * rsqrtf(rs[u] * (1.f / 1024.f) + 1e-6f) * g, (f32x4*)(p.out + (size_t)c * 4)); }
    }
}

#define XB_TMO      128
#define XB_XCNT(j)  (256  + 64 * (j))
#define XB_XSUB(j)  (1280 + 64 * (j))
#define XB_XGEN(j)  (2304 + 64 * (j))
#define XB_TOP      3328
#define XB_TOPGEN   3392
#define XCD_BAR_WORDS 3456
#define XB_SPIN_CAP (1u << 18)

__device__ __forceinline__ unsigned xb_ld(unsigned* p)              { return __hip_atomic_load(p, __ATOMIC_RELAXED, __HIP_MEMORY_SCOPE_AGENT); }
__device__ __forceinline__ unsigned xb_add(unsigned* p, unsigned v) { return __hip_atomic_fetch_add(p, v, __ATOMIC_RELAXED, __HIP_MEMORY_SCOPE_AGENT); }
__device__ __forceinline__ unsigned xb_xcc_id() { return (unsigned)__builtin_amdgcn_s_getreg((3 << 11) | 20) & 0xFu; }
#define XB_SPIN(cond, bar) do { unsigned _sp = 0; while (cond) { __builtin_amdgcn_s_sleep(1); \
    if ((++_sp & 255u) == 0u) { if (xb_ld(&(bar)[XB_TMO])) break; if (_sp > XB_SPIN_CAP) { atomicAdd(&(bar)[XB_TMO], 1u); break; } } } } while (0)

struct XcdBarrier {
    unsigned* bar; unsigned x;
    volatile LAS unsigned* st;
};

__device__ __forceinline__ XcdBarrier xcd_barrier_post(unsigned* bar, volatile LAS unsigned* st) {
    XcdBarrier b; b.bar = bar; b.x = xb_xcc_id(); b.st = st;
    if (threadIdx.x == 0) (void)xb_add(&bar[XB_XCNT(b.x)], 1u);
    return b;
}
__device__ __forceinline__ void xcd_barrier_complete(unsigned* bar, unsigned x, unsigned& nloc, unsigned& nx) {
    const unsigned G = gridDim.x * gridDim.y * gridDim.z;
    unsigned sum, cnt, mine, sp = 0u;
    for (;;) {
        sum = 0u; cnt = 0u; mine = 0u;
#pragma unroll
        for (unsigned j = 0; j < 16; ++j) { const unsigned c = xb_ld(&bar[XB_XCNT(j)]); sum += c; cnt += (c > 0u) ? 1u : 0u; mine = (j == x) ? c : mine; }
        if (sum == G) break;
        __builtin_amdgcn_s_sleep(1);
        if ((++sp & 255u) == 0u) { if (xb_ld(&bar[XB_TMO])) break; if (sp > XB_SPIN_CAP) { atomicAdd(&bar[XB_TMO], 1u); break; } }
    }
    nloc = mine > 0u ? mine : 1u; nx = cnt > 0u ? cnt : 1u;
}

__device__ __forceinline__ void xcd_barrier(const XcdBarrier& b) {
    asm volatile("s_waitcnt vmcnt(0)" ::: "memory");
    __syncthreads();
    if (threadIdx.x == 0) {
        unsigned* bar = b.bar;
        __builtin_amdgcn_s_waitcnt(0);
        unsigned nloc = b.st[0], nx = b.st[1];
        if (nloc == 0u) { xcd_barrier_complete(bar, b.x, nloc, nx); b.st[0] = nloc; b.st[1] = nx; }
        const unsigned old = xb_add(&bar[XB_XSUB(b.x)], 1u);
        const unsigned gen = old / nloc;
        if (old + 1u == (gen + 1u) * nloc) {
            __builtin_amdgcn_fence(__ATOMIC_RELEASE, "agent");
            asm volatile("s_waitcnt vmcnt(0)" ::: "memory");
            const unsigned og = xb_add(&bar[XB_TOP], 1u);
            const unsigned tg = og / nx;
            if (og + 1u == (tg + 1u) * nx) xb_add(&bar[XB_TOPGEN], 1u);
            else XB_SPIN(xb_ld(&bar[XB_TOPGEN]) == tg, bar);
            __builtin_amdgcn_fence(__ATOMIC_ACQUIRE, "agent");
            xb_add(&bar[XB_XGEN(b.x)], 1u);
            asm volatile("s_waitcnt vmcnt(0)" ::: "memory");
        } else {
            XB_SPIN(xb_ld(&bar[XB_XGEN(b.x)]) == gen, bar);
            __builtin_amdgcn_fence(__ATOMIC_ACQUIRE, "agent");
            asm volatile("s_waitcnt vmcnt(0)" ::: "memory");
        }
    }
    __syncthreads();
}

#ifndef GEMM_ALIGN
#define GEMM_ALIGN true
#endif
#ifndef GEMM_SP2
#define GEMM_SP2 true
#endif
__global__ void __launch_bounds__(NT) mega_fwd(Params p) {
    extern __shared__ __attribute__((aligned(16))) unsigned char lds_raw[];
    ldsp L = (ldsp)lds_raw;
    cg::grid_group grid = cg::this_grid();
    const int lo = p.ph_lo, hi = p.ph_hi;
#ifndef PHMASK
#define PHMASK 0xFFF
#endif
#define IN(k) (((PHMASK >> (k)) & 1) && lo <= (k) && (k) < hi)
    volatile LAS unsigned* xst = (volatile LAS unsigned*)(L + 149000);
    if (threadIdx.x == 0) { xst[0] = 0u; xst[1] = 0u; }
    __syncthreads();
    if (p.pad == 0x5a5a) grid.sync();
    const XcdBarrier xbar = xcd_barrier_post((unsigned*)(p.ws + WS_BAR), xst);
#define SEAM(k) do { if ((k) + 1 < hi) xcd_barrier(xbar); } while (0)
#ifndef DUPMASK
#define DUPMASK 0
#endif
#define NREP(k) (((DUPMASK >> (k)) & 1) ? 2 : 1)
    if (IN(0)) { { phase0(p, L); __syncthreads(); } SEAM(0); }
    if (IN(1)) { { phase1(p, L); __syncthreads(); } SEAM(1); }
    if (IN(2)) { { pg8::Gemm g{(const bf16_t*)(p.ws + WS_A1), (const bf16_t*)(p.ws + WS_WINT), MROWS, N1, 1024}; pg8::StaticOrder S; S.init(MROWS, N1, gridDim.x, blockIdx.x);
        EpiP E{(bf16_t*)(p.ws + WS_P), (float*)(p.ws + WS_GATES)}; pg8::gemm_phase<EpiP, pg8::StaticOrder, GEMM_ALIGN, GEMM_SP2>(L, g, S, E); } SEAM(2); }
    if (IN(3)) { phase_conv(p); SEAM(3); }
    if (IN(4)) { { const bool dry = p.dry != 0;
        if (gridDim.x == 256) {
            const int bx = blockIdx.x;
            for (int it = bx; it < 1088; it += 256) prep_gdn(p, L, it, dry);
            if (bx < 64) { prep_ret(p, L, bx * 2, dry); prep_ret(p, L, bx * 2 + 1, dry); }
            else { for (int j = 0; j < 5; ++j) prep_ret(p, L, 128 + (bx - 64) * 5 + j, dry); }
        } else { for (int it = blockIdx.x; it < 2176; it += gridDim.x) { if (it < 1088) prep_gdn(p, L, it, dry); else prep_ret(p, L, it - 1088, dry); } } } SEAM(4); }
    if (IN(5)) { { const float osc = p.dry ? 0.f : 1.f; for (int bx = blockIdx.x; bx < 256; bx += gridDim.x) { const int xx = bx & 7, yy = bx >> 3, slice = yy & 3, G = (yy >> 2) * 8 + xx;
            const int ty = G >> 5, dir = G & 1, h = (G >> 1) & 3, b = (G >> 3) & 3;
            if (ty == 0) scan_gdn(p, L, b, h, dir, slice, osc); else scan_ret(p, L, b, h, dir, slice, osc); __syncthreads();
            if (ty == 1 && gridDim.x == 256) {
                bf16_t* WoT = (bf16_t*)(p.ws + WS_WOUTT); bf16_t* WfoT = (bf16_t*)(p.ws + WS_WFOT);
                for (int j = bx - 128; j < 960; j += 128) { if (j < 256) { const int kt = j & 15, nt = j >> 4; transpose_item(p.w_out, 1024, kt * 64, nt * 64, WoT, 1024, nt * 64, L); }
                    else { const int jj = j - 256, kt = jj % 44, nt = jj / 44; transpose_item(p.w_ffn_out, 1024, kt * 64, nt * 64, WfoT, 2816, nt * 64, L); } } } } } SEAM(5); }
    if (IN(6)) { { phase_postnorm(p, L); __syncthreads(); } SEAM(6); }
    if (IN(7)) { { pg8::Gemm g{(const bf16_t*)(p.ws + WS_Y), (const bf16_t*)(p.ws + WS_WOUTT), LROWS, 1024, 1024}; pg8::StaticOrder S; S.init(LROWS, 1024, gridDim.x, blockIdx.x);
        EpiRes2 E{(bf16_t*)(p.ws + WS_X1B), p.x, (const float*)(p.ws + WS_MOD), p.norm_ffn_g, (bf16_t*)(p.ws + WS_A3), (float*)(p.ws + WS_SS)}; pg8::gemm_phase<EpiRes2, pg8::StaticOrder, GEMM_ALIGN, GEMM_SP2>(L, g, S, E); } SEAM(7); }
    if (IN(9)) { { pg8::Gemm g{(const bf16_t*)(p.ws + WS_A3), (const bf16_t*)(p.ws + WS_WFIT), LROWS, 5632, 1024}; pg8::StaticOrder S; S.init(LROWS, 5632, gridDim.x, blockIdx.x);
        EpiGLU2 E{(bf16_t*)(p.ws + WS_H), (const float*)(p.ws + WS_SS), (const float*)(p.ws + WS_BIAS2)}; pg8::gemm_phase<EpiGLU2, pg8::StaticOrder, GEMM_ALIGN, GEMM_SP2>(L, g, S, E); } SEAM(9); }
    if (IN(10)) { { pg8::Gemm g{(const bf16_t*)(p.ws + WS_H), (const bf16_t*)(p.ws + WS_WFOT), LROWS, 1024, 2816}; pg8::StaticOrder S; S.init(LROWS, 1024, gridDim.x, blockIdx.x);
        EpiRes3 E{p.out, (const bf16_t*)(p.ws + WS_X1B), (const float*)(p.ws + WS_MOD) + 5120, (float*)(p.ws + WS_SSF)}; pg8::gemm_phase<EpiRes3, pg8::StaticOrder, GEMM_ALIGN, GEMM_SP2>(L, g, S, E); } SEAM(10); }
    if (IN(11)) { phase_final(p); }
}

extern "C" void kernel_launch(void* const* d_in, const int* in_sizes, int n_in, void* d_out, int out_size, void* d_ws, size_t ws_size, hipStream_t stream) {
    static int grid_blocks = 0;
    if (!grid_blocks) {
        int dev = 0, cus = 0, per_cu = 0;
        hipGetDevice(&dev);
        hipDeviceGetAttribute(&cus, hipDeviceAttributeMultiprocessorCount, dev);
        if (hipFuncSetAttribute((const void*)mega_fwd, hipFuncAttributeMaxDynamicSharedMemorySize, LDS_BYTES) != hipSuccess) fprintf(stderr, "hipFuncSetAttribute failed\n");
        hipOccupancyMaxActiveBlocksPerMultiprocessor(&per_cu, (const void*)mega_fwd, NT, LDS_BYTES);
        if (per_cu < 1) per_cu = 1;
        grid_blocks = cus * per_cu;
        if (grid_blocks > 256) grid_blocks = 256;
    }
#ifndef PROBE_SEQ
#define PROBE_SEQ {0, 12, 0}
#endif
    static const int seq[][3] = {PROBE_SEQ};
    hipError_t e = hipSuccess;
    for (unsigned li = 0; li < sizeof(seq) / sizeof(seq[0]); ++li) {
        Params p{};
        const float** f = (const float**)&p;
        for (int i = 0; i < 19; ++i) f[i] = (const float*)d_in[i];
        p.out = (float*)d_out; p.ws = (unsigned char*)d_ws; p.ph_lo = seq[li][0]; p.ph_hi = seq[li][1]; p.dry = seq[li][2]; p.pad = 0;
        void* args[] = {&p};
        if (hipMemsetAsync((unsigned char*)d_ws + WS_BAR, 0, 3456 * 4, stream) != hipSuccess) fprintf(stderr, "barrier memset failed\n");
        e = hipLaunchCooperativeKernel((const void*)mega_fwd, dim3(grid_blocks), dim3(NT), args, LDS_BYTES, stream);
        if (e != hipSuccess) break;
    }
    if (e != hipSuccess) fprintf(stderr, "cooperative launch failed: %s (grid %d)\n", hipGetErrorString(e), grid_blocks);
}
```

```cpp
#include <hip/hip_runtime.h>
#include <hip/hip_cooperative_groups.h>
#include <cstdio>
namespace cg = cooperative_groups;
namespace pg8 {
#define PG8_LAS __attribute__((address_space(3)))
typedef unsigned short bf16_t;
typedef short bf16x8 __attribute__((ext_vector_type(8)));
typedef float f32x4 __attribute__((ext_vector_type(4)));
typedef unsigned u32x4 __attribute__((ext_vector_type(4)));
constexpr int BM = 256, BK = 64, HALF = 128, HTB = HALF * BK * 2  , STAGE_BYTES = 8 * HTB, NXCD = 8, WGM = 8;

__host__ __device__ __forceinline__ int lds_byte(int r, int c) { const int st = (r >> 4) * 2 + (c >> 5), rr = r & 15, cc = c & 31, ob = rr * 64 + cc * 2; return st * 1024 + (ob ^ (((ob >> 9) & 1) << 5)); }
__host__ __device__ __forceinline__ void stage_rc(int b, int& R, int& C) { const int st = b / 1024, sb = b % 1024, swz = sb ^ (((sb >> 9) & 1) << 5); R = (st >> 1) * 16 + swz / 64; C = (st & 1) * 32 + (swz % 64) / 2; }
__host__ __device__ __forceinline__ int perm32(int rho) { const int n = rho >> 4, i = rho & 15; return 8 * (i >> 2) + 4 * n + (i & 3); }

struct Unit { int pm, pn; };
struct Gemm { const bf16_t* A; const bf16_t* Bt; int M, N, K; };

struct StaticOrder {
    int nM, nN, nwg, G, c;
    __host__ __device__ void init(int M, int N, int G_, int c_) { nM = M / BM; nN = N / BM; nwg = nM * nN; G = G_; c = c_; }
    __host__ __device__ bool next(int i, Unit& u) const {
        const long L = (long)i * G + c; if (L >= nwg) return false;
        int wgid = (int)L; { const int q = nwg / NXCD, r = nwg % NXCD, xcd = wgid % NXCD, off = wgid / NXCD; wgid = (xcd < r ? xcd * (q + 1) : r * (q + 1) + (xcd - r) * q) + off; }
        const int nig = WGM * nN, gid = wgid / nig, fm = gid * WGM, gsz = (nM - fm) < WGM ? (nM - fm) : WGM;
        u.pm = fm + ((wgid % nig) % gsz); u.pn = (wgid % nig) / gsz; return true;
    }
    __device__ __forceinline__ void a_ready(const Unit&) const {}
    __device__ __forceinline__ void done(const Unit&) const {}
};

__device__ __forceinline__ unsigned cvt_pk_bf16(float lo, float hi) { unsigned r; asm volatile("v_cvt_pk_bf16_f32 %0, %1, %2" : "=v"(r) : "v"(lo), "v"(hi)); return r; }
template <class Epi, class Sched, bool ALIGN_EPI = false, bool SP2 = false>
__device__ __forceinline__ void gemm_phase(PG8_LAS unsigned char* lds, const Gemm g, const Sched& S, const Epi& E) {
    const int tid = threadIdx.x, wid = __builtin_amdgcn_readfirstlane(tid >> 6), lane = tid & 63, wr = wid >> 2, wc = wid & 3, fr = lane & 15, fq = lane >> 4;
    const int K = g.K, nt = K / BK;
    unsigned voffA[2], voffB[2];
#pragma unroll
    for (int i = 0; i < 2; ++i) { int R, C; stage_rc(tid * 16 + i * 8192, R, C); const int Rb = Epi::PERM ? ((R & ~31) + perm32(R & 31)) : R;
        voffA[i] = (unsigned)(R * K + C) * 2u; voffB[i] = (unsigned)(Rb * K + C) * 2u; }
    const size_t kstep = (size_t)(BK * 2);
    const size_t hstep = (size_t)HALF * K * 2;
    const size_t tstep = 2 * hstep;
    const unsigned ldsw = (unsigned)wid * 1024u;
    const int aoff = lds_byte(wr * 64 + fr, fq * 8), boff = lds_byte(wc * 32 + fr, fq * 8);
#define PG8_SA(b, h) (((b) * 2 + (h)) * HTB)
#define PG8_SB(b, h) ((4 + (b) * 2 + (h)) * HTB)
#define PG8_STAGE(bufoff, gbase, voff) do { _Pragma("unroll") for (int _i = 0; _i < 2; ++_i) \
        __builtin_amdgcn_global_load_lds((const unsigned*)((const char*)(gbase) + (voff)[_i]), (PG8_LAS unsigned*)(lds + (bufoff) + ldsw + _i * 8192), 16, 0, 0); } while (0)
#define PG8_LDA(dst, b, h) do { _Pragma("unroll") for (int m = 0; m < 4; ++m) _Pragma("unroll") for (int k = 0; k < 2; ++k) dst[m][k] = *(const PG8_LAS bf16x8*)(lds + PG8_SA(b, h) + aoff + m * 2048 + k * 1024); } while (0)
#define PG8_LDB(dst, b, h) do { _Pragma("unroll") for (int n = 0; n < 2; ++n) _Pragma("unroll") for (int k = 0; k < 2; ++k) dst[n][k] = *(const PG8_LAS bf16x8*)(lds + PG8_SB(b, h) + boff + n * 2048 + k * 1024); } while (0)
#define PG8_MMA(ai, bj, At, Bt) do { __builtin_amdgcn_s_setprio(1); _Pragma("unroll") for (int m = 0; m < 4; ++m) _Pragma("unroll") for (int n = 0; n < 2; ++n) _Pragma("unroll") for (int k = 0; k < 2; ++k) \
        acc[ai][bj][m][n] = __builtin_amdgcn_mfma_f32_16x16x32_bf16(Bt[n][k], At[m][k], acc[ai][bj][m][n], 0, 0, 0); __builtin_amdgcn_s_setprio(0); } while (0)
#define PG8_WAIT_V(n) asm volatile("s_waitcnt vmcnt(" #n ")" ::: "memory")
#define PG8_WAIT_L(n) asm volatile("s_waitcnt lgkmcnt(" #n ")" ::: "memory")
#define PG8_BAR __builtin_amdgcn_s_barrier()
#define PG8_SCHED __builtin_amdgcn_sched_barrier(0)
    Unit cur, nxt; int ui = 0;
    if (!S.next(0, cur)) return;
    f32x4 acc[2][2][4][2];
#pragma unroll
    for (int a = 0; a < 2; ++a)
#pragma unroll
        for (int b = 0; b < 2; ++b)
#pragma unroll
            for (int m = 0; m < 4; ++m)
#pragma unroll
                for (int n = 0; n < 2; ++n) acc[a][b][m][n] = (f32x4){0.f, 0.f, 0.f, 0.f};
    bf16x8 At[4][2], B0[2][2], B1[2][2];
    const char* cA = (const char*)g.A + (size_t)cur.pm * tstep; const char* cB = (const char*)g.Bt + (size_t)cur.pn * tstep;
    S.a_ready(cur);
    if constexpr (SP2) {
        PG8_STAGE(PG8_SB(0, 0), cB, voffB); PG8_STAGE(PG8_SB(0, 1), cB + hstep, voffB); PG8_STAGE(PG8_SA(0, 0), cA, voffA); PG8_STAGE(PG8_SA(0, 1), cA + hstep, voffA);
        if (wr == 1) PG8_BAR;
        PG8_WAIT_V(2); PG8_BAR;
        PG8_STAGE(PG8_SB(1, 0), cB + kstep, voffB); PG8_STAGE(PG8_SA(1, 0), cA + kstep, voffA); PG8_STAGE(PG8_SB(1, 1), cB + hstep + kstep, voffB);
        PG8_WAIT_V(6); PG8_BAR;
    } else {
        PG8_STAGE(PG8_SB(0, 0), cB, voffB); PG8_STAGE(PG8_SA(0, 0), cA, voffA); PG8_STAGE(PG8_SB(0, 1), cB + hstep, voffB); PG8_STAGE(PG8_SA(0, 1), cA + hstep, voffA);
        if (wr == 1) PG8_BAR;
        PG8_WAIT_V(4); PG8_BAR;
        PG8_STAGE(PG8_SB(1, 0), cB + kstep, voffB); PG8_STAGE(PG8_SA(1, 0), cA + kstep, voffA); PG8_STAGE(PG8_SB(1, 1), cB + hstep + kstep, voffB);
        PG8_WAIT_V(6); PG8_BAR;
    }
    for (;;) {
        const bool has_next = S.next(ui + 1, nxt);
        const char* nA = has_next ? (const char*)g.A + (size_t)nxt.pm * tstep : cA; const char* nB = has_next ? (const char*)g.Bt + (size_t)nxt.pn * tstep : cB;
        for (int t = 0; t < nt; t += 2) {
            const bool last = (t == nt - 2);
            const char* a1 = cA + (size_t)(t + 1) * kstep;
            const char* a2 = last ? nA : cA + (size_t)(t + 2) * kstep; const char* b2 = last ? nB : cB + (size_t)(t + 2) * kstep;
            const char* a3 = a2 + kstep; const char* b3 = b2 + kstep;
            if (last && has_next) S.a_ready(nxt);
            if constexpr (SP2) {
            PG8_LDB(B0, 0, 0); PG8_LDB(B1, 0, 1); PG8_SCHED; PG8_LDA(At, 0, 0); PG8_STAGE(PG8_SA(1, 1), a1 + hstep, voffA);
            PG8_WAIT_V(8); PG8_WAIT_L(0); PG8_BAR; PG8_MMA(0, 0, At, B0); PG8_MMA(0, 1, At, B1); PG8_BAR; PG8_SCHED;
            PG8_LDA(At, 0, 1); PG8_STAGE(PG8_SB(0, 0), b2, voffB); PG8_STAGE(PG8_SB(0, 1), b2 + hstep, voffB); PG8_STAGE(PG8_SA(0, 0), a2, voffA);
            PG8_WAIT_V(8); PG8_WAIT_L(0); PG8_BAR; PG8_MMA(1, 0, At, B0); PG8_MMA(1, 1, At, B1); PG8_BAR; PG8_SCHED;
            PG8_LDB(B0, 1, 0); PG8_LDB(B1, 1, 1); PG8_SCHED; PG8_LDA(At, 1, 0); PG8_STAGE(PG8_SA(0, 1), a2 + hstep, voffA);
            PG8_WAIT_V(8); PG8_WAIT_L(0); PG8_BAR; PG8_MMA(0, 0, At, B0); PG8_MMA(0, 1, At, B1); PG8_BAR; PG8_SCHED;
            PG8_LDA(At, 1, 1); PG8_STAGE(PG8_SB(1, 0), b3, voffB); PG8_STAGE(PG8_SB(1, 1), b3 + hstep, voffB); PG8_STAGE(PG8_SA(1, 0), a3, voffA);
            PG8_WAIT_V(8); PG8_WAIT_L(0); PG8_BAR; PG8_MMA(1, 0, At, B0); PG8_MMA(1, 1, At, B1); PG8_BAR; PG8_SCHED;
            } else {
            PG8_LDB(B0, 0, 0); PG8_SCHED; PG8_LDA(At, 0, 0); PG8_STAGE(PG8_SA(1, 1), a1 + hstep, voffA);
            PG8_WAIT_L(8); PG8_BAR; PG8_WAIT_L(0); PG8_MMA(0, 0, At, B0); PG8_BAR; PG8_SCHED;
            PG8_LDB(B1, 0, 1); PG8_STAGE(PG8_SB(0, 0), b2, voffB);
            PG8_BAR; PG8_WAIT_L(0); PG8_MMA(0, 1, At, B1); PG8_BAR;
            PG8_LDA(At, 0, 1); PG8_STAGE(PG8_SA(0, 0), a2, voffA);
            PG8_BAR; PG8_WAIT_L(0); PG8_MMA(1, 0, At, B0); PG8_BAR; PG8_SCHED;
            PG8_STAGE(PG8_SB(0, 1), b2 + hstep, voffB);
            PG8_WAIT_V(6); PG8_BAR; PG8_MMA(1, 1, At, B1); PG8_BAR;
            PG8_LDB(B0, 1, 0); PG8_SCHED; PG8_LDA(At, 1, 0); PG8_STAGE(PG8_SA(0, 1), a2 + hstep, voffA);
            PG8_WAIT_L(8); PG8_BAR; PG8_WAIT_L(0); PG8_MMA(0, 0, At, B0); PG8_BAR; PG8_SCHED;
            PG8_LDB(B1, 1, 1); PG8_STAGE(PG8_SB(1, 0), b3, voffB);
            PG8_BAR; PG8_WAIT_L(0); PG8_MMA(0, 1, At, B1); PG8_BAR;
            PG8_LDA(At, 1, 1); PG8_STAGE(PG8_SA(1, 0), a3, voffA);
            PG8_BAR; PG8_WAIT_L(0); PG8_MMA(1, 0, At, B0); PG8_BAR; PG8_SCHED;
            PG8_STAGE(PG8_SB(1, 1), b3 + hstep, voffB);
            PG8_WAIT_V(6); PG8_BAR; PG8_MMA(1, 1, At, B1); PG8_BAR;
            }
        }
        if constexpr (ALIGN_EPI) { if (wr == 0) PG8_BAR; }
        if constexpr (!Epi::AFTER_DRAIN) { E(acc, cur, wr, wc, fr, fq); S.done(cur); }
        if (!has_next) break;
#pragma unroll
        for (int a = 0; a < 2; ++a)
#pragma unroll
            for (int b = 0; b < 2; ++b)
#pragma unroll
                for (int m = 0; m < 4; ++m)
#pragma unroll
                    for (int n = 0; n < 2; ++n) acc[a][b][m][n] = (f32x4){0.f, 0.f, 0.f, 0.f};
        cur = nxt; cA = nA; cB = nB; ++ui;
        if constexpr (ALIGN_EPI) { if (wr == 1) PG8_BAR; }
    }
    PG8_WAIT_V(0);
    if constexpr (!ALIGN_EPI) { if (wr == 0) PG8_BAR; }
    PG8_BAR;
    if constexpr (Epi::AFTER_DRAIN) { E.fused(acc, cur, wr, wc, fr, fq, lds, wid, lane); S.done(cur); }
#undef PG8_SA
#undef PG8_SB
#undef PG8_STAGE
#undef PG8_LDA
#undef PG8_LDB
#undef PG8_MMA
#undef PG8_WAIT_V
#undef PG8_WAIT_L
#undef PG8_BAR
#undef PG8_SCHED
}
}

#define DI __device__ __forceinline__
#define LAS __attribute__((address_space(3)))
typedef LAS unsigned char* ldsp;
typedef unsigned short bf16_t;
typedef short bf16x8 __attribute__((ext_vector_type(8)));
typedef float f32x4 __attribute__((ext_vector_type(4)));
typedef unsigned u32x4 __attribute__((ext_vector_type(4)));
typedef unsigned u32x2 __attribute__((ext_vector_type(2)));
#define MFMA16(a, b, c) __builtin_amdgcn_mfma_f32_16x16x32_bf16((a), (b), (c), 0, 0, 0)

constexpr int NT = 512;
constexpr int TT = 4352, MROWS = 17408, LROWS = 16384;
constexpr size_t MiB = (size_t)1 << 20;
constexpr size_t PBUF = 17 * MiB;
constexpr int LDS_BYTES = 149504;
constexpr size_t WS_MOD = 0, WS_GATES = 256 * 1024, WS_SS = 2 * MiB, WS_BIAS2 = 2 * MiB + 256 * 1024, WS_SSF = 2 * MiB + 512 * 1024, WS_BAR = 3 * MiB;
constexpr size_t WS_WINT = 3 * MiB + 512 * 1024, WS_A1 = 12 * MiB, WS_P = 46 * MiB;
constexpr int N1 = 4352;
constexpr size_t WS_QP = WS_P, WS_KP = WS_P + PBUF, WS_VP = WS_P + 2 * PBUF, WS_Z = WS_P + 3 * PBUF, WS_RQ = WS_P + 4 * PBUF, WS_RK = WS_P + 5 * PBUF, WS_RV = WS_P + 6 * PBUF, WS_RG = WS_P + 7 * PBUF;
constexpr size_t WS_QC = 4 * MiB, WS_KC = 21 * MiB, WS_VC = 182 * MiB;
constexpr size_t WS_WF = 46 * MiB, WS_UF = 63 * MiB, WS_QF = 80 * MiB, WS_WB = 199 * MiB, WS_UB = 216 * MiB, WS_QB = 233 * MiB;
constexpr size_t WS_DEC = 250 * MiB;
constexpr size_t WS_Y = 199 * MiB, WS_WOUTT = 38 * MiB, WS_WFOT = 40 * MiB, WS_WFIT = 49 * MiB;
constexpr size_t WS_X1B = 4 * MiB;
constexpr size_t WS_OGB = 4 * MiB, WS_ORB = 182 * MiB;
constexpr size_t WS_X1 = 182 * MiB, WS_A3 = 60 * MiB, WS_H = 92 * MiB;

struct Params {
    const float *x, *c, *ctx, *c_ctx, *ada_w, *ada_b, *norm_mix_g, *norm_ffn_g, *w_in, *conv_w, *a_log, *dt_bias, *gdn_norm_g, *ret_logit, *ret_norm_g, *w_out, *w_ffn_in, *w_ffn_out, *final_g;
    float* out; unsigned char* ws; int ph_lo, ph_hi, dry, pad;
};

DI unsigned short f2bf(float f) { unsigned u = __float_as_uint(f); return (unsigned short)((u + 0x7fffu + ((u >> 16) & 1u)) >> 16); }
DI float bf2f(unsigned v) { return __uint_as_float(v << 16); }
typedef float f32x2_t __attribute__((ext_vector_type(2)));
typedef __bf16 bf16x2_t __attribute__((ext_vector_type(2)));
DI unsigned pk2(float lo, float hi) { const f32x2_t v = {lo, hi}; const bf16x2_t b = __builtin_convertvector(v, bf16x2_t); return __builtin_bit_cast(unsigned, b); }
DI float bflo(unsigned v) { return __uint_as_float(v << 16); }
DI float bfhi(unsigned v) { return __uint_as_float(v & 0xffff0000u); }
DI float silu_f(float x) { return x * __builtin_amdgcn_rcpf(1.f + __expf(-x)); }
DI float sigm_f(float x) { return __builtin_amdgcn_rcpf(1.f + __expf(-x)); }
DI float softplus_f(float x) { return fmaxf(x, 0.f) + log1pf(__expf(-fabsf(x))); }
DI float wave_sum(float v) { for (int o = 32; o; o >>= 1) v += __shfl_xor(v, o); return v; }
DI bf16x8 lds16(ldsp p) { return *(const LAS bf16x8*)p; }
DI void lds_barrier() { asm volatile("s_waitcnt lgkmcnt(0)\n\ts_barrier" ::: "memory"); }

DI void transpose_item(const float* W, int ldw, int k0, int srccol0, bf16_t* WT, int Kdim, int nout0, ldsp L) {
    const int tid = threadIdx.x;
    LAS float* scr = (LAS float*)L;
    for (int e = tid; e < 4096; e += NT) { const int kk = e >> 6, cc = e & 63; scr[kk * 65 + cc] = W[(size_t)(k0 + kk) * ldw + srccol0 + cc]; }
    __syncthreads();
    { const int n = tid >> 3, k8 = (tid & 7) * 8; u32x4 o;
      o.x = pk2(scr[(k8 + 0) * 65 + n], scr[(k8 + 1) * 65 + n]); o.y = pk2(scr[(k8 + 2) * 65 + n], scr[(k8 + 3) * 65 + n]);
      o.z = pk2(scr[(k8 + 4) * 65 + n], scr[(k8 + 5) * 65 + n]); o.w = pk2(scr[(k8 + 6) * 65 + n], scr[(k8 + 7) * 65 + n]);
      *(u32x4*)(WT + (size_t)(nout0 + n) * Kdim + k0 + k8) = o; }
    __syncthreads();
}

struct TD { const float* W; int ldw, k0, src; bf16_t* WT; int Kd, n0; bool on; };
DI void transpose2(const TD a, const TD b, ldsp L) {
    const int tid = threadIdx.x;
    LAS float* sa = (LAS float*)L; LAS float* sb = sa + 64 * 65;
    float va[8], vb[8];
#pragma unroll
    for (int i = 0; i < 8; ++i) { const int e = tid + i * NT, kk = e >> 6, cc = e & 63;
        va[i] = a.W[(size_t)(a.k0 + kk) * a.ldw + a.src + cc]; vb[i] = b.on ? b.W[(size_t)(b.k0 + kk) * b.ldw + b.src + cc] : 0.f; }
#pragma unroll
    for (int i = 0; i < 8; ++i) { const int e = tid + i * NT, kk = e >> 6, cc = e & 63; sa[kk * 65 + cc] = va[i]; sb[kk * 65 + cc] = vb[i]; }
    __syncthreads();
    { const int n = tid >> 3, k8 = (tid & 7) * 8; u32x4 o;
      o.x = pk2(sa[(k8 + 0) * 65 + n], sa[(k8 + 1) * 65 + n]); o.y = pk2(sa[(k8 + 2) * 65 + n], sa[(k8 + 3) * 65 + n]); o.z = pk2(sa[(k8 + 4) * 65 + n], sa[(k8 + 5) * 65 + n]); o.w = pk2(sa[(k8 + 6) * 65 + n], sa[(k8 + 7) * 65 + n]);
      *(u32x4*)(a.WT + (size_t)(a.n0 + n) * a.Kd + a.k0 + k8) = o;
      if (b.on) { o.x = pk2(sb[(k8 + 0) * 65 + n], sb[(k8 + 1) * 65 + n]); o.y = pk2(sb[(k8 + 2) * 65 + n], sb[(k8 + 3) * 65 + n]); o.z = pk2(sb[(k8 + 4) * 65 + n], sb[(k8 + 5) * 65 + n]); o.w = pk2(sb[(k8 + 6) * 65 + n], sb[(k8 + 7) * 65 + n]);
          *(u32x4*)(b.WT + (size_t)(b.n0 + n) * b.Kd + b.k0 + k8) = o; } }
    __syncthreads();
}
DI void phase0(const Params& p, ldsp L) {
    const int tid = threadIdx.x;
    float* MOD = (float*)(p.ws + WS_MOD);
    if (blockIdx.x < 192) {
        LAS float* sc = (LAS float*)L; LAS float* red = sc + 5120;
        for (int e = tid; e < 5120; e += NT) { const int r = e >> 10, k = e & 1023; const float v = r < 4 ? p.c[r * 1024 + k] : p.c_ctx[k]; sc[e] = silu_f(v); }
        __syncthreads();
        for (int it = blockIdx.x; it < 192; it += gridDim.x) {
            const int cl = tid & 31, kg = tid >> 5, col = it * 32 + cl;
            float a0 = 0, a1 = 0, a2 = 0, a3 = 0, a4 = 0;
#pragma unroll 64
            for (int k = kg * 64; k < kg * 64 + 64; ++k) { const float w = p.ada_w[(size_t)k * 6144 + col]; a0 += sc[k] * w; a1 += sc[1024 + k] * w; a2 += sc[2048 + k] * w; a3 += sc[3072 + k] * w; a4 += sc[4096 + k] * w; }
            red[(kg * 5 + 0) * 32 + cl] = a0; red[(kg * 5 + 1) * 32 + cl] = a1; red[(kg * 5 + 2) * 32 + cl] = a2; red[(kg * 5 + 3) * 32 + cl] = a3; red[(kg * 5 + 4) * 32 + cl] = a4;
            __syncthreads();
            if (tid < 160) { const int r = tid >> 5; float s = 0; for (int g = 0; g < 16; ++g) s += red[(g * 5 + r) * 32 + cl]; MOD[r * 6144 + col] = s + p.ada_b[col]; }
            __syncthreads();
        }
    }
    { unsigned* zw = (unsigned*)(p.ws + WS_WINT + (size_t)4160 * 2048); for (int e = blockIdx.x * NT + tid; e < 192 * 512; e += gridDim.x * NT) zw[e] = 0u; }
    { float* zs = (float*)(p.ws + WS_SS); float* zf = (float*)(p.ws + WS_SSF); for (int e = blockIdx.x * NT + tid; e < 16384; e += gridDim.x * NT) { zs[e] = 0.f; zf[e] = 0.f; }
      float* zb = (float*)(p.ws + WS_BIAS2); for (int e = blockIdx.x * NT + tid; e < 4 * 5632; e += gridDim.x * NT) zb[e] = 0.f; }
}

DI void phase1(const Params& p, ldsp L) {
    const int tid = threadIdx.x, lane = tid & 63, w = tid >> 6;
    const float* MOD = (const float*)(p.ws + WS_MOD);
    bf16_t* A1 = (bf16_t*)(p.ws + WS_A1);
    const int nwv = gridDim.x * 8;
    for (int R0 = blockIdx.x * 8 + w; R0 < MROWS; R0 += 2 * nwv) {
        f32x4 v[2][4]; const float* mod[2]; int Rr[2]; bool ok[2];
#pragma unroll
        for (int u = 0; u < 2; ++u) { const int R = R0 + u * nwv; ok[u] = R < MROWS; const int Rc = ok[u] ? R : R0; Rr[u] = Rc; const int b = Rc / TT, t = Rc % TT;
            const float* src = t < 256 ? p.ctx + ((size_t)b * 256 + t) * 1024 : p.x + ((size_t)b * 4096 + (t - 256)) * 1024; mod[u] = MOD + (t < 256 ? 4 : b) * 6144;
#pragma unroll
            for (int i = 0; i < 4; ++i) v[u][i] = __builtin_nontemporal_load((const f32x4*)(src + (lane + 64 * i) * 4)); }
        float ss[2];
#pragma unroll
        for (int u = 0; u < 2; ++u) { ss[u] = 0;
#pragma unroll
            for (int i = 0; i < 4; ++i) ss[u] += v[u][i].x * v[u][i].x + v[u][i].y * v[u][i].y + v[u][i].z * v[u][i].z + v[u][i].w * v[u][i].w; }
        for (int o = 32; o; o >>= 1) { ss[0] += __shfl_xor(ss[0], o); ss[1] += __shfl_xor(ss[1], o); }
#pragma unroll
        for (int u = 0; u < 2; ++u) { const float rstd = rsqrtf(ss[u] * (1.f / 1024.f) + 1e-6f);
#pragma unroll
            for (int i = 0; i < 4; ++i) { const int k = (lane + 64 * i) * 4;
                const f32x4 g = *(const f32x4*)(p.norm_mix_g + k), sh = *(const f32x4*)(mod[u] + k), sc = *(const f32x4*)(mod[u] + 1024 + k);
                v[u][i] = v[u][i] * rstd * g * (sc + 1.f) + sh;
                u32x2 o; o.x = pk2(v[u][i].x, v[u][i].y); o.y = pk2(v[u][i].z, v[u][i].w); if (ok[u]) *(u32x2*)(A1 + (size_t)Rr[u] * 1024 + k) = o; } }
    }
    { float* BIAS2 = (float*)(p.ws + WS_BIAS2);
      for (int it = blockIdx.x; it < 176; it += gridDim.x) { const int n = (it % 11) * 512 + tid, k0 = (it / 11) * 64; float a0 = 0, a1 = 0, a2 = 0, a3 = 0;
#pragma unroll 16
          for (int k = k0; k < k0 + 64; ++k) { const float wv = p.w_ffn_in[(size_t)k * 5632 + n]; a0 += MOD[3072 + k] * wv; a1 += MOD[6144 + 3072 + k] * wv; a2 += MOD[2 * 6144 + 3072 + k] * wv; a3 += MOD[3 * 6144 + 3072 + k] * wv; }
          unsafeAtomicAdd(BIAS2 + n, a0); unsafeAtomicAdd(BIAS2 + 5632 + n, a1); unsafeAtomicAdd(BIAS2 + 2 * 5632 + n, a2); unsafeAtomicAdd(BIAS2 + 3 * 5632 + n, a3); } }
    { bf16_t* WinT = (bf16_t*)(p.ws + WS_WINT);
      for (int j = blockIdx.x; j < 1040; j += 2 * gridDim.x) { TD d[2];
#pragma unroll
          for (int u = 0; u < 2; ++u) { const int jj = j + u * gridDim.x, jc = jj < 1040 ? jj : j, kt = jc & 15, nt = jc >> 4, n0 = nt * 64;
              d[u] = TD{p.w_in, 4112, kt * 64, nt == 64 ? 2048 : (n0 < 2048 ? n0 : n0 + 16), WinT, 1024, n0, jj < 1040}; }
          transpose2(d[0], d[1], L); } }
}

struct EpiP {
    static constexpr bool PERM = true, AFTER_DRAIN = false;
    bf16_t* O; float* gates;
    DI void operator()(const f32x4 (&acc)[2][2][4][2], const pg8::Unit& u, int wr, int wc, int fr, int fq) const {
        if (u.pn == 16) {
            if (wc == 0 && fq < 2) { const int r0 = u.pm * 256 + wr * 64 + fr;
#pragma unroll
                for (int ai = 0; ai < 2; ++ai)
#pragma unroll
                    for (int m = 0; m < 4; ++m)
#pragma unroll
                        for (int n = 0; n < 2; ++n) *(f32x4*)(gates + (size_t)(r0 + ai * 128 + m * 16) * 16 + 8 * fq + 4 * n) = acc[ai][0][m][n]; }
            return; }
        const int row0 = u.pm * 256 + wr * 64 + fr; int colt = u.pn * 256; const int t = colt >> 9; bf16_t* base = O + (size_t)t * (PBUF / 2); colt -= t * 512;
        const int col0 = colt + wc * 32 + 8 * fq;
#pragma unroll
        for (int ai = 0; ai < 2; ++ai)
#pragma unroll
            for (int m = 0; m < 4; ++m) { bf16_t* rowp = base + (size_t)(row0 + ai * 128 + m * 16) * 512 + col0;
#pragma unroll
                for (int bj = 0; bj < 2; ++bj) { const f32x4 v0 = acc[ai][bj][m][0], v1 = acc[ai][bj][m][1]; u32x4 o;
                    o.x = pg8::cvt_pk_bf16(v0[0], v0[1]); o.y = pg8::cvt_pk_bf16(v0[2], v0[3]); o.z = pg8::cvt_pk_bf16(v1[0], v1[1]); o.w = pg8::cvt_pk_bf16(v1[2], v1[3]);
                    *(u32x4*)(rowp + bj * 128) = o; } }
    }
};
struct EpiRes {
    static constexpr bool PERM = false, AFTER_DRAIN = false;
    float* out; const float* res; const float* gate;
    DI void operator()(const f32x4 (&acc)[2][2][4][2], const pg8::Unit& u, int wr, int wc, int fr, int fq) const {
        const int row0 = u.pm * 256 + wr * 64 + fr, col0 = u.pn * 256 + wc * 32 + 4 * fq;
        const float* gp = gate + (size_t)(row0 >> 12) * 6144 + col0;
        f32x4 gv[2][2];
#pragma unroll
        for (int bj = 0; bj < 2; ++bj)
#pragma unroll
            for (int n = 0; n < 2; ++n) gv[bj][n] = *(const f32x4*)(gp + bj * 128 + n * 16);
#pragma unroll
        for (int ai = 0; ai < 2; ++ai)
#pragma unroll
            for (int m = 0; m < 4; ++m) { const size_t ro = (size_t)(row0 + ai * 128 + m * 16) * 1024 + col0;
#pragma unroll
                for (int bj = 0; bj < 2; ++bj)
#pragma unroll
                    for (int n = 0; n < 2; ++n) { const f32x4 r = *(const f32x4*)(res + ro + bj * 128 + n * 16); *(f32x4*)(out + ro + bj * 128 + n * 16) = r + gv[bj][n] * acc[ai][bj][m][n]; } }
    }
};
struct EpiGLU {
    static constexpr bool PERM = true, AFTER_DRAIN = false;
    bf16_t* H;
    DI void operator()(const f32x4 (&acc)[2][2][4][2], const pg8::Unit& u, int wr, int wc, int fr, int fq) const {
        const int row0 = u.pm * 256 + wr * 64 + fr, col0 = u.pn * 128 + wc * 32 + 8 * fq;
#pragma unroll
        for (int ai = 0; ai < 2; ++ai)
#pragma unroll
            for (int m = 0; m < 4; ++m) { bf16_t* rowp = H + (size_t)(row0 + ai * 128 + m * 16) * 2816 + col0;
                const f32x4 g0 = acc[ai][0][m][0], g1 = acc[ai][0][m][1], u0 = acc[ai][1][m][0], u1 = acc[ai][1][m][1]; u32x4 o;
                o.x = pg8::cvt_pk_bf16(silu_f(g0[0]) * u0[0], silu_f(g0[1]) * u0[1]); o.y = pg8::cvt_pk_bf16(silu_f(g0[2]) * u0[2], silu_f(g0[3]) * u0[3]);
                o.z = pg8::cvt_pk_bf16(silu_f(g1[0]) * u1[0], silu_f(g1[1]) * u1[1]); o.w = pg8::cvt_pk_bf16(silu_f(g1[2]) * u1[2], silu_f(g1[3]) * u1[3]);
                *(u32x4*)rowp = o; }
    }
};

struct EpiRes2 {
    static constexpr bool PERM = false, AFTER_DRAIN = false;
    bf16_t* out; const float* res; const float* mod; const float* gffn; bf16_t* A3; float* SS;
    DI void operator()(const f32x4 (&acc)[2][2][4][2], const pg8::Unit& u, int wr, int wc, int fr, int fq) const {
        const int row0 = u.pm * 256 + wr * 64 + fr, col0 = u.pn * 256 + wc * 32 + 4 * fq;
        const float* mp = mod + (size_t)(row0 >> 12) * 6144 + col0;
        f32x4 gv[2][2], gs[2][2];
#pragma unroll
        for (int bj = 0; bj < 2; ++bj)
#pragma unroll
            for (int n = 0; n < 2; ++n) { gv[bj][n] = *(const f32x4*)(mp + 2048 + bj * 128 + n * 16); gs[bj][n] = *(const f32x4*)(gffn + col0 + bj * 128 + n * 16) * (*(const f32x4*)(mp + 4096 + bj * 128 + n * 16) + 1.f); }
#pragma unroll
        for (int ai = 0; ai < 2; ++ai)
#pragma unroll
            for (int m = 0; m < 4; ++m) { const int row = row0 + ai * 128 + m * 16; const size_t ro = (size_t)row * 1024 + col0; float ssq = 0.f;
#pragma unroll
                for (int bj = 0; bj < 2; ++bj)
#pragma unroll
                    for (int n = 0; n < 2; ++n) { const f32x4 r = *(const f32x4*)(res + ro + bj * 128 + n * 16); const f32x4 x1 = r + gv[bj][n] * acc[ai][bj][m][n];
                        { u32x2 xo; xo.x = pk2(x1.x, x1.y); xo.y = pk2(x1.z, x1.w); *(u32x2*)(out + ro + bj * 128 + n * 16) = xo; } ssq += x1.x * x1.x + x1.y * x1.y + x1.z * x1.z + x1.w * x1.w;
                        const f32x4 a = x1 * gs[bj][n]; u32x2 o; o.x = pk2(a.x, a.y); o.y = pk2(a.z, a.w); *(u32x2*)(A3 + ro + bj * 128 + n * 16) = o; }
                ssq += __shfl_xor(ssq, 16); ssq += __shfl_xor(ssq, 32);
                if (fq == 0) unsafeAtomicAdd(SS + row, ssq); }
    }
};
struct EpiGLU2 {
    static constexpr bool PERM = true, AFTER_DRAIN = false;
    bf16_t* H; const float* SS; const float* bias;
    DI void operator()(const f32x4 (&acc)[2][2][4][2], const pg8::Unit& u, int wr, int wc, int fr, int fq) const {
        const int row0 = u.pm * 256 + wr * 64 + fr, col0 = u.pn * 128 + wc * 32 + 8 * fq;
        const float* bp = bias + (size_t)(row0 >> 12) * 5632 + col0;
        const f32x4 bg0 = *(const f32x4*)bp, bg1 = *(const f32x4*)(bp + 4), bu0 = *(const f32x4*)(bp + 2816), bu1 = *(const f32x4*)(bp + 2816 + 4);
#pragma unroll
        for (int ai = 0; ai < 2; ++ai)
#pragma unroll
            for (int m = 0; m < 4; ++m) { const int row = row0 + ai * 128 + m * 16; bf16_t* rowp = H + (size_t)row * 2816 + col0;
                const float rstd = rsqrtf(SS[row] * (1.f / 1024.f) + 1e-6f);
                const f32x4 g0 = acc[ai][0][m][0] * rstd + bg0, g1 = acc[ai][0][m][1] * rstd + bg1, u0 = acc[ai][1][m][0] * rstd + bu0, u1 = acc[ai][1][m][1] * rstd + bu1; u32x4 o;
                o.x = pk2(silu_f(g0[0]) * u0[0], silu_f(g0[1]) * u0[1]); o.y = pk2(silu_f(g0[2]) * u0[2], silu_f(g0[3]) * u0[3]);
                o.z = pk2(silu_f(g1[0]) * u1[0], silu_f(g1[1]) * u1[1]); o.w = pk2(silu_f(g1[2]) * u1[2], silu_f(g1[3]) * u1[3]);
                *(u32x4*)rowp = o; }
    }
};

struct EpiRes3 {
    static constexpr bool PERM = false, AFTER_DRAIN = false;
    float* out; const bf16_t* res; const float* gate; float* SSF;
    DI void operator()(const f32x4 (&acc)[2][2][4][2], const pg8::Unit& u, int wr, int wc, int fr, int fq) const {
        const int row0 = u.pm * 256 + wr * 64 + fr, col0 = u.pn * 256 + wc * 32 + 4 * fq;
        const float* gp = gate + (size_t)(row0 >> 12) * 6144 + col0;
        f32x4 gv[2][2];
#pragma unroll
        for (int bj = 0; bj < 2; ++bj)
#pragma unroll
            for (int n = 0; n < 2; ++n) gv[bj][n] = *(const f32x4*)(gp + bj * 128 + n * 16);
#pragma unroll
        for (int ai = 0; ai < 2; ++ai)
#pragma unroll
            for (int m = 0; m < 4; ++m) { const int row = row0 + ai * 128 + m * 16; const size_t ro = (size_t)row * 1024 + col0; float ssq = 0.f;
#pragma unroll
                for (int bj = 0; bj < 2; ++bj)
#pragma unroll
                    for (int n = 0; n < 2; ++n) { const u32x2 rb = *(const u32x2*)(res + ro + bj * 128 + n * 16); const f32x4 r = {bflo(rb.x), bfhi(rb.x), bflo(rb.y), bfhi(rb.y)}; const f32x4 x2 = r + gv[bj][n] * acc[ai][bj][m][n];
                        *(f32x4*)(out + ro + bj * 128 + n * 16) = x2; ssq += x2.x * x2.x + x2.y * x2.y + x2.z * x2.z + x2.w * x2.w; }
                ssq += __shfl_xor(ssq, 16); ssq += __shfl_xor(ssq, 32);
                if (fq == 0) unsafeAtomicAdd(SSF + row, ssq); }
    }
};

DI void phase_conv(const Params& p) {
    const int tid = threadIdx.x;
    const int tensor = blockIdx.x % 3, g = blockIdx.x / 3, Gt = (gridDim.x - tensor + 2) / 3;
    const bf16_t* __restrict__ src = (const bf16_t*)(p.ws + WS_QP + (size_t)tensor * PBUF);
    bf16_t* __restrict__ dst = (bf16_t*)(p.ws + (tensor == 0 ? WS_QC : tensor == 1 ? WS_KC : WS_VC));
    const int colb = (tid & 63) * 8, cwb = tensor * 512 + colb, rq = (tid >> 6) * 4;
    float cw[5][8];
#pragma unroll
    for (int i = 0; i < 5; ++i) { const f32x4 a = *(const f32x4*)(p.conv_w + i * 1536 + cwb), bq = *(const f32x4*)(p.conv_w + i * 1536 + cwb + 4);
        cw[i][0] = a.x; cw[i][1] = a.y; cw[i][2] = a.z; cw[i][3] = a.w; cw[i][4] = bq.x; cw[i][5] = bq.y; cw[i][6] = bq.z; cw[i][7] = bq.w; }
    u32x4 in[8], nx[8];
#define CONV_LOAD(dstv, j_) do { const int cr_ = (j_) >> 1, b_ = cr_ / 68, n_ = cr_ % 68, t0_ = n_ * 64 + ((j_) & 1) * 32 + rq; const int lo_ = n_ < 4 ? 0 : 256, hi_ = n_ < 4 ? 256 : TT; \
        _Pragma("unroll") for (int i = 0; i < 8; ++i) { const int tt = t0_ + i - 2; dstv[i] = (u32x4){0u, 0u, 0u, 0u}; if (tt >= lo_ && tt < hi_) dstv[i] = *(const u32x4*)(src + ((size_t)b_ * TT + tt) * 512 + colb); } } while (0)
    if (g < 544) CONV_LOAD(in, g);
#pragma unroll 1
    for (int j = g; j < 544; j += Gt) {
        if (j + Gt < 544) CONV_LOAD(nx, j + Gt);
        const int cr = j >> 1, b = cr / 68, n = cr % 68, t0 = n * 64 + (j & 1) * 32 + rq;
#pragma unroll
        for (int u = 0; u < 4; ++u) {
            float acc[8];
#pragma unroll
            for (int e = 0; e < 8; ++e) acc[e] = 0.f;
#pragma unroll
            for (int i = 0; i < 5; ++i) { const u32x4 v = in[u + i];
                acc[0] += bflo(v.x) * cw[i][0]; acc[1] += bfhi(v.x) * cw[i][1]; acc[2] += bflo(v.y) * cw[i][2]; acc[3] += bfhi(v.y) * cw[i][3];
                acc[4] += bflo(v.z) * cw[i][4]; acc[5] += bfhi(v.z) * cw[i][5]; acc[6] += bflo(v.w) * cw[i][6]; acc[7] += bfhi(v.w) * cw[i][7]; }
            float ss = 0;
#pragma unroll
            for (int e = 0; e < 8; ++e) { acc[e] = silu_f(acc[e]); ss += acc[e] * acc[e]; }
            if (tensor < 2) { ss += __shfl_xor(ss, 1); ss += __shfl_xor(ss, 2); ss += __shfl_xor(ss, 4); ss += __shfl_xor(ss, 8);
                const float sc = rsqrtf(ss + 1e-6f) * (tensor == 0 ? 0.08838834764831845f : 1.f);
#pragma unroll
                for (int e = 0; e < 8; ++e) acc[e] *= sc; }
            u32x4 o; o.x = pk2(acc[0], acc[1]); o.y = pk2(acc[2], acc[3]); o.z = pk2(acc[4], acc[5]); o.w = pk2(acc[6], acc[7]);
            *(u32x4*)(dst + ((size_t)b * TT + t0 + u) * 512 + colb) = o;
        }
#pragma unroll
        for (int i = 0; i < 8; ++i) in[i] = nx[i];
    }
#undef CONV_LOAD
}

constexpr int L_QS = 0, L_KS = 17408, L_WT = 0, L_UT = 18432, L_KT = 36864, L_VT = 55296, L_AA = 73728, L_QKF = 91136, L_QKB = 100352,
              L_TWF = 109568, L_TUF = 118784, L_TWB = 128000, L_TUB = 137216, L_VEC = 146432;
static_assert(L_VEC + 1024 <= LDS_BYTES, "lds");

DI void rot4(unsigned (&a)[4], int sft) {
    if (sft & 1) { const unsigned t = a[0]; a[0] = a[1]; a[1] = a[2]; a[2] = a[3]; a[3] = t; }
    if (sft & 2) { const unsigned t0 = a[0], t1 = a[1]; a[0] = a[2]; a[1] = a[3]; a[2] = t0; a[3] = t1; }
}
#define MFMA4F(a, b, c) __builtin_amdgcn_mfma_f32_16x16x4f32((a), (b), (c), 0, 0, 0)
constexpr int L_DS = 0;
DI void solve_diag(ldsp L, int w, int lane) {
    const int dir = w >> 2, k = w & 3, c = lane & 15;
    const LAS float* AA = (const LAS float*)(L + L_AA); const LAS float* VEC = (const LAS float*)(L + L_VEC);
    const int sg = dir ? -1 : 1, o0 = dir ? 63 : 0;
    const LAS float* Ab = AA + (o0 + sg * 16 * k) * 68 + (o0 + sg * 16 * k);
    float D[16];
#pragma unroll
    for (int i = 0; i < 16; ++i) { float s0 = (c == i) ? 1.f : 0.f;
#pragma unroll
        for (int j = 0; j < i; ++j) s0 -= Ab[sg * (i * 68 + j)] * D[j];
        D[i] = s0; }
    const int Cc = o0 + sg * (16 * k + c);
    const float beta = VEC[(dir ? 192 : 128) + Cc], cw = beta * __expf(VEC[(dir ? 64 : 0) + Cc]);
    ldsp TW = L + (dir ? L_TWB : L_TWF), TU = L + (dir ? L_TUB : L_TUF);
    if (lane < 16) {
#pragma unroll
        for (int i = 0; i < 16; ++i) { *(LAS float*)(L + L_DS + ((w * 16 + i) * 20 + c) * 4) = D[i];
            const int R = o0 + sg * (16 * k + i);
            *(LAS unsigned short*)(TW + R * 144 + Cc * 2) = f2bf(D[i] * cw); *(LAS unsigned short*)(TU + R * 144 + Cc * 2) = f2bf(D[i] * beta); } }
}
template <int KB> DI void solve_offdiag(ldsp L, int dir, int lane) {
    const int fr = lane & 15, fq = lane >> 4;
    const LAS float* AA = (const LAS float*)(L + L_AA); const LAS float* VEC = (const LAS float*)(L + L_VEC);
    const LAS float* DS = (const LAS float*)(L + L_DS) + dir * 4 * 320;
    const int sg = dir ? -1 : 1, o0 = dir ? 63 : 0;
    const int Cc = o0 + sg * (16 * KB + fr);
    const float beta = VEC[(dir ? 192 : 128) + Cc], cw = beta * __expf(VEC[(dir ? 64 : 0) + Cc]);
    ldsp TW = L + (dir ? L_TWB : L_TWF), TU = L + (dir ? L_TUB : L_TUF);
    f32x4 Tb[4];
#pragma unroll
    for (int r = 0; r < 4; ++r) Tb[KB][r] = DS[KB * 320 + (4 * fq + r) * 20 + fr];
#pragma unroll
    for (int i = KB + 1; i < 4; ++i) {
        f32x4 P = {0.f, 0.f, 0.f, 0.f};
#pragma unroll
        for (int j = KB; j < i; ++j) {
            const int row = o0 + sg * (16 * i + fr);
            f32x4 a;
            if (dir == 0) a = *(const LAS f32x4*)(AA + row * 68 + 16 * j + 4 * fq);
            else { const f32x4 t = *(const LAS f32x4*)(AA + row * 68 + 60 - 16 * j - 4 * fq); a = (f32x4){t.w, t.z, t.y, t.x}; }
#pragma unroll
            for (int r = 0; r < 4; ++r) P = MFMA4F(a[r], Tb[j][r], P);
        }
        const f32x4 d = *(const LAS f32x4*)(DS + i * 320 + fr * 20 + 4 * fq);
        f32x4 Z = {0.f, 0.f, 0.f, 0.f};
#pragma unroll
        for (int r = 0; r < 4; ++r) Z = MFMA4F(d[r], P[r], Z);
        Tb[i] = -Z;
#pragma unroll
        for (int r = 0; r < 4; ++r) { const int R = o0 + sg * (16 * i + 4 * fq + r);
            *(LAS unsigned short*)(TW + R * 144 + Cc * 2) = f2bf(Tb[i][r] * cw); *(LAS unsigned short*)(TU + R * 144 + Cc * 2) = f2bf(Tb[i][r] * beta); }
    }
}

DI void prep_gdn(const Params& p, ldsp L, int it, bool dry) {
    const int tid = threadIdx.x, lane = tid & 63, w = __builtin_amdgcn_readfirstlane(tid >> 6), fr = lane & 15, fq = lane >> 4;
    const int cr = it >> 2, h = it & 3, b = cr / 68, n = cr % 68;
    const size_t row0 = (size_t)b * TT + n * 64;
    const bf16_t* QC = (const bf16_t*)(p.ws + WS_QC); bf16_t* KC = (bf16_t*)(p.ws + WS_KC); const bf16_t* VC = (const bf16_t*)(p.ws + WS_VC);
    float* OG = p.out;
    LAS float* VEC = (LAS float*)(L + L_VEC);
#pragma unroll
    for (int u = 0; u < 2; ++u) { const int cid = w * 2 + u, r = (cid & 3) * 16 + fr, c8 = ((cid >> 2) * 4 + fq) * 8;
        const size_t g = (row0 + r) * 512 + h * 128 + c8;
        const u32x4 q = *(const u32x4*)(QC + g), k = *(const u32x4*)(KC + g), v = *(const u32x4*)(VC + g);
        *(LAS u32x4*)(L + L_QS + r * 272 + c8 * 2) = q; *(LAS u32x4*)(L + L_KS + r * 272 + c8 * 2) = k;
        unsigned kk[4] = {k.x, k.y, k.z, k.w}, vv[4] = {v.x, v.y, v.z, v.w};
        rot4(kk, fq); rot4(vv, fq);
#pragma unroll
        for (int e = 0; e < 4; ++e) { const int row = c8 + 2 * ((e + fq) & 3);
            *(LAS unsigned short*)(L + L_KT + row * 144 + r * 2) = (unsigned short)(kk[e] & 0xffff); *(LAS unsigned short*)(L + L_KT + (row + 1) * 144 + r * 2) = (unsigned short)(kk[e] >> 16);
            *(LAS unsigned short*)(L + L_VT + row * 144 + r * 2) = (unsigned short)(vv[e] & 0xffff); *(LAS unsigned short*)(L + L_VT + (row + 1) * 144 + r * 2) = (unsigned short)(vv[e] >> 16); } }
    for (int e = tid; e < 9216; e += NT) *(LAS unsigned*)(L + L_TWF + e * 4) = 0u;
    if (tid < 64) {
        const float* gp = (const float*)(p.ws + WS_GATES) + (row0 + tid) * 16;
        const float gf = -__expf(p.a_log[h]) * softplus_f(gp[h] + p.dt_bias[h]);
        const float gb = -__expf(p.a_log[4 + h]) * softplus_f(gp[4 + h] + p.dt_bias[4 + h]);
        float pf = gf, pb = gb;
        for (int o = 1; o < 64; o <<= 1) { const float a = __shfl_up(pf, o), c = __shfl_up(pb, o); if (lane >= o) { pf += a; pb += c; } }
        const float totb = __shfl(pb, 63), GfL = __shfl(pf, 63);
        const float Gf = pf, Gb = totb - pb + gb;
        VEC[tid] = Gf; VEC[64 + tid] = Gb; VEC[128 + tid] = sigm_f(gp[8 + h]); VEC[192 + tid] = sigm_f(gp[12 + h]);
        float* dec = (float*)(p.ws + WS_DEC) + (size_t)(it * 2) * 80;
        dec[tid] = __expf(GfL - Gf); dec[80 + tid] = __expf(totb - Gb);
        if (tid == 0) { dec[64] = __expf(GfL); dec[80 + 64] = __expf(totb); }
    }
    lds_barrier();
    { const int mat = w >> 2, tr = w & 3;
      ldsp Ab = L + (mat ? L_QS : L_KS);
      bf16x8 a[4];
#pragma unroll
      for (int kk = 0; kk < 4; ++kk) a[kk] = lds16(Ab + (tr * 16 + fr) * 272 + kk * 64 + fq * 16);
#pragma unroll
      for (int tc = 0; tc < 4; ++tc) {
          f32x4 acc = {0.f, 0.f, 0.f, 0.f};
#pragma unroll
          for (int kk = 0; kk < 4; ++kk) acc = MFMA16(a[kk], lds16(L + L_KS + (tc * 16 + fr) * 272 + kk * 64 + fq * 16), acc);
          const int s = tc * 16 + fr; const float Gfs = VEC[s], Gbs = VEC[64 + s];
#pragma unroll
          for (int j = 0; j < 4; ++j) { const int t = tr * 16 + fq * 4 + j; const float Gft = VEC[t], Gbt = VEC[64 + t];
              if (mat == 0) { float v = 0.f; if (s < t) v = VEC[128 + t] * acc[j] * __expf(Gft - Gfs); else if (s > t) v = VEC[192 + t] * acc[j] * __expf(Gbt - Gbs);
                  *(LAS float*)(L + L_AA + (t * 68 + s) * 4) = v; }
              else { const float vf = (s <= t) ? acc[j] * __expf(Gft - Gfs) : 0.f, vb = (s >= t) ? acc[j] * __expf(Gbt - Gbs) : 0.f;
                  *(LAS unsigned short*)(L + L_QKF + t * 144 + s * 2) = f2bf(vf); *(LAS unsigned short*)(L + L_QKB + t * 144 + s * 2) = f2bf(vb); } } } }
    lds_barrier();
    solve_diag(L, w, lane);
    lds_barrier();
    if (w < 6) { const int dr_ = w >= 3 ? 1 : 0, kb = w - 3 * dr_; if (kb == 0) solve_offdiag<0>(L, dr_, lane); else if (kb == 1) solve_offdiag<1>(L, dr_, lane); else solve_offdiag<2>(L, dr_, lane); }
    lds_barrier();
    f32x4 oacc[8];
#pragma unroll
    for (int i = 0; i < 8; ++i) oacc[i] = (f32x4){0.f, 0.f, 0.f, 0.f};
#pragma unroll 1
    for (int dir = 0; dir < 2; ++dir) {
        ldsp TW = L + (dir ? L_TWB : L_TWF), TU = L + (dir ? L_TUB : L_TUF), QKM = L + (dir ? L_QKB : L_QKF);
        bf16_t* Wg = (bf16_t*)(p.ws + (dir ? WS_WB : WS_WF)) + (size_t)it * 8192;
        bf16_t* Ug = (bf16_t*)(p.ws + (dir ? WS_UB : WS_UF)) + (size_t)it * 8192;
        bf16_t* Qg = (bf16_t*)(p.ws + (dir ? WS_QB : WS_QF)) + (size_t)it * 8192;
        u32x2 qv[8];
        if (w < 4) {
#pragma unroll
            for (int dr = 0; dr < 8; ++dr) qv[dr] = *(const u32x2*)(QC + (row0 + w * 16 + fr) * 512 + h * 128 + dr * 16 + fq * 4);
            const bf16x8 b0 = lds16(TW + (w * 16 + fr) * 144 + fq * 16), b1 = lds16(TW + (w * 16 + fr) * 144 + 64 + fq * 16);
            const int t = w * 16 + fr; const float et = dir ? __expf(VEC[64] - VEC[64 + t]) : __expf(VEC[63] - VEC[t]);
#pragma unroll
            for (int dr = 0; dr < 8; ++dr) { f32x4 acc = {0.f, 0.f, 0.f, 0.f};
                acc = MFMA16(lds16(L + L_KT + (dr * 16 + fr) * 144 + fq * 16), b0, acc); acc = MFMA16(lds16(L + L_KT + (dr * 16 + fr) * 144 + 64 + fq * 16), b1, acc);
                const int d0 = dr * 16 + fq * 4; u32x2 o; o.x = pk2(acc[0], acc[1]); o.y = pk2(acc[2], acc[3]);
                { u32x2 og; og.x = pk2(acc[0] * et, acc[1] * et); og.y = pk2(acc[2] * et, acc[3] * et); *(u32x2*)(Wg + ((w * 4 + (dr >> 1)) * 64 + ((dr & 1) * 2 + (fq >> 1)) * 16 + fr) * 8 + (fq & 1) * 4) = og; }
                *(LAS unsigned short*)(L + L_WT + (d0 + 0) * 144 + t * 2) = (unsigned short)(o.x & 0xffff); *(LAS unsigned short*)(L + L_WT + (d0 + 1) * 144 + t * 2) = (unsigned short)(o.x >> 16);
                *(LAS unsigned short*)(L + L_WT + (d0 + 2) * 144 + t * 2) = (unsigned short)(o.y & 0xffff); *(LAS unsigned short*)(L + L_WT + (d0 + 3) * 144 + t * 2) = (unsigned short)(o.y >> 16); }
        } else {
            const int tw = w - 4;
            const bf16x8 a0 = lds16(TU + (tw * 16 + fr) * 144 + fq * 16), a1 = lds16(TU + (tw * 16 + fr) * 144 + 64 + fq * 16);
            const int t0 = tw * 16 + fq * 4; float eu[4];
#pragma unroll
            for (int j = 0; j < 4; ++j) eu[j] = dir ? __expf(VEC[64] - VEC[64 + t0 + j]) : __expf(VEC[63] - VEC[t0 + j]);
#pragma unroll
            for (int tc = 0; tc < 8; ++tc) { f32x4 acc = {0.f, 0.f, 0.f, 0.f};
                acc = MFMA16(a0, lds16(L + L_VT + (tc * 16 + fr) * 144 + fq * 16), acc); acc = MFMA16(a1, lds16(L + L_VT + (tc * 16 + fr) * 144 + 64 + fq * 16), acc);
                const int c = tc * 16 + fr; u32x2 o; o.x = pk2(acc[0], acc[1]); o.y = pk2(acc[2], acc[3]);
                *(LAS u32x2*)(L + L_UT + c * 144 + t0 * 2) = o; { u32x2 og; og.x = pk2(acc[0] * eu[0], acc[1] * eu[1]); og.y = pk2(acc[2] * eu[2], acc[3] * eu[3]); *(u32x2*)(Ug + c * 64 + t0) = og; } }
        }
        lds_barrier();
        if (w < 4) {
            const bf16x8 b0 = lds16(QKM + (w * 16 + fr) * 144 + fq * 16), b1 = lds16(QKM + (w * 16 + fr) * 144 + 64 + fq * 16);
            const int t = w * 16 + fr; const float eg = __expf(VEC[(dir ? 64 : 0) + t]);
#pragma unroll
            for (int dr = 0; dr < 8; ++dr) { f32x4 acc = {0.f, 0.f, 0.f, 0.f};
                acc = MFMA16(lds16(L + L_WT + (dr * 16 + fr) * 144 + fq * 16), b0, acc); acc = MFMA16(lds16(L + L_WT + (dr * 16 + fr) * 144 + 64 + fq * 16), b1, acc);
                const u32x2 q = qv[dr];
                u32x2 o; o.x = pk2(eg * bflo(q.x) - acc[0], eg * bfhi(q.x) - acc[1]); o.y = pk2(eg * bflo(q.y) - acc[2], eg * bfhi(q.y) - acc[3]);
                *(u32x2*)(Qg + ((w * 4 + (dr >> 1)) * 64 + ((dr & 1) * 2 + (fq >> 1)) * 16 + fr) * 8 + (fq & 1) * 4) = o; }
        } else {
            const int tw = w - 4;
            const bf16x8 b0 = lds16(QKM + (tw * 16 + fr) * 144 + fq * 16), b1 = lds16(QKM + (tw * 16 + fr) * 144 + 64 + fq * 16);
#pragma unroll
            for (int ct = 0; ct < 8; ++ct) { oacc[ct] = MFMA16(lds16(L + L_UT + (ct * 16 + fr) * 144 + fq * 16), b0, oacc[ct]); oacc[ct] = MFMA16(lds16(L + L_UT + (ct * 16 + fr) * 144 + 64 + fq * 16), b1, oacc[ct]); }
        }
        lds_barrier();
    }
    if (w >= 4 && n >= 4) { const int t = (w - 4) * 16 + fr; const size_t lrow = (size_t)b * 4096 + (n - 4) * 64 + t;
#pragma unroll
        for (int ct = 0; ct < 8; ++ct) *(f32x4*)(OG + lrow * 512 + h * 128 + ct * 16 + fq * 4) = oacc[ct]; }
    if (!dry) for (int pc = tid; pc < 1024; pc += NT) { const int d = pc >> 3, t8 = (pc & 7) * 8; const u32x4 v = *(const LAS u32x4*)(L + L_KT + d * 144 + t8 * 2);
        { const int e_ = ((((d >> 4) * 2 + (t8 >> 5)) * 64) + ((t8 >> 3) & 3) * 16 + (d & 15)) * 8; *(u32x4*)(KC + (row0 + (e_ >> 7)) * 512 + h * 128 + (e_ & 127)) = v; } }
    lds_barrier();
}

DI float logsig_f(float x) { return -softplus_f(-x); }

DI void prep_ret(const Params& p, ldsp L, int it, bool dry) {
    const int tid = threadIdx.x, lane = tid & 63, w = __builtin_amdgcn_readfirstlane(tid >> 6), fr = lane & 15, fq = lane >> 4;
    const int cr = it >> 2, h = it & 3, b = cr / 68, n = cr % 68; const bool isctx = n < 4;
    const size_t row0 = (size_t)b * TT + n * 64;
    bf16_t* RQ = (bf16_t*)(p.ws + WS_RQ); bf16_t* RK = (bf16_t*)(p.ws + WS_RK); const bf16_t* RV = (const bf16_t*)(p.ws + WS_RV);
    float* ORp = p.out + (size_t)LROWS * 512;
    constexpr int R_QS = 0, R_KS = 17408, R_KT = 36864, R_VT = 55296, R_QKD = 73728;
    const float lgf2 = logsig_f(p.ret_logit[h]) * 1.4426950408889634f, lgb2 = logsig_f(p.ret_logit[4 + h]) * 1.4426950408889634f;
    u32x4 q1s = {0u, 0u, 0u, 0u}, q2s = {0u, 0u, 0u, 0u};
    { const int r = (w & 3) * 16 + fr, p8 = ((w >> 2) * 4 + fq) * 8, t = n * 64 + r;
      float pos; int i0; float rc;
      if (p8 < 16) { pos = isctx ? (float)t : 256.f; i0 = p8; rc = 1.f / 16.f; }
      else if (p8 < 40) { pos = isctx ? 0.f : (float)((t - 256) >> 6); i0 = p8 - 16; rc = 1.f / 24.f; }
      else { pos = isctx ? 0.f : (float)((t - 256) & 63); i0 = p8 - 40; rc = 1.f / 24.f; }
      float cs[8], sn[8];
#pragma unroll
      for (int e = 0; e < 8; ++e) { const float ang = pos * exp2f(-13.287712379549449f * (float)(i0 + e) * rc); cs[e] = __cosf(ang); sn[e] = __sinf(ang); }
      const size_t g = (row0 + r) * 512 + h * 128 + p8;
      { const u32x4 k1 = *(const u32x4*)(RK + g), k2 = *(const u32x4*)(RK + g + 64);
        const unsigned a1[4] = {k1.x, k1.y, k1.z, k1.w}, a2[4] = {k2.x, k2.y, k2.z, k2.w}; unsigned o1[4], o2[4];
#pragma unroll
        for (int e = 0; e < 4; ++e) { const float x0 = bflo(a1[e]), x1 = bfhi(a1[e]), y0 = bflo(a2[e]), y1 = bfhi(a2[e]); const float sc = 0.08838834764831845f;
            o1[e] = pk2((x0 * cs[2 * e] - y0 * sn[2 * e]) * sc, (x1 * cs[2 * e + 1] - y1 * sn[2 * e + 1]) * sc);
            o2[e] = pk2((x0 * sn[2 * e] + y0 * cs[2 * e]) * sc, (x1 * sn[2 * e + 1] + y1 * cs[2 * e + 1]) * sc); }
        *(LAS u32x4*)(L + R_KS + r * 272 + p8 * 2) = (u32x4){o1[0], o1[1], o1[2], o1[3]}; *(LAS u32x4*)(L + R_KS + r * 272 + (64 + p8) * 2) = (u32x4){o2[0], o2[1], o2[2], o2[3]};
rot4(o1, fq); rot4(o2, fq);
#pragma unroll
        for (int e = 0; e < 4; ++e) { const int row = p8 + 2 * ((e + fq) & 3);
            *(LAS unsigned short*)(L + R_KT + row * 144 + r * 2) = (unsigned short)(o1[e] & 0xffff); *(LAS unsigned short*)(L + R_KT + (row + 1) * 144 + r * 2) = (unsigned short)(o1[e] >> 16);
            *(LAS unsigned short*)(L + R_KT + (64 + row) * 144 + r * 2) = (unsigned short)(o2[e] & 0xffff); *(LAS unsigned short*)(L + R_KT + (64 + row + 1) * 144 + r * 2) = (unsigned short)(o2[e] >> 16); } }
      if (!isctx) {
        const u32x4 k1 = *(const u32x4*)(RQ + g), k2 = *(const u32x4*)(RQ + g + 64);
        const unsigned a1[4] = {k1.x, k1.y, k1.z, k1.w}, a2[4] = {k2.x, k2.y, k2.z, k2.w}; unsigned o1[4], o2[4];
#pragma unroll
        for (int e = 0; e < 4; ++e) { const float x0 = bflo(a1[e]), x1 = bfhi(a1[e]), y0 = bflo(a2[e]), y1 = bfhi(a2[e]);
            o1[e] = pk2(x0 * cs[2 * e] - y0 * sn[2 * e], x1 * cs[2 * e + 1] - y1 * sn[2 * e + 1]);
            o2[e] = pk2(x0 * sn[2 * e] + y0 * cs[2 * e], x1 * sn[2 * e + 1] + y1 * cs[2 * e + 1]); }
        const u32x4 q1 = {o1[0], o1[1], o1[2], o1[3]}, q2 = {o2[0], o2[1], o2[2], o2[3]};
        *(LAS u32x4*)(L + R_QS + r * 272 + p8 * 2) = q1; *(LAS u32x4*)(L + R_QS + r * 272 + (64 + p8) * 2) = q2;
        q1s = q1; q2s = q2;
#pragma unroll
        for (int u = 0; u < 2; ++u) { const int cid = w * 2 + u, r2 = (cid & 3) * 16 + fr, c8 = ((cid >> 2) * 4 + fq) * 8; const u32x4 v = *(const u32x4*)(RV + (row0 + r2) * 512 + h * 128 + c8);
            unsigned vv[4] = {v.x, v.y, v.z, v.w}; rot4(vv, fq);
#pragma unroll
            for (int e = 0; e < 4; ++e) { const int row = c8 + 2 * ((e + fq) & 3); *(LAS unsigned short*)(L + R_VT + row * 144 + r2 * 2) = (unsigned short)(vv[e] & 0xffff); *(LAS unsigned short*)(L + R_VT + (row + 1) * 144 + r2 * 2) = (unsigned short)(vv[e] >> 16); } }
      }
    }
    lds_barrier();
    if (!dry && !isctx) { const int r = (w & 3) * 16 + fr, p8 = ((w >> 2) * 4 + fq) * 8; const int e1 = ((((r >> 4) * 4 + (p8 >> 5)) * 64) + ((p8 >> 3) & 3) * 16 + (r & 15)) * 8, e2 = e1 + 2 * 64 * 8;
        *(u32x4*)(RQ + (row0 + (e1 >> 7)) * 512 + h * 128 + (e1 & 127)) = q1s; *(u32x4*)(RQ + (row0 + (e2 >> 7)) * 512 + h * 128 + (e2 & 127)) = q2s; }
    if (!dry) for (int pc = tid; pc < 1024; pc += NT) { const int d = pc >> 3, t8 = (pc & 7) * 8; const u32x4 v = *(const LAS u32x4*)(L + R_KT + d * 144 + t8 * 2);
        { const int e_ = ((((d >> 4) * 2 + (t8 >> 5)) * 64) + ((t8 >> 3) & 3) * 16 + (d & 15)) * 8; *(u32x4*)(RK + (row0 + (e_ >> 7)) * 512 + h * 128 + (e_ & 127)) = v; } }
    if (!isctx) {
        { const int tr = w >> 1; bf16x8 a[4];
#pragma unroll
          for (int kk = 0; kk < 4; ++kk) a[kk] = lds16(L + R_QS + (tr * 16 + fr) * 272 + kk * 64 + fq * 16);
#pragma unroll
          for (int x = 0; x < 2; ++x) { const int tc = (w & 1) * 2 + x; f32x4 acc = {0.f, 0.f, 0.f, 0.f};
#pragma unroll
              for (int kk = 0; kk < 4; ++kk) acc = MFMA16(a[kk], lds16(L + R_KS + (tc * 16 + fr) * 272 + kk * 64 + fq * 16), acc);
              const int s = tc * 16 + fr;
#pragma unroll
              for (int j = 0; j < 4; ++j) { const int t = tr * 16 + fq * 4 + j, dt = t - s;
                  const float f = (dt >= 0 ? exp2f((float)dt * lgf2) : 0.f) + (dt <= 0 ? exp2f((float)(-dt) * lgb2) : 0.f);
                  *(LAS unsigned short*)(L + R_QKD + t * 144 + s * 2) = f2bf(acc[j] * f); } } }
        lds_barrier();
        { const int tw = w & 3; const bf16x8 b0 = lds16(L + R_QKD + (tw * 16 + fr) * 144 + fq * 16), b1 = lds16(L + R_QKD + (tw * 16 + fr) * 144 + 64 + fq * 16);
          const int t = tw * 16 + fr; const size_t lrow = (size_t)b * 4096 + (n - 4) * 64 + t;
#pragma unroll
          for (int x = 0; x < 4; ++x) { const int ct = (w >> 2) * 4 + x; f32x4 acc = {0.f, 0.f, 0.f, 0.f};
              acc = MFMA16(lds16(L + R_VT + (ct * 16 + fr) * 144 + fq * 16), b0, acc); acc = MFMA16(lds16(L + R_VT + (ct * 16 + fr) * 144 + 64 + fq * 16), b1, acc);
              *(f32x4*)(ORp + lrow * 512 + h * 128 + ct * 16 + fq * 4) = acc; } }
    }
    lds_barrier();
}

DI int chunk_of(int i, int dir) { return dir == 0 ? i : (i < 4 ? 3 - i : 71 - i); }
constexpr int S_ST = 0, S_VT = 8704;

struct GSet { bf16x8 W[4], Q[4], K[2]; u32x2 U; float gl; f32x4 O; };
struct GCtx { const bf16_t *Wb, *Qb, *Ub, *KC; const float* DEC; float* OG; bf16_t* OGB; int b, h, dir, slice, w, fr, fq, tr, tc; unsigned lw, lk, lu, lo; float osc; };
DI void gdn_load(GSet& s, const GCtx& c, int n) {
    const int it = __builtin_amdgcn_readfirstlane((c.b * 68 + n) * 4 + c.h); const size_t r0 = (size_t)c.b * TT + n * 64;
    const char* wp = (const char*)c.Wb + (size_t)it * 16384; const char* qp = (const char*)c.Qb + (size_t)it * 16384;
#pragma unroll
    for (int kk = 0; kk < 4; ++kk) { s.W[kk] = *(const bf16x8*)(wp + (c.lw + kk * 1024)); s.Q[kk] = *(const bf16x8*)(qp + (c.lw + kk * 1024)); }
    const char* kp = (const char*)c.KC + (r0 * 512 + c.h * 128) * 2;
    s.K[0] = *(const bf16x8*)(kp + c.lk); s.K[1] = *(const bf16x8*)(kp + (c.lk + 4 * 512 * 2));
    s.U = *(const u32x2*)((const char*)c.Ub + (size_t)it * 16384 + c.lu);
    s.gl = c.DEC[(size_t)(it * 2 + c.dir) * 80 + 64];
    if (c.dir == 0) { const int nn = n >= 4 ? n - 4 : 0; s.O = *(const f32x4*)((const char*)c.OG + (((size_t)c.b * 4096 + nn * 64) * 512 + c.h * 128 + c.slice * 32) * 4 + c.lo); }
}
DI void gdn_step(const GSet& s, const GCtx& c, ldsp L, f32x4& S0, f32x4& S1, int n) {
    f32x4 X = {0.f, 0.f, 0.f, 0.f}, OX = {0.f, 0.f, 0.f, 0.f};
#pragma unroll
    for (int kk = 0; kk < 4; ++kk) { const bf16x8 sf = lds16(L + S_ST + (c.tc * 16 + c.fr) * 272 + kk * 64 + c.fq * 16); X = MFMA16(s.W[kk], sf, X); OX = MFMA16(sf, s.Q[kk], OX); }
    { u32x2 o; o.x = pk2(bflo(s.U.x) - X[0], bfhi(s.U.x) - X[1]); o.y = pk2(bflo(s.U.y) - X[2], bfhi(s.U.y) - X[3]);
      *(LAS u32x2*)(L + S_VT + (c.tc * 16 + c.fr) * 144 + (c.tr * 16 + c.fq * 4) * 2) = o; }
    { const bool valid = n >= 4; const float sc = valid ? c.osc : 0.f;
      if (c.dir == 0) { const int nn = valid ? n - 4 : 0;
          *(f32x4*)((char*)c.OG + (((size_t)c.b * 4096 + nn * 64) * 512 + c.h * 128 + c.slice * 32) * 4 + c.lo) = s.O + OX * sc; }
      else { const size_t row = valid ? (size_t)c.b * 4096 + (n - 4) * 64 + c.tr * 16 + c.fr : (size_t)LROWS + c.tr * 16 + c.fr;
          u32x2 o; o.x = pk2(OX[0] * sc, OX[1] * sc); o.y = pk2(OX[2] * sc, OX[3] * sc);
          *(u32x2*)(c.OGB + row * 512 + c.h * 128 + c.slice * 32 + c.tc * 16 + c.fq * 4) = o; } }
    lds_barrier();
    { S0 *= s.gl; S1 *= s.gl;
#pragma unroll
      for (int kk = 0; kk < 2; ++kk) { S0 = MFMA16(s.K[kk], lds16(L + S_VT + c.fr * 144 + kk * 64 + c.fq * 16), S0); S1 = MFMA16(s.K[kk], lds16(L + S_VT + (16 + c.fr) * 144 + kk * 64 + c.fq * 16), S1); }
      u32x2 o; o.x = pk2(S0[0], S0[1]); o.y = pk2(S0[2], S0[3]); *(LAS u32x2*)(L + S_ST + c.fr * 272 + (c.w * 16 + c.fq * 4) * 2) = o;
      o.x = pk2(S1[0], S1[1]); o.y = pk2(S1[2], S1[3]); *(LAS u32x2*)(L + S_ST + (16 + c.fr) * 272 + (c.w * 16 + c.fq * 4) * 2) = o; }
    lds_barrier();
}
DI void scan_gdn(const Params& p, ldsp L, int b, int h, int dir, int slice, float osc) {
    const int tid = threadIdx.x, lane = tid & 63, w = __builtin_amdgcn_readfirstlane(tid >> 6);
    GCtx c; c.Wb = (const bf16_t*)(p.ws + (dir ? WS_WB : WS_WF)); c.Ub = (const bf16_t*)(p.ws + (dir ? WS_UB : WS_UF)); c.Qb = (const bf16_t*)(p.ws + (dir ? WS_QB : WS_QF));
    c.KC = (const bf16_t*)(p.ws + WS_KC); c.DEC = (const float*)(p.ws + WS_DEC); c.OG = p.out; c.OGB = (bf16_t*)(p.ws + WS_OGB);
    c.b = b; c.h = h; c.dir = dir; c.slice = slice; c.w = w; c.fr = lane & 15; c.fq = lane >> 4; c.tr = w >> 1; c.tc = w & 1; c.osc = osc;
    c.lw = (unsigned)((c.tr * 256 + c.fq * 16 + c.fr) * 16); c.lk = (unsigned)(((w * 8 + c.fq) * 512 + c.fr * 8) * 2);
    c.lu = (unsigned)(((slice * 32 + c.tc * 16 + c.fr) * 64 + c.tr * 16 + c.fq * 4) * 2); c.lo = (unsigned)(((c.tr * 16 + c.fr) * 512 + c.tc * 16 + c.fq * 4) * 4);
    for (int e = tid; e < (8704 + 4608) / 4; e += NT) ((LAS unsigned*)L)[e] = 0u;
    lds_barrier();
    f32x4 S0 = {0.f, 0.f, 0.f, 0.f}, S1 = {0.f, 0.f, 0.f, 0.f};
    GSet A, B, C;
    gdn_load(A, c, chunk_of(0, dir)); gdn_load(B, c, chunk_of(1, dir));
#pragma unroll 1
    for (int i = 0; i < 66; i += 6) {
        gdn_load(C, c, chunk_of(i + 2, dir)); gdn_step(A, c, L, S0, S1, chunk_of(i, dir));
        gdn_load(A, c, chunk_of(i + 3, dir)); gdn_step(B, c, L, S0, S1, chunk_of(i + 1, dir));
        gdn_load(B, c, chunk_of(i + 4, dir)); gdn_step(C, c, L, S0, S1, chunk_of(i + 2, dir));
        gdn_load(C, c, chunk_of(i + 5, dir)); gdn_step(A, c, L, S0, S1, chunk_of(i + 3, dir));
        gdn_load(A, c, chunk_of(i + 6, dir)); gdn_step(B, c, L, S0, S1, chunk_of(i + 4, dir));
        gdn_load(B, c, chunk_of(i + 7, dir)); gdn_step(C, c, L, S0, S1, chunk_of(i + 5, dir));
    }
    gdn_step(A, c, L, S0, S1, chunk_of(66, dir)); gdn_step(B, c, L, S0, S1, chunk_of(67, dir));
}

struct RSet { bf16x8 Q[4], K[2]; u32x2 V; f32x4 O; };
struct RCtx { const bf16_t *RQ, *RK, *RV; float* ORp; bf16_t* ORB; int b, h, dir, slice, w, fr, fq, tr, tc, vt, vc4; unsigned lq, lk, lv, lo; float osc, gC, zeta, xiT; };
DI void ret_load(RSet& s, const RCtx& c, int n) {
    const size_t r0 = (size_t)c.b * TT + n * 64; const size_t ub = (r0 * 512 + c.h * 128) * 2;
    const char* qp = (const char*)c.RQ + ub;
#pragma unroll
    for (int kk = 0; kk < 4; ++kk) s.Q[kk] = *(const bf16x8*)(qp + (c.lq + kk * 4 * 512 * 2));
    const char* kp = (const char*)c.RK + ub;
    s.K[0] = *(const bf16x8*)(kp + c.lk); s.K[1] = *(const bf16x8*)(kp + (c.lk + 4 * 512 * 2));
    s.V = *(const u32x2*)((const char*)c.RV + ub + c.lv);
    if (c.dir == 0) { const int nn = n >= 4 ? n - 4 : 0; s.O = *(const f32x4*)((const char*)c.ORp + (((size_t)c.b * 4096 + nn * 64) * 512 + c.h * 128 + c.slice * 32) * 4 + c.lo); }
}
DI void ret_step(const RSet& s, const RCtx& c, ldsp L, f32x4& S0, f32x4& S1, int n) {
    { unsigned vz[4] = {f2bf(bflo(s.V.x) * c.zeta), f2bf(bfhi(s.V.x) * c.zeta), f2bf(bflo(s.V.y) * c.zeta), f2bf(bfhi(s.V.y) * c.zeta)};
      const int sft = (c.vc4 >> 3) & 3; rot4(vz, sft);
#pragma unroll
      for (int i = 0; i < 4; ++i) *(LAS unsigned short*)(L + S_VT + (c.vc4 + ((i + sft) & 3)) * 144 + c.vt * 2) = (unsigned short)vz[i]; }
    { f32x4 OX = {0.f, 0.f, 0.f, 0.f};
#pragma unroll
      for (int kk = 0; kk < 4; ++kk) OX = MFMA16(lds16(L + S_ST + (c.tc * 16 + c.fr) * 272 + kk * 64 + c.fq * 16), s.Q[kk], OX);
      const bool valid = n >= 4; const float sc = valid ? c.osc * c.xiT : 0.f;
      if (c.dir == 0) { const int nn = valid ? n - 4 : 0;
          *(f32x4*)((char*)c.ORp + (((size_t)c.b * 4096 + nn * 64) * 512 + c.h * 128 + c.slice * 32) * 4 + c.lo) = s.O + OX * sc; }
      else { const size_t row = valid ? (size_t)c.b * 4096 + (n - 4) * 64 + c.tr * 16 + c.fr : (size_t)LROWS + c.tr * 16 + c.fr;
          u32x2 o; o.x = pk2(OX[0] * sc, OX[1] * sc); o.y = pk2(OX[2] * sc, OX[3] * sc);
          *(u32x2*)(c.ORB + row * 512 + c.h * 128 + c.slice * 32 + c.tc * 16 + c.fq * 4) = o; } }
    lds_barrier();
    { S0 *= c.gC; S1 *= c.gC;
#pragma unroll
      for (int kk = 0; kk < 2; ++kk) { S0 = MFMA16(s.K[kk], lds16(L + S_VT + c.fr * 144 + kk * 64 + c.fq * 16), S0); S1 = MFMA16(s.K[kk], lds16(L + S_VT + (16 + c.fr) * 144 + kk * 64 + c.fq * 16), S1); }
      u32x2 o; o.x = pk2(S0[0], S0[1]); o.y = pk2(S0[2], S0[3]); *(LAS u32x2*)(L + S_ST + c.fr * 272 + (c.w * 16 + c.fq * 4) * 2) = o;
      o.x = pk2(S1[0], S1[1]); o.y = pk2(S1[2], S1[3]); *(LAS u32x2*)(L + S_ST + (16 + c.fr) * 272 + (c.w * 16 + c.fq * 4) * 2) = o; }
    lds_barrier();
}
DI void scan_ret(const Params& p, ldsp L, int b, int h, int dir, int slice, float osc) {
    const int tid = threadIdx.x, lane = tid & 63, w = __builtin_amdgcn_readfirstlane(tid >> 6);
    RCtx c; c.RQ = (const bf16_t*)(p.ws + WS_RQ); c.RK = (const bf16_t*)(p.ws + WS_RK); c.RV = (const bf16_t*)(p.ws + WS_RV); c.ORp = p.out + (size_t)LROWS * 512; c.ORB = (bf16_t*)(p.ws + WS_ORB);
    c.b = b; c.h = h; c.dir = dir; c.slice = slice; c.w = w; c.fr = lane & 15; c.fq = lane >> 4; c.tr = w >> 1; c.tc = w & 1; c.osc = osc; c.vt = tid >> 3; c.vc4 = (tid & 7) * 4;
    c.lq = (unsigned)(((c.tr * 16 + c.fq) * 512 + c.fr * 8) * 2); c.lk = (unsigned)(((w * 8 + c.fq) * 512 + c.fr * 8) * 2); c.lv = (unsigned)((c.vt * 512 + slice * 32 + c.vc4) * 2); c.lo = (unsigned)(((c.tr * 16 + c.fr) * 512 + c.tc * 16 + c.fq * 4) * 4);
    const float lg2 = logsig_f(p.ret_logit[dir * 4 + h]) * 1.4426950408889634f;
    c.gC = exp2f(64.f * lg2); c.zeta = exp2f((float)(dir ? c.vt : 63 - c.vt) * lg2);
    { const int t = c.tr * 16 + c.fr; c.xiT = exp2f((float)(dir ? 64 - t : t + 1) * lg2); }
    for (int e = tid; e < (8704 + 4608) / 4; e += NT) ((LAS unsigned*)L)[e] = 0u;
    lds_barrier();
    f32x4 S0 = {0.f, 0.f, 0.f, 0.f}, S1 = {0.f, 0.f, 0.f, 0.f};
    RSet A, B, C;
    ret_load(A, c, chunk_of(0, dir)); ret_load(B, c, chunk_of(1, dir));
#pragma unroll 1
    for (int i = 0; i < 66; i += 6) {
        ret_load(C, c, chunk_of(i + 2, dir)); ret_step(A, c, L, S0, S1, chunk_of(i, dir));
        ret_load(A, c, chunk_of(i + 3, dir)); ret_step(B, c, L, S0, S1, chunk_of(i + 1, dir));
        ret_load(B, c, chunk_of(i + 4, dir)); ret_step(C, c, L, S0, S1, chunk_of(i + 2, dir));
        ret_load(C, c, chunk_of(i + 5, dir)); ret_step(A, c, L, S0, S1, chunk_of(i + 3, dir));
        ret_load(A, c, chunk_of(i + 6, dir)); ret_step(B, c, L, S0, S1, chunk_of(i + 4, dir));
        ret_load(B, c, chunk_of(i + 7, dir)); ret_step(C, c, L, S0, S1, chunk_of(i + 5, dir));
    }
    ret_step(A, c, L, S0, S1, chunk_of(66, dir)); ret_step(B, c, L, S0, S1, chunk_of(67, dir));
}

DI void phase_postnorm(const Params& p, ldsp L) {
    const int tid = threadIdx.x, lane = tid & 63, w = tid >> 6;
    const float* OG = p.out; const float* ORp = p.out + (size_t)LROWS * 512;
    const bf16_t* Z = (const bf16_t*)(p.ws + WS_Z); const bf16_t* RG = (const bf16_t*)(p.ws + WS_RG);
    const bf16_t* OGB = (const bf16_t*)(p.ws + WS_OGB); const bf16_t* ORB = (const bf16_t*)(p.ws + WS_ORB);
    bf16_t* Y = (bf16_t*)(p.ws + WS_Y);
    const int d0 = (lane & 15) * 8;
    float gg[8], rg_[8];
#pragma unroll
    for (int e = 0; e < 8; ++e) { gg[e] = p.gdn_norm_g[d0 + e]; rg_[e] = p.ret_norm_g[d0 + e]; }
#pragma unroll 2
    for (int R = blockIdx.x * 8 + w; R < LROWS; R += gridDim.x * 8) {
        const size_t prow = (size_t)(R >> 12) * TT + 256 + (R & 4095);
        { const f32x4 a = __builtin_nontemporal_load((const f32x4*)(OG + (size_t)R * 512 + lane * 8)), c = __builtin_nontemporal_load((const f32x4*)(OG + (size_t)R * 512 + lane * 8 + 4));
          const u32x4 sb = __builtin_nontemporal_load((const u32x4*)(OGB + (size_t)R * 512 + lane * 8));
          float v[8] = {a.x + bflo(sb.x), a.y + bfhi(sb.x), a.z + bflo(sb.y), a.w + bfhi(sb.y), c.x + bflo(sb.z), c.y + bfhi(sb.z), c.z + bflo(sb.w), c.w + bfhi(sb.w)}; float ss = 0;
#pragma unroll
          for (int e = 0; e < 8; ++e) ss += v[e] * v[e];
          ss += __shfl_xor(ss, 1); ss += __shfl_xor(ss, 2); ss += __shfl_xor(ss, 4); ss += __shfl_xor(ss, 8);
          const float rs = rsqrtf(ss * (1.f / 128.f) + 1e-6f);
          const u32x4 z = __builtin_nontemporal_load((const u32x4*)(Z + prow * 512 + lane * 8)); const unsigned zz[4] = {z.x, z.y, z.z, z.w}; unsigned o[4];
#pragma unroll
          for (int e = 0; e < 4; ++e) o[e] = pk2(v[2 * e] * rs * gg[2 * e] * silu_f(bflo(zz[e])), v[2 * e + 1] * rs * gg[2 * e + 1] * silu_f(bfhi(zz[e])));
          *(u32x4*)(Y + (size_t)R * 1024 + lane * 8) = (u32x4){o[0], o[1], o[2], o[3]}; }
        { const f32x4 a = __builtin_nontemporal_load((const f32x4*)(ORp + (size_t)R * 512 + lane * 8)), c = __builtin_nontemporal_load((const f32x4*)(ORp + (size_t)R * 512 + lane * 8 + 4));
          const u32x4 sb = __builtin_nontemporal_load((const u32x4*)(ORB + (size_t)R * 512 + lane * 8));
          float v[8] = {a.x + bflo(sb.x), a.y + bfhi(sb.x), a.z + bflo(sb.y), a.w + bfhi(sb.y), c.x + bflo(sb.z), c.y + bfhi(sb.z), c.z + bflo(sb.w), c.w + bfhi(sb.w)}; float s = 0;
#pragma unroll
          for (int e = 0; e < 8; ++e) s += v[e];
          s += __shfl_xor(s, 1); s += __shfl_xor(s, 2); s += __shfl_xor(s, 4); s += __shfl_xor(s, 8);
          const float mu = s * (1.f / 128.f); float ss = 0;
#pragma unroll
          for (int e = 0; e < 8; ++e) { v[e] -= mu; ss += v[e] * v[e]; }
          ss += __shfl_xor(ss, 1); ss += __shfl_xor(ss, 2); ss += __shfl_xor(ss, 4); ss += __shfl_xor(ss, 8);
          const float rs = rsqrtf(ss * (1.f / 128.f) + 1e-6f);
          const u32x4 z = __builtin_nontemporal_load((const u32x4*)(RG + prow * 512 + lane * 8)); const unsigned zz[4] = {z.x, z.y, z.z, z.w}; unsigned o[4];
#pragma unroll
          for (int e = 0; e < 4; ++e) o[e] = pk2(v[2 * e] * rs * rg_[2 * e] * silu_f(bflo(zz[e])), v[2 * e + 1] * rs * rg_[2 * e + 1] * silu_f(bfhi(zz[e])));
          *(u32x4*)(Y + (size_t)R * 1024 + 512 + lane * 8) = (u32x4){o[0], o[1], o[2], o[3]}; }
    }
    __syncthreads();
    bf16_t* WoT = (bf16_t*)(p.ws + WS_WOUTT); bf16_t* WfiT = (bf16_t*)(p.ws + WS_WFIT); bf16_t* WfoT = (bf16_t*)(p.ws + WS_WFOT);
    if (gridDim.x == 256) {
        for (int j = blockIdx.x; j < 1408; j += 2 * gridDim.x) { TD d[2];
#pragma unroll
            for (int u = 0; u < 2; ++u) { const int jj = j + u * gridDim.x, jc = jj < 1408 ? jj : j, kt = jc & 15, nt = jc >> 4, n0 = nt * 64, pn = n0 >> 8, bj = (n0 >> 7) & 1, i = n0 & 127;
                d[u] = TD{p.w_ffn_in, 5632, kt * 64, bj * 2816 + pn * 128 + i, WfiT, 1024, n0, jj < 1408}; }
            transpose2(d[0], d[1], L); }
    } else
    for (int j = blockIdx.x; j < 256 + 1408 + 704; j += gridDim.x) {
        if (j < 256) { const int kt = j & 15, nt = j >> 4; transpose_item(p.w_out, 1024, kt * 64, nt * 64, WoT, 1024, nt * 64, L); }
        else if (j < 256 + 1408) { const int jj = j - 256, kt = jj & 15, nt = jj >> 4, n0 = nt * 64;
            const int pn = n0 >> 8, bj = (n0 >> 7) & 1, i = n0 & 127; transpose_item(p.w_ffn_in, 5632, kt * 64, bj * 2816 + pn * 128 + i, WfiT, 1024, n0, L); }
        else { const int jj = j - 256 - 1408, kt = jj % 44, nt = jj / 44; transpose_item(p.w_ffn_out, 1024, kt * 64, nt * 64, WfoT, 2816, nt * 64, L); }
    }
}

DI void phase_norm2(const Params& p) {
    const int tid = threadIdx.x, lane = tid & 63, w = tid >> 6;
    const float* X1 = (const float*)(p.ws + WS_X1); const float* MOD = (const float*)(p.ws + WS_MOD); bf16_t* A3 = (bf16_t*)(p.ws + WS_A3);
    const int nwv = gridDim.x * 8;
    for (int R0 = blockIdx.x * 8 + w; R0 < LROWS; R0 += 2 * nwv) {
        f32x4 v[2][4]; int Rr[2]; bool ok[2];
#pragma unroll
        for (int u = 0; u < 2; ++u) { const int R = R0 + u * nwv; ok[u] = R < LROWS; Rr[u] = ok[u] ? R : R0; const float* src = X1 + (size_t)Rr[u] * 1024;
#pragma unroll
            for (int i = 0; i < 4; ++i) v[u][i] = *(const f32x4*)(src + (lane + 64 * i) * 4); }
        float ss[2];
#pragma unroll
        for (int u = 0; u < 2; ++u) { ss[u] = 0;
#pragma unroll
            for (int i = 0; i < 4; ++i) ss[u] += v[u][i].x * v[u][i].x + v[u][i].y * v[u][i].y + v[u][i].z * v[u][i].z + v[u][i].w * v[u][i].w; }
        for (int o = 32; o; o >>= 1) { ss[0] += __shfl_xor(ss[0], o); ss[1] += __shfl_xor(ss[1], o); }
#pragma unroll
        for (int u = 0; u < 2; ++u) { const float rstd = rsqrtf(ss[u] * (1.f / 1024.f) + 1e-6f); const float* mod = MOD + (size_t)(Rr[u] >> 12) * 6144;
#pragma unroll
            for (int i = 0; i < 4; ++i) { const int k = (lane + 64 * i) * 4;
                const f32x4 g = *(const f32x4*)(p.norm_ffn_g + k), sh = *(const f32x4*)(mod + 3072 + k), sc = *(const f32x4*)(mod + 4096 + k);
                const f32x4 hh = v[u][i] * rstd * g * (sc + 1.f) + sh;
                u32x2 o; o.x = pk2(hh.x, hh.y); o.y = pk2(hh.z, hh.w); if (ok[u]) *(u32x2*)(A3 + (size_t)Rr[u] * 1024 + k) = o; } }
    }
}
DI void phase_final(const Params& p) {
    const float* SSF = (const float*)(p.ws + WS_SSF);
    const int nth = gridDim.x * NT;
#pragma unroll 1
    for (int c0 = blockIdx.x * NT + threadIdx.x; c0 < LROWS * 256; c0 += 8 * nth) {
        f32x4 v[8]; float rs[8];
#pragma unroll
        for (int u = 0; u < 8; ++u) { const int c = c0 + u * nth; v[u] = __builtin_nontemporal_load((const f32x4*)(p.out + (size_t)c * 4)); rs[u] = SSF[c >> 8]; }
#pragma unroll
        for (int u = 0; u < 8; ++u) { const int c = c0 + u * nth; const f32x4 g = *(const f32x4*)(p.final_g + (c & 255) * 4);
            __builtin_nontemporal_store(v[u] * rsqrtf(rs[u] * (1.f / 1024.f) + 1e-6f) * g, (f32x4*)(p.out + (size_t)c * 4)); }
    }
}

#define XB_TMO      128
#define XB_XCNT(j)  (256  + 64 * (j))
#define XB_XSUB(j)  (1280 + 64 * (j))
#define XB_XGEN(j)  (2304 + 64 * (j))
#define XB_TOP      3328
#define XB_TOPGEN   3392
#define XCD_BAR_WORDS 3456
#define XB_SPIN_CAP (1u << 18)

__device__ __forceinline__ unsigned xb_ld(unsigned* p)              { return __hip_atomic_load(p, __ATOMIC_RELAXED, __HIP_MEMORY_SCOPE_AGENT); }
__device__ __forceinline__ unsigned xb_add(unsigned* p, unsigned v) { return __hip_atomic_fetch_add(p, v, __ATOMIC_RELAXED, __HIP_MEMORY_SCOPE_AGENT); }
__device__ __forceinline__ unsigned xb_xcc_id() { return (unsigned)__builtin_amdgcn_s_getreg((3 << 11) | 20) & 0xFu; }
#define XB_SPIN(cond, bar) do { unsigned _sp = 0; while (cond) { __builtin_amdgcn_s_sleep(1); \
    if ((++_sp & 255u) == 0u) { if (xb_ld(&(bar)[XB_TMO])) break; if (_sp > XB_SPIN_CAP) { atomicAdd(&(bar)[XB_TMO], 1u); break; } } } } while (0)

struct XcdBarrier {
    unsigned* bar; unsigned x;
    volatile LAS unsigned* st;
};

__device__ __forceinline__ XcdBarrier xcd_barrier_post(unsigned* bar, volatile LAS unsigned* st) {
    XcdBarrier b; b.bar = bar; b.x = xb_xcc_id(); b.st = st;
    if (threadIdx.x == 0) (void)xb_add(&bar[XB_XCNT(b.x)], 1u);
    return b;
}
__device__ __forceinline__ void xcd_barrier_complete(unsigned* bar, unsigned x, unsigned& nloc, unsigned& nx) {
    const unsigned G = gridDim.x * gridDim.y * gridDim.z;
    unsigned sum, cnt, mine, sp = 0u;
    for (;;) {
        sum = 0u; cnt = 0u; mine = 0u;
#pragma unroll
        for (unsigned j = 0; j < 16; ++j) { const unsigned c = xb_ld(&bar[XB_XCNT(j)]); sum += c; cnt += (c > 0u) ? 1u : 0u; mine = (j == x) ? c : mine; }
        if (sum == G) break;
        __builtin_amdgcn_s_sleep(1);
        if ((++sp & 255u) == 0u) { if (xb_ld(&bar[XB_TMO])) break; if (sp > XB_SPIN_CAP) { atomicAdd(&bar[XB_TMO], 1u); break; } }
    }
    nloc = mine > 0u ? mine : 1u; nx = cnt > 0u ? cnt : 1u;
}

__device__ __forceinline__ void xcd_barrier(const XcdBarrier& b) {
    asm volatile("s_waitcnt vmcnt(0)" ::: "memory");
    __syncthreads();
    if (threadIdx.x == 0) {
        unsigned* bar = b.bar;
        __builtin_amdgcn_s_waitcnt(0);
        unsigned nloc = b.st[0], nx = b.st[1];
        if (nloc == 0u) { xcd_barrier_complete(bar, b.x, nloc, nx); b.st[0] = nloc; b.st[1] = nx; }
        const unsigned old = xb_add(&bar[XB_XSUB(b.x)], 1u);
        const unsigned gen = old / nloc;
        if (old + 1u == (gen + 1u) * nloc) {
            __builtin_amdgcn_fence(__ATOMIC_RELEASE, "agent");
            asm volatile("s_waitcnt vmcnt(0)" ::: "memory");
            const unsigned og = xb_add(&bar[XB_TOP], 1u);
            const unsigned tg = og / nx;
            if (og + 1u == (tg + 1u) * nx) xb_add(&bar[XB_TOPGEN], 1u);
            else XB_SPIN(xb_ld(&bar[XB_TOPGEN]) == tg, bar);
            __builtin_amdgcn_fence(__ATOMIC_ACQUIRE, "agent");
            xb_add(&bar[XB_XGEN(b.x)], 1u);
            asm volatile("s_waitcnt vmcnt(0)" ::: "memory");
        } else {
            XB_SPIN(xb_ld(&bar[XB_XGEN(b.x)]) == gen, bar);
            __builtin_amdgcn_fence(__ATOMIC_ACQUIRE, "agent");
            asm volatile("s_waitcnt vmcnt(0)" ::: "memory");
        }
    }
    __syncthreads();
}

#ifndef GEMM_ALIGN
#define GEMM_ALIGN true
#endif
#ifndef GEMM_SP2
#define GEMM_SP2 true
#endif
__global__ void __launch_bounds__(NT) mega_fwd(Params p) {
    extern __shared__ __attribute__((aligned(16))) unsigned char lds_raw[];
    ldsp L = (ldsp)lds_raw;
    cg::grid_group grid = cg::this_grid();
    const int lo = p.ph_lo, hi = p.ph_hi;
#ifndef PHMASK
#define PHMASK 0xFFF
#endif
#define IN(k) (((PHMASK >> (k)) & 1) && lo <= (k) && (k) < hi)
    volatile LAS unsigned* xst = (volatile LAS unsigned*)(L + 149000);
    if (threadIdx.x == 0) { xst[0] = 0u; xst[1] = 0u; }
    __syncthreads();
    if (p.pad == 0x5a5a) grid.sync();
    const XcdBarrier xbar = xcd_barrier_post((unsigned*)(p.ws + WS_BAR), xst);
#define SEAM(k) do { if ((k) + 1 < hi) xcd_barrier(xbar); } while (0)
#ifndef DUPMASK
#define DUPMASK 0
#endif
#define NREP(k) (((DUPMASK >> (k)) & 1) ? 2 : 1)
    if (IN(0)) { { phase0(p, L); __syncthreads(); } SEAM(0); }
    if (IN(1)) { { phase1(p, L); __syncthreads(); } SEAM(1); }
    if (IN(2)) { { pg8::Gemm g{(const bf16_t*)(p.ws + WS_A1), (const bf16_t*)(p.ws + WS_WINT), MROWS, N1, 1024}; pg8::StaticOrder S; S.init(MROWS, N1, gridDim.x, blockIdx.x);
        EpiP E{(bf16_t*)(p.ws + WS_P), (float*)(p.ws + WS_GATES)}; pg8::gemm_phase<EpiP, pg8::StaticOrder, GEMM_ALIGN, GEMM_SP2>(L, g, S, E); } SEAM(2); }
    if (IN(3)) { phase_conv(p); SEAM(3); }
    if (IN(4)) { { const bool dry = p.dry != 0;
        if (gridDim.x == 256) {
            const int bx = blockIdx.x;
            for (int it = bx; it < 1088; it += 256) prep_gdn(p, L, it, dry);
            if (bx < 64) { prep_ret(p, L, bx * 2, dry); prep_ret(p, L, bx * 2 + 1, dry); }
            else { for (int j = 0; j < 5; ++j) prep_ret(p, L, 128 + (bx - 64) * 5 + j, dry); }
        } else { for (int it = blockIdx.x; it < 2176; it += gridDim.x) { if (it < 1088) prep_gdn(p, L, it, dry); else prep_ret(p, L, it - 1088, dry); } } } SEAM(4); }
    if (IN(5)) { { const float osc = p.dry ? 0.f : 1.f; for (int bx = blockIdx.x; bx < 256; bx += gridDim.x) { const int xx = bx & 7, yy = bx >> 3, slice = yy & 3, G = (yy >> 2) * 8 + xx;
            const int ty = G >> 5, dir = G & 1, h = (G >> 1) & 3, b = (G >> 3) & 3;
            if (ty == 0) scan_gdn(p, L, b, h, dir, slice, osc); else scan_ret(p, L, b, h, dir, slice, osc); __syncthreads();
            if (ty == 1 && gridDim.x == 256) {
                bf16_t* WoT = (bf16_t*)(p.ws + WS_WOUTT); bf16_t* WfoT = (bf16_t*)(p.ws + WS_WFOT);
                for (int j = bx - 128; j < 960; j += 256) { TD d[2];
#pragma unroll
                    for (int u = 0; u < 2; ++u) { const int jj = j + u * 128, jc = jj < 960 ? jj : j;
                        if (jc < 256) { const int kt = jc & 15, nt = jc >> 4; d[u] = TD{p.w_out, 1024, kt * 64, nt * 64, WoT, 1024, nt * 64, jj < 960}; }
                        else { const int j2 = jc - 256, kt = j2 % 44, nt = j2 / 44; d[u] = TD{p.w_ffn_out, 1024, kt * 64, nt * 64, WfoT, 2816, nt * 64, jj < 960}; } }
                    transpose2(d[0], d[1], L); } } } } SEAM(5); }
    if (IN(6)) { { phase_postnorm(p, L); __syncthreads(); } SEAM(6); }
    if (IN(7)) { { pg8::Gemm g{(const bf16_t*)(p.ws + WS_Y), (const bf16_t*)(p.ws + WS_WOUTT), LROWS, 1024, 1024}; pg8::StaticOrder S; S.init(LROWS, 1024, gridDim.x, blockIdx.x);
        EpiRes2 E{(bf16_t*)(p.ws + WS_X1B), p.x, (const float*)(p.ws + WS_MOD), p.norm_ffn_g, (bf16_t*)(p.ws + WS_A3), (float*)(p.ws + WS_SS)}; pg8::gemm_phase<EpiRes2, pg8::StaticOrder, GEMM_ALIGN, GEMM_SP2>(L, g, S, E); } SEAM(7); }
    if (IN(9)) { { pg8::Gemm g{(const bf16_t*)(p.ws + WS_A3), (const bf16_t*)(p.ws + WS_WFIT), LROWS, 5632, 1024}; pg8::StaticOrder S; S.init(LROWS, 5632, gridDim.x, blockIdx.x);
        EpiGLU2 E{(bf16_t*)(p.ws + WS_H), (const float*)(p.ws + WS_SS), (const float*)(p.ws + WS_BIAS2)}; pg8::gemm_phase<EpiGLU2, pg8::StaticOrder, GEMM_ALIGN, GEMM_SP2>(L, g, S, E); } SEAM(9); }
    if (IN(10)) { { pg8::Gemm g{(const bf16_t*)(p.ws + WS_H), (const bf16_t*)(p.ws + WS_WFOT), LROWS, 1024, 2816}; pg8::StaticOrder S; S.init(LROWS, 1024, gridDim.x, blockIdx.x);
        EpiRes3 E{p.out, (const bf16_t*)(p.ws + WS_X1B), (const float*)(p.ws + WS_MOD) + 5120, (float*)(p.ws + WS_SSF)}; pg8::gemm_phase<EpiRes3, pg8::StaticOrder, GEMM_ALIGN, GEMM_SP2>(L, g, S, E); } SEAM(10); }
    if (IN(11)) { phase_final(p); }
}

extern "C" void kernel_launch(void* const* d_in, const int* in_sizes, int n_in, void* d_out, int out_size, void* d_ws, size_t ws_size, hipStream_t stream) {
    static int grid_blocks = 0;
    if (!grid_blocks) {
        int dev = 0, cus = 0, per_cu = 0;
        hipGetDevice(&dev);
        hipDeviceGetAttribute(&cus, hipDeviceAttributeMultiprocessorCount, dev);
        if (hipFuncSetAttribute((const void*)mega_fwd, hipFuncAttributeMaxDynamicSharedMemorySize, LDS_BYTES) != hipSuccess) fprintf(stderr, "hipFuncSetAttribute failed\n");
        hipOccupancyMaxActiveBlocksPerMultiprocessor(&per_cu, (const void*)mega_fwd, NT, LDS_BYTES);
        if (per_cu < 1) per_cu = 1;
        grid_blocks = cus * per_cu;
        if (grid_blocks > 256) grid_blocks = 256;
    }
#ifndef PROBE_SEQ
#define PROBE_SEQ {0, 12, 0}
#endif
    static const int seq[][3] = {PROBE_SEQ};
    hipError_t e = hipSuccess;
    for (unsigned li = 0; li < sizeof(seq) / sizeof(seq[0]); ++li) {
        Params p{};
        const float** f = (const float**)&p;
        for (int i = 0; i < 19; ++i) f[i] = (const float*)d_in[i];
        p.out = (float*)d_out; p.ws = (unsigned char*)d_ws; p.ph_lo = seq[li][0]; p.ph_hi = seq[li][1]; p.dry = seq[li][2]; p.pad = 0;
        void* args[] = {&p};
        if (hipMemsetAsync((unsigned char*)d_ws + WS_BAR, 0, 3456 * 4, stream) != hipSuccess) fprintf(stderr, "barrier memset failed\n");
        e = hipLaunchCooperativeKernel((const void*)mega_fwd, dim3(grid_blocks), dim3(NT), args, LDS_BYTES, stream);
        if (e != hipSuccess) break;
    }
    if (e != hipSuccess) fprintf(stderr, "cooperative launch failed: %s (grid %d)\n", hipGetErrorString(e), grid_blocks);
}
```

```cpp
#include <hip/hip_runtime.h>
#include <hip/hip_cooperative_groups.h>
#include <cstdio>
namespace cg = cooperative_groups;
namespace pg8 {
#define PG8_LAS __attribute__((address_space(3)))
typedef unsigned short bf16_t;
typedef short bf16x8 __attribute__((ext_vector_type(8)));
typedef float f32x4 __attribute__((ext_vector_type(4)));
typedef unsigned u32x4 __attribute__((ext_vector_type(4)));
constexpr int BM = 256, BK = 64, HALF = 128, HTB = HALF * BK * 2  , STAGE_BYTES = 8 * HTB, NXCD = 8, WGM = 8;

__host__ __device__ __forceinline__ int lds_byte(int r, int c) { const int st = (r >> 4) * 2 + (c >> 5), rr = r & 15, cc = c & 31, ob = rr * 64 + cc * 2; return st * 1024 + (ob ^ (((ob >> 9) & 1) << 5)); }
__host__ __device__ __forceinline__ void stage_rc(int b, int& R, int& C) { const int st = b / 1024, sb = b % 1024, swz = sb ^ (((sb >> 9) & 1) << 5); R = (st >> 1) * 16 + swz / 64; C = (st & 1) * 32 + (swz % 64) / 2; }
__host__ __device__ __forceinline__ int perm32(int rho) { const int n = rho >> 4, i = rho & 15; return 8 * (i >> 2) + 4 * n + (i & 3); }

struct Unit { int pm, pn; };
struct Gemm { const bf16_t* A; const bf16_t* Bt; int M, N, K; };

struct StaticOrder {
    int nM, nN, nwg, G, c;
    __host__ __device__ void init(int M, int N, int G_, int c_) { nM = M / BM; nN = N / BM; nwg = nM * nN; G = G_; c = c_; }
    __host__ __device__ bool next(int i, Unit& u) const {
        const long L = (long)i * G + c; if (L >= nwg) return false;
        int wgid = (int)L; { const int q = nwg / NXCD, r = nwg % NXCD, xcd = wgid % NXCD, off = wgid / NXCD; wgid = (xcd < r ? xcd * (q + 1) : r * (q + 1) + (xcd - r) * q) + off; }
        const int nig = WGM * nN, gid = wgid / nig, fm = gid * WGM, gsz = (nM - fm) < WGM ? (nM - fm) : WGM;
        u.pm = fm + ((wgid % nig) % gsz); u.pn = (wgid % nig) / gsz; return true;
    }
    __device__ __forceinline__ void a_ready(const Unit&) const {}
    __device__ __forceinline__ void done(const Unit&) const {}
};

__device__ __forceinline__ unsigned cvt_pk_bf16(float lo, float hi) { unsigned r; asm volatile("v_cvt_pk_bf16_f32 %0, %1, %2" : "=v"(r) : "v"(lo), "v"(hi)); return r; }
template <class Epi, class Sched, bool ALIGN_EPI = false, bool SP2 = false>
__device__ __forceinline__ void gemm_phase(PG8_LAS unsigned char* lds, const Gemm g, const Sched& S, const Epi& E) {
    const int tid = threadIdx.x, wid = __builtin_amdgcn_readfirstlane(tid >> 6), lane = tid & 63, wr = wid >> 2, wc = wid & 3, fr = lane & 15, fq = lane >> 4;
    const int K = g.K, nt = K / BK;
    unsigned voffA[2], voffB[2];
#pragma unroll
    for (int i = 0; i < 2; ++i) { int R, C; stage_rc(tid * 16 + i * 8192, R, C); const int Rb = Epi::PERM ? ((R & ~31) + perm32(R & 31)) : R;
        voffA[i] = (unsigned)(R * K + C) * 2u; voffB[i] = (unsigned)(Rb * K + C) * 2u; }
    const size_t kstep = (size_t)(BK * 2);
    const size_t hstep = (size_t)HALF * K * 2;
    const size_t tstep = 2 * hstep;
    const unsigned ldsw = (unsigned)wid * 1024u;
    const int aoff = lds_byte(wr * 64 + fr, fq * 8), boff = lds_byte(wc * 32 + fr, fq * 8);
#define PG8_SA(b, h) (((b) * 2 + (h)) * HTB)
#define PG8_SB(b, h) ((4 + (b) * 2 + (h)) * HTB)
#define PG8_STAGE(bufoff, gbase, voff) do { _Pragma("unroll") for (int _i = 0; _i < 2; ++_i) \
        __builtin_amdgcn_global_load_lds((const unsigned*)((const char*)(gbase) + (voff)[_i]), (PG8_LAS unsigned*)(lds + (bufoff) + ldsw + _i * 8192), 16, 0, 0); } while (0)
#define PG8_LDA(dst, b, h) do { _Pragma("unroll") for (int m = 0; m < 4; ++m) _Pragma("unroll") for (int k = 0; k < 2; ++k) dst[m][k] = *(const PG8_LAS bf16x8*)(lds + PG8_SA(b, h) + aoff + m * 2048 + k * 1024); } while (0)
#define PG8_LDB(dst, b, h) do { _Pragma("unroll") for (int n = 0; n < 2; ++n) _Pragma("unroll") for (int k = 0; k < 2; ++k) dst[n][k] = *(const PG8_LAS bf16x8*)(lds + PG8_SB(b, h) + boff + n * 2048 + k * 1024); } while (0)
#define PG8_MMA(ai, bj, At, Bt) do { __builtin_amdgcn_s_setprio(1); _Pragma("unroll") for (int m = 0; m < 4; ++m) _Pragma("unroll") for (int n = 0; n < 2; ++n) _Pragma("unroll") for (int k = 0; k < 2; ++k) \
        acc[ai][bj][m][n] = __builtin_amdgcn_mfma_f32_16x16x32_bf16(Bt[n][k], At[m][k], acc[ai][bj][m][n], 0, 0, 0); __builtin_amdgcn_s_setprio(0); } while (0)
#define PG8_WAIT_V(n) asm volatile("s_waitcnt vmcnt(" #n ")" ::: "memory")
#define PG8_WAIT_L(n) asm volatile("s_waitcnt lgkmcnt(" #n ")" ::: "memory")
#define PG8_BAR __builtin_amdgcn_s_barrier()
#define PG8_SCHED __builtin_amdgcn_sched_barrier(0)
    Unit cur, nxt; int ui = 0;
    if (!S.next(0, cur)) return;
    f32x4 acc[2][2][4][2];
#pragma unroll
    for (int a = 0; a < 2; ++a)
#pragma unroll
        for (int b = 0; b < 2; ++b)
#pragma unroll
            for (int m = 0; m < 4; ++m)
#pragma unroll
                for (int n = 0; n < 2; ++n) acc[a][b][m][n] = (f32x4){0.f, 0.f, 0.f, 0.f};
    bf16x8 At[4][2], B0[2][2], B1[2][2];
    const char* cA = (const char*)g.A + (size_t)cur.pm * tstep; const char* cB = (const char*)g.Bt + (size_t)cur.pn * tstep;
    S.a_ready(cur);
    if constexpr (SP2) {
        PG8_STAGE(PG8_SB(0, 0), cB, voffB); PG8_STAGE(PG8_SB(0, 1), cB + hstep, voffB); PG8_STAGE(PG8_SA(0, 0), cA, voffA); PG8_STAGE(PG8_SA(0, 1), cA + hstep, voffA);
        if (wr == 1) PG8_BAR;
        PG8_WAIT_V(2); PG8_BAR;
        PG8_STAGE(PG8_SB(1, 0), cB + kstep, voffB); PG8_STAGE(PG8_SA(1, 0), cA + kstep, voffA); PG8_STAGE(PG8_SB(1, 1), cB + hstep + kstep, voffB);
        PG8_WAIT_V(6); PG8_BAR;
    } else {
        PG8_STAGE(PG8_SB(0, 0), cB, voffB); PG8_STAGE(PG8_SA(0, 0), cA, voffA); PG8_STAGE(PG8_SB(0, 1), cB + hstep, voffB); PG8_STAGE(PG8_SA(0, 1), cA + hstep, voffA);
        if (wr == 1) PG8_BAR;
        PG8_WAIT_V(4); PG8_BAR;
        PG8_STAGE(PG8_SB(1, 0), cB + kstep, voffB); PG8_STAGE(PG8_SA(1, 0), cA + kstep, voffA); PG8_STAGE(PG8_SB(1, 1), cB + hstep + kstep, voffB);
        PG8_WAIT_V(6); PG8_BAR;
    }
    for (;;) {
        const bool has_next = S.next(ui + 1, nxt);
        const char* nA = has_next ? (const char*)g.A + (size_t)nxt.pm * tstep : cA; const char* nB = has_next ? (const char*)g.Bt + (size_t)nxt.pn * tstep : cB;
        for (int t = 0; t < nt; t += 2) {
            const bool last = (t == nt - 2);
            const char* a1 = cA + (size_t)(t + 1) * kstep;
            const char* a2 = last ? nA : cA + (size_t)(t + 2) * kstep; const char* b2 = last ? nB : cB + (size_t)(t + 2) * kstep;
            const char* a3 = a2 + kstep; const char* b3 = b2 + kstep;
            if (last && has_next) S.a_ready(nxt);
            if constexpr (SP2) {
            PG8_LDB(B0, 0, 0); PG8_LDB(B1, 0, 1); PG8_SCHED; PG8_LDA(At, 0, 0); PG8_STAGE(PG8_SA(1, 1), a1 + hstep, voffA);
            PG8_WAIT_V(8); PG8_WAIT_L(0); PG8_BAR; PG8_MMA(0, 0, At, B0); PG8_MMA(0, 1, At, B1); PG8_BAR; PG8_SCHED;
            PG8_LDA(At, 0, 1); PG8_STAGE(PG8_SB(0, 0), b2, voffB); PG8_STAGE(PG8_SB(0, 1), b2 + hstep, voffB); PG8_STAGE(PG8_SA(0, 0), a2, voffA);
            PG8_WAIT_V(8); PG8_WAIT_L(0); PG8_BAR; PG8_MMA(1, 0, At, B0); PG8_MMA(1, 1, At, B1); PG8_BAR; PG8_SCHED;
            PG8_LDB(B0, 1, 0); PG8_LDB(B1, 1, 1); PG8_SCHED; PG8_LDA(At, 1, 0); PG8_STAGE(PG8_SA(0, 1), a2 + hstep, voffA);
            PG8_WAIT_V(8); PG8_WAIT_L(0); PG8_BAR; PG8_MMA(0, 0, At, B0); PG8_MMA(0, 1, At, B1); PG8_BAR; PG8_SCHED;
            PG8_LDA(At, 1, 1); PG8_STAGE(PG8_SB(1, 0), b3, voffB); PG8_STAGE(PG8_SB(1, 1), b3 + hstep, voffB); PG8_STAGE(PG8_SA(1, 0), a3, voffA);
            PG8_WAIT_V(8); PG8_WAIT_L(0); PG8_BAR; PG8_MMA(1, 0, At, B0); PG8_MMA(1, 1, At, B1); PG8_BAR; PG8_SCHED;
            } else {
            PG8_LDB(B0, 0, 0); PG8_SCHED; PG8_LDA(At, 0, 0); PG8_STAGE(PG8_SA(1, 1), a1 + hstep, voffA);
            PG8_WAIT_L(8); PG8_BAR; PG8_WAIT_L(0); PG8_MMA(0, 0, At, B0); PG8_BAR; PG8_SCHED;
            PG8_LDB(B1, 0, 1); PG8_STAGE(PG8_SB(0, 0), b2, voffB);
            PG8_BAR; PG8_WAIT_L(0); PG8_MMA(0, 1, At, B1); PG8_BAR;
            PG8_LDA(At, 0, 1); PG8_STAGE(PG8_SA(0, 0), a2, voffA);
            PG8_BAR; PG8_WAIT_L(0); PG8_MMA(1, 0, At, B0); PG8_BAR; PG8_SCHED;
            PG8_STAGE(PG8_SB(0, 1), b2 + hstep, voffB);
            PG8_WAIT_V(6); PG8_BAR; PG8_MMA(1, 1, At, B1); PG8_BAR;
            PG8_LDB(B0, 1, 0); PG8_SCHED; PG8_LDA(At, 1, 0); PG8_STAGE(PG8_SA(0, 1), a2 + hstep, voffA);
            PG8_WAIT_L(8); PG8_BAR; PG8_WAIT_L(0); PG8_MMA(0, 0, At, B0); PG8_BAR; PG8_SCHED;
            PG8_LDB(B1, 1, 1); PG8_STAGE(PG8_SB(1, 0), b3, voffB);
            PG8_BAR; PG8_WAIT_L(0); PG8_MMA(0, 1, At, B1); PG8_BAR;
            PG8_LDA(At, 1, 1); PG8_STAGE(PG8_SA(1, 0), a3, voffA);
            PG8_BAR; PG8_WAIT_L(0); PG8_MMA(1, 0, At, B0); PG8_BAR; PG8_SCHED;
            PG8_STAGE(PG8_SB(1, 1), b3 + hstep, voffB);
            PG8_WAIT_V(6); PG8_BAR; PG8_MMA(1, 1, At, B1); PG8_BAR;
            }
        }
        if constexpr (ALIGN_EPI) { if (wr == 0) PG8_BAR; }
        if constexpr (!Epi::AFTER_DRAIN) { E(acc, cur, wr, wc, fr, fq); S.done(cur); }
        if (!has_next) break;
#pragma unroll
        for (int a = 0; a < 2; ++a)
#pragma unroll
            for (int b = 0; b < 2; ++b)
#pragma unroll
                for (int m = 0; m < 4; ++m)
#pragma unroll
                    for (int n = 0; n < 2; ++n) acc[a][b][m][n] = (f32x4){0.f, 0.f, 0.f, 0.f};
        cur = nxt; cA = nA; cB = nB; ++ui;
        if constexpr (ALIGN_EPI) { if (wr == 1) PG8_BAR; }
    }
    PG8_WAIT_V(0);
    if constexpr (!ALIGN_EPI) { if (wr == 0) PG8_BAR; }
    PG8_BAR;
    if constexpr (Epi::AFTER_DRAIN) { E.fused(acc, cur, wr, wc, fr, fq, lds, wid, lane); S.done(cur); }
#undef PG8_SA
#undef PG8_SB
#undef PG8_STAGE
#undef PG8_LDA
#undef PG8_LDB
#undef PG8_MMA
#undef PG8_WAIT_V
#undef PG8_WAIT_L
#undef PG8_BAR
#undef PG8_SCHED
}
}

#define DI __device__ __forceinline__
#define LAS __attribute__((address_space(3)))
typedef LAS unsigned char* ldsp;
typedef unsigned short bf16_t;
typedef short bf16x8 __attribute__((ext_vector_type(8)));
typedef float f32x4 __attribute__((ext_vector_type(4)));
typedef unsigned u32x4 __attribute__((ext_vector_type(4)));
typedef unsigned u32x2 __attribute__((ext_vector_type(2)));
#define MFMA16(a, b, c) __builtin_amdgcn_mfma_f32_16x16x32_bf16((a), (b), (c), 0, 0, 0)

constexpr int NT = 512;
constexpr int TT = 4352, MROWS = 17408, LROWS = 16384;
constexpr size_t MiB = (size_t)1 << 20;
constexpr size_t PBUF = 17 * MiB;
constexpr int LDS_BYTES = 149504;
constexpr size_t WS_MOD = 0, WS_GATES = 256 * 1024, WS_SS = 2 * MiB, WS_BIAS2 = 2 * MiB + 256 * 1024, WS_SSF = 2 * MiB + 512 * 1024, WS_BAR = 3 * MiB;
constexpr size_t WS_WINT = 3 * MiB + 512 * 1024, WS_A1 = 12 * MiB, WS_P = 46 * MiB;
constexpr int N1 = 4352;
constexpr size_t WS_QP = WS_P, WS_KP = WS_P + PBUF, WS_VP = WS_P + 2 * PBUF, WS_Z = WS_P + 3 * PBUF, WS_RQ = WS_P + 4 * PBUF, WS_RK = WS_P + 5 * PBUF, WS_RV = WS_P + 6 * PBUF, WS_RG = WS_P + 7 * PBUF;
constexpr size_t WS_QC = 4 * MiB, WS_KC = 21 * MiB, WS_VC = 182 * MiB;
constexpr size_t WS_WF = 46 * MiB, WS_UF = 63 * MiB, WS_QF = 80 * MiB, WS_WB = 199 * MiB, WS_UB = 216 * MiB, WS_QB = 233 * MiB;
constexpr size_t WS_DEC = 250 * MiB;
constexpr size_t WS_Y = 199 * MiB, WS_WOUTT = 38 * MiB, WS_WFOT = 40 * MiB, WS_WFIT = 49 * MiB;
constexpr size_t WS_X1B = 4 * MiB;
constexpr size_t WS_OGB = 4 * MiB, WS_ORB = 182 * MiB;
constexpr size_t WS_X1 = 182 * MiB, WS_A3 = 60 * MiB, WS_H = 92 * MiB;

struct Params {
    const float *x, *c, *ctx, *c_ctx, *ada_w, *ada_b, *norm_mix_g, *norm_ffn_g, *w_in, *conv_w, *a_log, *dt_bias, *gdn_norm_g, *ret_logit, *ret_norm_g, *w_out, *w_ffn_in, *w_ffn_out, *final_g;
    float* out; unsigned char* ws; int ph_lo, ph_hi, dry, pad;
};

DI unsigned short f2bf(float f) { unsigned u = __float_as_uint(f); return (unsigned short)((u + 0x7fffu + ((u >> 16) & 1u)) >> 16); }
DI float bf2f(unsigned v) { return __uint_as_float(v << 16); }
typedef float f32x2_t __attribute__((ext_vector_type(2)));
typedef __bf16 bf16x2_t __attribute__((ext_vector_type(2)));
DI unsigned pk2(float lo, float hi) { const f32x2_t v = {lo, hi}; const bf16x2_t b = __builtin_convertvector(v, bf16x2_t); return __builtin_bit_cast(unsigned, b); }
DI float bflo(unsigned v) { return __uint_as_float(v << 16); }
DI float bfhi(unsigned v) { return __uint_as_float(v & 0xffff0000u); }
DI float silu_f(float x) { return x * __builtin_amdgcn_rcpf(1.f + __expf(-x)); }
DI float sigm_f(float x) { return __builtin_amdgcn_rcpf(1.f + __expf(-x)); }
DI float softplus_f(float x) { return fmaxf(x, 0.f) + log1pf(__expf(-fabsf(x))); }
DI float wave_sum(float v) { for (int o = 32; o; o >>= 1) v += __shfl_xor(v, o); return v; }
DI bf16x8 lds16(ldsp p) { return *(const LAS bf16x8*)p; }
DI void lds_barrier() { asm volatile("s_waitcnt lgkmcnt(0)\n\ts_barrier" ::: "memory"); }

DI void transpose_item(const float* W, int ldw, int k0, int srccol0, bf16_t* WT, int Kdim, int nout0, ldsp L) {
    const int tid = threadIdx.x;
    LAS float* scr = (LAS float*)L;
    for (int e = tid; e < 4096; e += NT) { const int kk = e >> 6, cc = e & 63; scr[kk * 65 + cc] = W[(size_t)(k0 + kk) * ldw + srccol0 + cc]; }
    __syncthreads();
    { const int n = tid >> 3, k8 = (tid & 7) * 8; u32x4 o;
      o.x = pk2(scr[(k8 + 0) * 65 + n], scr[(k8 + 1) * 65 + n]); o.y = pk2(scr[(k8 + 2) * 65 + n], scr[(k8 + 3) * 65 + n]);
      o.z = pk2(scr[(k8 + 4) * 65 + n], scr[(k8 + 5) * 65 + n]); o.w = pk2(scr[(k8 + 6) * 65 + n], scr[(k8 + 7) * 65 + n]);
      *(u32x4*)(WT + (size_t)(nout0 + n) * Kdim + k0 + k8) = o; }
    __syncthreads();
}

struct TD { const float* W; int ldw, k0, src; bf16_t* WT; int Kd, n0; bool on; };
DI void transpose2(const TD a, const TD b, ldsp L) {
    const int tid = threadIdx.x;
    LAS float* sa = (LAS float*)L; LAS float* sb = sa + 64 * 65;
    float va[8], vb[8];
#pragma unroll
    for (int i = 0; i < 8; ++i) { const int e = tid + i * NT, kk = e >> 6, cc = e & 63;
        va[i] = a.W[(size_t)(a.k0 + kk) * a.ldw + a.src + cc]; vb[i] = b.on ? b.W[(size_t)(b.k0 + kk) * b.ldw + b.src + cc] : 0.f; }
#pragma unroll
    for (int i = 0; i < 8; ++i) { const int e = tid + i * NT, kk = e >> 6, cc = e & 63; sa[kk * 65 + cc] = va[i]; sb[kk * 65 + cc] = vb[i]; }
    __syncthreads();
    { const int n = tid >> 3, k8 = (tid & 7) * 8; u32x4 o;
      o.x = pk2(sa[(k8 + 0) * 65 + n], sa[(k8 + 1) * 65 + n]); o.y = pk2(sa[(k8 + 2) * 65 + n], sa[(k8 + 3) * 65 + n]); o.z = pk2(sa[(k8 + 4) * 65 + n], sa[(k8 + 5) * 65 + n]); o.w = pk2(sa[(k8 + 6) * 65 + n], sa[(k8 + 7) * 65 + n]);
      *(u32x4*)(a.WT + (size_t)(a.n0 + n) * a.Kd + a.k0 + k8) = o;
      if (b.on) { o.x = pk2(sb[(k8 + 0) * 65 + n], sb[(k8 + 1) * 65 + n]); o.y = pk2(sb[(k8 + 2) * 65 + n], sb[(k8 + 3) * 65 + n]); o.z = pk2(sb[(k8 + 4) * 65 + n], sb[(k8 + 5) * 65 + n]); o.w = pk2(sb[(k8 + 6) * 65 + n], sb[(k8 + 7) * 65 + n]);
          *(u32x4*)(b.WT + (size_t)(b.n0 + n) * b.Kd + b.k0 + k8) = o; } }
    __syncthreads();
}
DI void phase0(const Params& p, ldsp L) {
    const int tid = threadIdx.x;
    float* MOD = (float*)(p.ws + WS_MOD);
    if (blockIdx.x < 192) {
        LAS float* sc = (LAS float*)L; LAS float* red = sc + 5120;
        for (int e = tid; e < 5120; e += NT) { const int r = e >> 10, k = e & 1023; const float v = r < 4 ? p.c[r * 1024 + k] : p.c_ctx[k]; sc[e] = silu_f(v); }
        __syncthreads();
        for (int it = blockIdx.x; it < 192; it += gridDim.x) {
            const int cl = tid & 31, kg = tid >> 5, col = it * 32 + cl;
            float a0 = 0, a1 = 0, a2 = 0, a3 = 0, a4 = 0;
#pragma unroll 64
            for (int k = kg * 64; k < kg * 64 + 64; ++k) { const float w = p.ada_w[(size_t)k * 6144 + col]; a0 += sc[k] * w; a1 += sc[1024 + k] * w; a2 += sc[2048 + k] * w; a3 += sc[3072 + k] * w; a4 += sc[4096 + k] * w; }
            red[(kg * 5 + 0) * 32 + cl] = a0; red[(kg * 5 + 1) * 32 + cl] = a1; red[(kg * 5 + 2) * 32 + cl] = a2; red[(kg * 5 + 3) * 32 + cl] = a3; red[(kg * 5 + 4) * 32 + cl] = a4;
            __syncthreads();
            if (tid < 160) { const int r = tid >> 5; float s = 0; for (int g = 0; g < 16; ++g) s += red[(g * 5 + r) * 32 + cl]; MOD[r * 6144 + col] = s + p.ada_b[col]; }
            __syncthreads();
        }
    }
    { unsigned* zw = (unsigned*)(p.ws + WS_WINT + (size_t)4160 * 2048); for (int e = blockIdx.x * NT + tid; e < 192 * 512; e += gridDim.x * NT) zw[e] = 0u; }
    { float* zs = (float*)(p.ws + WS_SS); float* zf = (float*)(p.ws + WS_SSF); for (int e = blockIdx.x * NT + tid; e < 16384; e += gridDim.x * NT) { zs[e] = 0.f; zf[e] = 0.f; }
      float* zb = (float*)(p.ws + WS_BIAS2); for (int e = blockIdx.x * NT + tid; e < 4 * 5632; e += gridDim.x * NT) zb[e] = 0.f; }
}

DI void phase1(const Params& p, ldsp L) {
    const int tid = threadIdx.x, lane = tid & 63, w = tid >> 6;
    const float* MOD = (const float*)(p.ws + WS_MOD);
    bf16_t* A1 = (bf16_t*)(p.ws + WS_A1);
    const int nwv = gridDim.x * 8;
    for (int R0 = blockIdx.x * 8 + w; R0 < MROWS; R0 += 2 * nwv) {
        f32x4 v[2][4]; const float* mod[2]; int Rr[2]; bool ok[2];
#pragma unroll
        for (int u = 0; u < 2; ++u) { const int R = R0 + u * nwv; ok[u] = R < MROWS; const int Rc = ok[u] ? R : R0; Rr[u] = Rc; const int b = Rc / TT, t = Rc % TT;
            const float* src = t < 256 ? p.ctx + ((size_t)b * 256 + t) * 1024 : p.x + ((size_t)b * 4096 + (t - 256)) * 1024; mod[u] = MOD + (t < 256 ? 4 : b) * 6144;
#pragma unroll
            for (int i = 0; i < 4; ++i) v[u][i] = __builtin_nontemporal_load((const f32x4*)(src + (lane + 64 * i) * 4)); }
        float ss[2];
#pragma unroll
        for (int u = 0; u < 2; ++u) { ss[u] = 0;
#pragma unroll
            for (int i = 0; i < 4; ++i) ss[u] += v[u][i].x * v[u][i].x + v[u][i].y * v[u][i].y + v[u][i].z * v[u][i].z + v[u][i].w * v[u][i].w; }
        for (int o = 32; o; o >>= 1) { ss[0] += __shfl_xor(ss[0], o); ss[1] += __shfl_xor(ss[1], o); }
#pragma unroll
        for (int u = 0; u < 2; ++u) { const float rstd = rsqrtf(ss[u] * (1.f / 1024.f) + 1e-6f);
#pragma unroll
            for (int i = 0; i < 4; ++i) { const int k = (lane + 64 * i) * 4;
                const f32x4 g = *(const f32x4*)(p.norm_mix_g + k), sh = *(const f32x4*)(mod[u] + k), sc = *(const f32x4*)(mod[u] + 1024 + k);
                v[u][i] = v[u][i] * rstd * g * (sc + 1.f) + sh;
                u32x2 o; o.x = pk2(v[u][i].x, v[u][i].y); o.y = pk2(v[u][i].z, v[u][i].w); if (ok[u]) *(u32x2*)(A1 + (size_t)Rr[u] * 1024 + k) = o; } }
    }
    { float* BIAS2 = (float*)(p.ws + WS_BIAS2); LAS float* red = (LAS float*)L;
      for (int it = blockIdx.x; it < 176; it += gridDim.x) { const int ng = it % 11, kq = tid >> 7, k0 = (it / 11) * 64 + kq * 16, cl = (tid & 127) * 4;
          f32x4 a0 = {0.f, 0.f, 0.f, 0.f}, a1 = a0, a2 = a0, a3 = a0;
#pragma unroll
          for (int kk = 0; kk < 16; ++kk) { const int k = k0 + kk; const f32x4 wv = *(const f32x4*)(p.w_ffn_in + (size_t)k * 5632 + ng * 512 + cl);
              a0 += wv * MOD[3072 + k]; a1 += wv * MOD[6144 + 3072 + k]; a2 += wv * MOD[2 * 6144 + 3072 + k]; a3 += wv * MOD[3 * 6144 + 3072 + k]; }
          *(LAS f32x4*)(red + (kq * 4 + 0) * 512 + cl) = a0; *(LAS f32x4*)(red + (kq * 4 + 1) * 512 + cl) = a1; *(LAS f32x4*)(red + (kq * 4 + 2) * 512 + cl) = a2; *(LAS f32x4*)(red + (kq * 4 + 3) * 512 + cl) = a3;
          __syncthreads();
#pragma unroll
          for (int b = 0; b < 4; ++b) { const float sm = red[(0 * 4 + b) * 512 + tid] + red[(1 * 4 + b) * 512 + tid] + red[(2 * 4 + b) * 512 + tid] + red[(3 * 4 + b) * 512 + tid];
              unsafeAtomicAdd(BIAS2 + b * 5632 + ng * 512 + tid, sm); }
          __syncthreads(); } }
    { bf16_t* WinT = (bf16_t*)(p.ws + WS_WINT);
      for (int j = blockIdx.x; j < 1040; j += 2 * gridDim.x) { TD d[2];
#pragma unroll
          for (int u = 0; u < 2; ++u) { const int jj = j + u * gridDim.x, jc = jj < 1040 ? jj : j, kt = jc & 15, nt = jc >> 4, n0 = nt * 64;
              d[u] = TD{p.w_in, 4112, kt * 64, nt == 64 ? 2048 : (n0 < 2048 ? n0 : n0 + 16), WinT, 1024, n0, jj < 1040}; }
          transpose2(d[0], d[1], L); } }
}

struct EpiP {
    static constexpr bool PERM = true, AFTER_DRAIN = false;
    bf16_t* O; float* gates;
    DI void operator()(const f32x4 (&acc)[2][2][4][2], const pg8::Unit& u, int wr, int wc, int fr, int fq) const {
        if (u.pn == 16) {
            if (wc == 0 && fq < 2) { const int r0 = u.pm * 256 + wr * 64 + fr;
#pragma unroll
                for (int ai = 0; ai < 2; ++ai)
#pragma unroll
                    for (int m = 0; m < 4; ++m)
#pragma unroll
                        for (int n = 0; n < 2; ++n) *(f32x4*)(gates + (size_t)(r0 + ai * 128 + m * 16) * 16 + 8 * fq + 4 * n) = acc[ai][0][m][n]; }
            return; }
        const int row0 = u.pm * 256 + wr * 64 + fr; int colt = u.pn * 256; const int t = colt >> 9; bf16_t* base = O + (size_t)t * (PBUF / 2); colt -= t * 512;
        const int col0 = colt + wc * 32 + 8 * fq;
#pragma unroll
        for (int ai = 0; ai < 2; ++ai)
#pragma unroll
            for (int m = 0; m < 4; ++m) { bf16_t* rowp = base + (size_t)(row0 + ai * 128 + m * 16) * 512 + col0;
#pragma unroll
                for (int bj = 0; bj < 2; ++bj) { const f32x4 v0 = acc[ai][bj][m][0], v1 = acc[ai][bj][m][1]; u32x4 o;
                    o.x = pg8::cvt_pk_bf16(v0[0], v0[1]); o.y = pg8::cvt_pk_bf16(v0[2], v0[3]); o.z = pg8::cvt_pk_bf16(v1[0], v1[1]); o.w = pg8::cvt_pk_bf16(v1[2], v1[3]);
                    *(u32x4*)(rowp + bj * 128) = o; } }
    }
};
struct EpiRes {
    static constexpr bool PERM = false, AFTER_DRAIN = false;
    float* out; const float* res; const float* gate;
    DI void operator()(const f32x4 (&acc)[2][2][4][2], const pg8::Unit& u, int wr, int wc, int fr, int fq) const {
        const int row0 = u.pm * 256 + wr * 64 + fr, col0 = u.pn * 256 + wc * 32 + 4 * fq;
        const float* gp = gate + (size_t)(row0 >> 12) * 6144 + col0;
        f32x4 gv[2][2];
#pragma unroll
        for (int bj = 0; bj < 2; ++bj)
#pragma unroll
            for (int n = 0; n < 2; ++n) gv[bj][n] = *(const f32x4*)(gp + bj * 128 + n * 16);
#pragma unroll
        for (int ai = 0; ai < 2; ++ai)
#pragma unroll
            for (int m = 0; m < 4; ++m) { const size_t ro = (size_t)(row0 + ai * 128 + m * 16) * 1024 + col0;
#pragma unroll
                for (int bj = 0; bj < 2; ++bj)
#pragma unroll
                    for (int n = 0; n < 2; ++n) { const f32x4 r = *(const f32x4*)(res + ro + bj * 128 + n * 16); *(f32x4*)(out + ro + bj * 128 + n * 16) = r + gv[bj][n] * acc[ai][bj][m][n]; } }
    }
};
struct EpiGLU {
    static constexpr bool PERM = true, AFTER_DRAIN = false;
    bf16_t* H;
    DI void operator()(const f32x4 (&acc)[2][2][4][2], const pg8::Unit& u, int wr, int wc, int fr, int fq) const {
        const int row0 = u.pm * 256 + wr * 64 + fr, col0 = u.pn * 128 + wc * 32 + 8 * fq;
#pragma unroll
        for (int ai = 0; ai < 2; ++ai)
#pragma unroll
            for (int m = 0; m < 4; ++m) { bf16_t* rowp = H + (size_t)(row0 + ai * 128 + m * 16) * 2816 + col0;
                const f32x4 g0 = acc[ai][0][m][0], g1 = acc[ai][0][m][1], u0 = acc[ai][1][m][0], u1 = acc[ai][1][m][1]; u32x4 o;
                o.x = pg8::cvt_pk_bf16(silu_f(g0[0]) * u0[0], silu_f(g0[1]) * u0[1]); o.y = pg8::cvt_pk_bf16(silu_f(g0[2]) * u0[2], silu_f(g0[3]) * u0[3]);
                o.z = pg8::cvt_pk_bf16(silu_f(g1[0]) * u1[0], silu_f(g1[1]) * u1[1]); o.w = pg8::cvt_pk_bf16(silu_f(g1[2]) * u1[2], silu_f(g1[3]) * u1[3]);
                *(u32x4*)rowp = o; }
    }
};

struct EpiRes2 {
    static constexpr bool PERM = false, AFTER_DRAIN = false;
    bf16_t* out; const float* res; const float* mod; const float* gffn; bf16_t* A3; float* SS;
    DI void operator()(const f32x4 (&acc)[2][2][4][2], const pg8::Unit& u, int wr, int wc, int fr, int fq) const {
        const int row0 = u.pm * 256 + wr * 64 + fr, col0 = u.pn * 256 + wc * 32 + 4 * fq;
        const float* mp = mod + (size_t)(row0 >> 12) * 6144 + col0;
        f32x4 gv[2][2], gs[2][2];
#pragma unroll
        for (int bj = 0; bj < 2; ++bj)
#pragma unroll
            for (int n = 0; n < 2; ++n) { gv[bj][n] = *(const f32x4*)(mp + 2048 + bj * 128 + n * 16); gs[bj][n] = *(const f32x4*)(gffn + col0 + bj * 128 + n * 16) * (*(const f32x4*)(mp + 4096 + bj * 128 + n * 16) + 1.f); }
#pragma unroll
        for (int ai = 0; ai < 2; ++ai)
#pragma unroll
            for (int m = 0; m < 4; ++m) { const int row = row0 + ai * 128 + m * 16; const size_t ro = (size_t)row * 1024 + col0; float ssq = 0.f;
#pragma unroll
                for (int bj = 0; bj < 2; ++bj)
#pragma unroll
                    for (int n = 0; n < 2; ++n) { const f32x4 r = *(const f32x4*)(res + ro + bj * 128 + n * 16); const f32x4 x1 = r + gv[bj][n] * acc[ai][bj][m][n];
                        { u32x2 xo; xo.x = pk2(x1.x, x1.y); xo.y = pk2(x1.z, x1.w); *(u32x2*)(out + ro + bj * 128 + n * 16) = xo; } ssq += x1.x * x1.x + x1.y * x1.y + x1.z * x1.z + x1.w * x1.w;
                        const f32x4 a = x1 * gs[bj][n]; u32x2 o; o.x = pk2(a.x, a.y); o.y = pk2(a.z, a.w); *(u32x2*)(A3 + ro + bj * 128 + n * 16) = o; }
                ssq += __shfl_xor(ssq, 16); ssq += __shfl_xor(ssq, 32);
                if (fq == 0) unsafeAtomicAdd(SS + row, ssq); }
    }
};
struct EpiGLU2 {
    static constexpr bool PERM = true, AFTER_DRAIN = false;
    bf16_t* H; const float* SS; const float* bias;
    DI void operator()(const f32x4 (&acc)[2][2][4][2], const pg8::Unit& u, int wr, int wc, int fr, int fq) const {
        const int row0 = u.pm * 256 + wr * 64 + fr, col0 = u.pn * 128 + wc * 32 + 8 * fq;
        const float* bp = bias + (size_t)(row0 >> 12) * 5632 + col0;
        const f32x4 bg0 = *(const f32x4*)bp, bg1 = *(const f32x4*)(bp + 4), bu0 = *(const f32x4*)(bp + 2816), bu1 = *(const f32x4*)(bp + 2816 + 4);
#pragma unroll
        for (int ai = 0; ai < 2; ++ai)
#pragma unroll
            for (int m = 0; m < 4; ++m) { const int row = row0 + ai * 128 + m * 16; bf16_t* rowp = H + (size_t)row * 2816 + col0;
                const float rstd = rsqrtf(SS[row] * (1.f / 1024.f) + 1e-6f);
                const f32x4 g0 = acc[ai][0][m][0] * rstd + bg0, g1 = acc[ai][0][m][1] * rstd + bg1, u0 = acc[ai][1][m][0] * rstd + bu0, u1 = acc[ai][1][m][1] * rstd + bu1; u32x4 o;
                o.x = pk2(silu_f(g0[0]) * u0[0], silu_f(g0[1]) * u0[1]); o.y = pk2(silu_f(g0[2]) * u0[2], silu_f(g0[3]) * u0[3]);
                o.z = pk2(silu_f(g1[0]) * u1[0], silu_f(g1[1]) * u1[1]); o.w = pk2(silu_f(g1[2]) * u1[2], silu_f(g1[3]) * u1[3]);
                *(u32x4*)rowp = o; }
    }
};

struct EpiRes3 {
    static constexpr bool PERM = false, AFTER_DRAIN = false;
    float* out; const bf16_t* res; const float* gate; float* SSF;
    DI void operator()(const f32x4 (&acc)[2][2][4][2], const pg8::Unit& u, int wr, int wc, int fr, int fq) const {
        const int row0 = u.pm * 256 + wr * 64 + fr, col0 = u.pn * 256 + wc * 32 + 4 * fq;
        const float* gp = gate + (size_t)(row0 >> 12) * 6144 + col0;
        f32x4 gv[2][2];
#pragma unroll
        for (int bj = 0; bj < 2; ++bj)
#pragma unroll
            for (int n = 0; n < 2; ++n) gv[bj][n] = *(const f32x4*)(gp + bj * 128 + n * 16);
#pragma unroll
        for (int ai = 0; ai < 2; ++ai)
#pragma unroll
            for (int m = 0; m < 4; ++m) { const int row = row0 + ai * 128 + m * 16; const size_t ro = (size_t)row * 1024 + col0; float ssq = 0.f;
#pragma unroll
                for (int bj = 0; bj < 2; ++bj)
#pragma unroll
                    for (int n = 0; n < 2; ++n) { const u32x2 rb = *(const u32x2*)(res + ro + bj * 128 + n * 16); const f32x4 r = {bflo(rb.x), bfhi(rb.x), bflo(rb.y), bfhi(rb.y)}; const f32x4 x2 = r + gv[bj][n] * acc[ai][bj][m][n];
                        *(f32x4*)(out + ro + bj * 128 + n * 16) = x2; ssq += x2.x * x2.x + x2.y * x2.y + x2.z * x2.z + x2.w * x2.w; }
                ssq += __shfl_xor(ssq, 16); ssq += __shfl_xor(ssq, 32);
                if (fq == 0) unsafeAtomicAdd(SSF + row, ssq); }
    }
};

DI void phase_conv(const Params& p) {
    const int tid = threadIdx.x;
    const int tensor = blockIdx.x % 3, g = blockIdx.x / 3, Gt = (gridDim.x - tensor + 2) / 3;
    const bf16_t* __restrict__ src = (const bf16_t*)(p.ws + WS_QP + (size_t)tensor * PBUF);
    bf16_t* __restrict__ dst = (bf16_t*)(p.ws + (tensor == 0 ? WS_QC : tensor == 1 ? WS_KC : WS_VC));
    const int colb = (tid & 63) * 8, cwb = tensor * 512 + colb, rq = (tid >> 6) * 4;
    float cw[5][8];
#pragma unroll
    for (int i = 0; i < 5; ++i) { const f32x4 a = *(const f32x4*)(p.conv_w + i * 1536 + cwb), bq = *(const f32x4*)(p.conv_w + i * 1536 + cwb + 4);
        cw[i][0] = a.x; cw[i][1] = a.y; cw[i][2] = a.z; cw[i][3] = a.w; cw[i][4] = bq.x; cw[i][5] = bq.y; cw[i][6] = bq.z; cw[i][7] = bq.w; }
    u32x4 in[8], nx[8];
#define CONV_LOAD(dstv, j_) do { const int cr_ = (j_) >> 1, b_ = cr_ / 68, n_ = cr_ % 68, t0_ = n_ * 64 + ((j_) & 1) * 32 + rq; const int lo_ = n_ < 4 ? 0 : 256, hi_ = n_ < 4 ? 256 : TT; \
        _Pragma("unroll") for (int i = 0; i < 8; ++i) { const int tt = t0_ + i - 2; dstv[i] = (u32x4){0u, 0u, 0u, 0u}; if (tt >= lo_ && tt < hi_) dstv[i] = *(const u32x4*)(src + ((size_t)b_ * TT + tt) * 512 + colb); } } while (0)
    if (g < 544) CONV_LOAD(in, g);
#pragma unroll 1
    for (int j = g; j < 544; j += Gt) {
        if (j + Gt < 544) CONV_LOAD(nx, j + Gt);
        const int cr = j >> 1, b = cr / 68, n = cr % 68, t0 = n * 64 + (j & 1) * 32 + rq;
#pragma unroll
        for (int u = 0; u < 4; ++u) {
            float acc[8];
#pragma unroll
            for (int e = 0; e < 8; ++e) acc[e] = 0.f;
#pragma unroll
            for (int i = 0; i < 5; ++i) { const u32x4 v = in[u + i];
                acc[0] += bflo(v.x) * cw[i][0]; acc[1] += bfhi(v.x) * cw[i][1]; acc[2] += bflo(v.y) * cw[i][2]; acc[3] += bfhi(v.y) * cw[i][3];
                acc[4] += bflo(v.z) * cw[i][4]; acc[5] += bfhi(v.z) * cw[i][5]; acc[6] += bflo(v.w) * cw[i][6]; acc[7] += bfhi(v.w) * cw[i][7]; }
            float ss = 0;
#pragma unroll
            for (int e = 0; e < 8; ++e) { acc[e] = silu_f(acc[e]); ss += acc[e] * acc[e]; }
            if (tensor < 2) { ss += __shfl_xor(ss, 1); ss += __shfl_xor(ss, 2); ss += __shfl_xor(ss, 4); ss += __shfl_xor(ss, 8);
                const float sc = rsqrtf(ss + 1e-6f) * (tensor == 0 ? 0.08838834764831845f : 1.f);
#pragma unroll
                for (int e = 0; e < 8; ++e) acc[e] *= sc; }
            u32x4 o; o.x = pk2(acc[0], acc[1]); o.y = pk2(acc[2], acc[3]); o.z = pk2(acc[4], acc[5]); o.w = pk2(acc[6], acc[7]);
            *(u32x4*)(dst + ((size_t)b * TT + t0 + u) * 512 + colb) = o;
        }
#pragma unroll
        for (int i = 0; i < 8; ++i) in[i] = nx[i];
    }
#undef CONV_LOAD
}

constexpr int L_QS = 0, L_KS = 17408, L_WT = 0, L_UT = 18432, L_KT = 36864, L_VT = 55296, L_AA = 73728, L_QKF = 91136, L_QKB = 100352,
              L_TWF = 109568, L_TUF = 118784, L_TWB = 128000, L_TUB = 137216, L_VEC = 146432;
static_assert(L_VEC + 1024 <= LDS_BYTES, "lds");

DI void rot4(unsigned (&a)[4], int sft) {
    if (sft & 1) { const unsigned t = a[0]; a[0] = a[1]; a[1] = a[2]; a[2] = a[3]; a[3] = t; }
    if (sft & 2) { const unsigned t0 = a[0], t1 = a[1]; a[0] = a[2]; a[1] = a[3]; a[2] = t0; a[3] = t1; }
}
#define MFMA4F(a, b, c) __builtin_amdgcn_mfma_f32_16x16x4f32((a), (b), (c), 0, 0, 0)
constexpr int L_DS = 0;
DI void solve_diag(ldsp L, int w, int lane) {
    const int dir = w >> 2, k = w & 3, c = lane & 15;
    const LAS float* AA = (const LAS float*)(L + L_AA); const LAS float* VEC = (const LAS float*)(L + L_VEC);
    const int sg = dir ? -1 : 1, o0 = dir ? 63 : 0;
    const LAS float* Ab = AA + (o0 + sg * 16 * k) * 68 + (o0 + sg * 16 * k);
    float D[16];
#pragma unroll
    for (int i = 0; i < 16; ++i) { float s0 = (c == i) ? 1.f : 0.f;
#pragma unroll
        for (int j = 0; j < i; ++j) s0 -= Ab[sg * (i * 68 + j)] * D[j];
        D[i] = s0; }
    const int Cc = o0 + sg * (16 * k + c);
    const float beta = VEC[(dir ? 192 : 128) + Cc], cw = beta * __expf(VEC[(dir ? 64 : 0) + Cc]);
    ldsp TW = L + (dir ? L_TWB : L_TWF), TU = L + (dir ? L_TUB : L_TUF);
    if (lane < 16) {
#pragma unroll
        for (int i = 0; i < 16; ++i) { *(LAS float*)(L + L_DS + ((w * 16 + i) * 20 + c) * 4) = D[i];
            const int R = o0 + sg * (16 * k + i);
            *(LAS unsigned short*)(TW + R * 144 + Cc * 2) = f2bf(D[i] * cw); *(LAS unsigned short*)(TU + R * 144 + Cc * 2) = f2bf(D[i] * beta); } }
}
template <int KB> DI void solve_offdiag(ldsp L, int dir, int lane) {
    const int fr = lane & 15, fq = lane >> 4;
    const LAS float* AA = (const LAS float*)(L + L_AA); const LAS float* VEC = (const LAS float*)(L + L_VEC);
    const LAS float* DS = (const LAS float*)(L + L_DS) + dir * 4 * 320;
    const int sg = dir ? -1 : 1, o0 = dir ? 63 : 0;
    const int Cc = o0 + sg * (16 * KB + fr);
    const float beta = VEC[(dir ? 192 : 128) + Cc], cw = beta * __expf(VEC[(dir ? 64 : 0) + Cc]);
    ldsp TW = L + (dir ? L_TWB : L_TWF), TU = L + (dir ? L_TUB : L_TUF);
    f32x4 Tb[4];
#pragma unroll
    for (int r = 0; r < 4; ++r) Tb[KB][r] = DS[KB * 320 + (4 * fq + r) * 20 + fr];
#pragma unroll
    for (int i = KB + 1; i < 4; ++i) {
        f32x4 P = {0.f, 0.f, 0.f, 0.f};
#pragma unroll
        for (int j = KB; j < i; ++j) {
            const int row = o0 + sg * (16 * i + fr);
            f32x4 a;
            if (dir == 0) a = *(const LAS f32x4*)(AA + row * 68 + 16 * j + 4 * fq);
            else { const f32x4 t = *(const LAS f32x4*)(AA + row * 68 + 60 - 16 * j - 4 * fq); a = (f32x4){t.w, t.z, t.y, t.x}; }
#pragma unroll
            for (int r = 0; r < 4; ++r) P = MFMA4F(a[r], Tb[j][r], P);
        }
        const f32x4 d = *(const LAS f32x4*)(DS + i * 320 + fr * 20 + 4 * fq);
        f32x4 Z = {0.f, 0.f, 0.f, 0.f};
#pragma unroll
        for (int r = 0; r < 4; ++r) Z = MFMA4F(d[r], P[r], Z);
        Tb[i] = -Z;
#pragma unroll
        for (int r = 0; r < 4; ++r) { const int R = o0 + sg * (16 * i + 4 * fq + r);
            *(LAS unsigned short*)(TW + R * 144 + Cc * 2) = f2bf(Tb[i][r] * cw); *(LAS unsigned short*)(TU + R * 144 + Cc * 2) = f2bf(Tb[i][r] * beta); }
    }
}

DI void prep_gdn(const Params& p, ldsp L, int it, bool dry) {
    const int tid = threadIdx.x, lane = tid & 63, w = __builtin_amdgcn_readfirstlane(tid >> 6), fr = lane & 15, fq = lane >> 4;
    const int cr = it >> 2, h = it & 3, b = cr / 68, n = cr % 68;
    const size_t row0 = (size_t)b * TT + n * 64;
    const bf16_t* QC = (const bf16_t*)(p.ws + WS_QC); bf16_t* KC = (bf16_t*)(p.ws + WS_KC); const bf16_t* VC = (const bf16_t*)(p.ws + WS_VC);
    float* OG = p.out;
    LAS float* VEC = (LAS float*)(L + L_VEC);
#pragma unroll
    for (int u = 0; u < 2; ++u) { const int cid = w * 2 + u, r = (cid & 3) * 16 + fr, c8 = ((cid >> 2) * 4 + fq) * 8;
        const size_t g = (row0 + r) * 512 + h * 128 + c8;
        const u32x4 q = *(const u32x4*)(QC + g), k = *(const u32x4*)(KC + g), v = *(const u32x4*)(VC + g);
        *(LAS u32x4*)(L + L_QS + r * 272 + c8 * 2) = q; *(LAS u32x4*)(L + L_KS + r * 272 + c8 * 2) = k;
        unsigned kk[4] = {k.x, k.y, k.z, k.w}, vv[4] = {v.x, v.y, v.z, v.w};
        rot4(kk, fq); rot4(vv, fq);
#pragma unroll
        for (int e = 0; e < 4; ++e) { const int row = c8 + 2 * ((e + fq) & 3);
            *(LAS unsigned short*)(L + L_KT + row * 144 + r * 2) = (unsigned short)(kk[e] & 0xffff); *(LAS unsigned short*)(L + L_KT + (row + 1) * 144 + r * 2) = (unsigned short)(kk[e] >> 16);
            *(LAS unsigned short*)(L + L_VT + row * 144 + r * 2) = (unsigned short)(vv[e] & 0xffff); *(LAS unsigned short*)(L + L_VT + (row + 1) * 144 + r * 2) = (unsigned short)(vv[e] >> 16); } }
    for (int e = tid; e < 9216; e += NT) *(LAS unsigned*)(L + L_TWF + e * 4) = 0u;
    if (tid < 64) {
        const float* gp = (const float*)(p.ws + WS_GATES) + (row0 + tid) * 16;
        const float gf = -__expf(p.a_log[h]) * softplus_f(gp[h] + p.dt_bias[h]);
        const float gb = -__expf(p.a_log[4 + h]) * softplus_f(gp[4 + h] + p.dt_bias[4 + h]);
        float pf = gf, pb = gb;
        for (int o = 1; o < 64; o <<= 1) { const float a = __shfl_up(pf, o), c = __shfl_up(pb, o); if (lane >= o) { pf += a; pb += c; } }
        const float totb = __shfl(pb, 63), GfL = __shfl(pf, 63);
        const float Gf = pf, Gb = totb - pb + gb;
        VEC[tid] = Gf; VEC[64 + tid] = Gb; VEC[128 + tid] = sigm_f(gp[8 + h]); VEC[192 + tid] = sigm_f(gp[12 + h]);
        float* dec = (float*)(p.ws + WS_DEC) + (size_t)(it * 2) * 80;
        dec[tid] = __expf(GfL - Gf); dec[80 + tid] = __expf(totb - Gb);
        if (tid == 0) { dec[64] = __expf(GfL); dec[80 + 64] = __expf(totb); }
    }
    lds_barrier();
    { const int mat = w >> 2, tr = w & 3;
      ldsp Ab = L + (mat ? L_QS : L_KS);
      bf16x8 a[4];
#pragma unroll
      for (int kk = 0; kk < 4; ++kk) a[kk] = lds16(Ab + (tr * 16 + fr) * 272 + kk * 64 + fq * 16);
#pragma unroll
      for (int tc = 0; tc < 4; ++tc) {
          f32x4 acc = {0.f, 0.f, 0.f, 0.f};
#pragma unroll
          for (int kk = 0; kk < 4; ++kk) acc = MFMA16(a[kk], lds16(L + L_KS + (tc * 16 + fr) * 272 + kk * 64 + fq * 16), acc);
          const int s = tc * 16 + fr; const float Gfs = VEC[s], Gbs = VEC[64 + s];
#pragma unroll
          for (int j = 0; j < 4; ++j) { const int t = tr * 16 + fq * 4 + j; const float Gft = VEC[t], Gbt = VEC[64 + t];
              if (mat == 0) { float v = 0.f; if (s < t) v = VEC[128 + t] * acc[j] * __expf(Gft - Gfs); else if (s > t) v = VEC[192 + t] * acc[j] * __expf(Gbt - Gbs);
                  *(LAS float*)(L + L_AA + (t * 68 + s) * 4) = v; }
              else { const float vf = (s <= t) ? acc[j] * __expf(Gft - Gfs) : 0.f, vb = (s >= t) ? acc[j] * __expf(Gbt - Gbs) : 0.f;
                  *(LAS unsigned short*)(L + L_QKF + t * 144 + s * 2) = f2bf(vf); *(LAS unsigned short*)(L + L_QKB + t * 144 + s * 2) = f2bf(vb); } } } }
    lds_barrier();
    solve_diag(L, w, lane);
    lds_barrier();
    if (w < 6) { const int dr_ = w >= 3 ? 1 : 0, kb = w - 3 * dr_; if (kb == 0) solve_offdiag<0>(L, dr_, lane); else if (kb == 1) solve_offdiag<1>(L, dr_, lane); else solve_offdiag<2>(L, dr_, lane); }
    lds_barrier();
    f32x4 oacc[8];
#pragma unroll
    for (int i = 0; i < 8; ++i) oacc[i] = (f32x4){0.f, 0.f, 0.f, 0.f};
#pragma unroll 1
    for (int dir = 0; dir < 2; ++dir) {
        ldsp TW = L + (dir ? L_TWB : L_TWF), TU = L + (dir ? L_TUB : L_TUF), QKM = L + (dir ? L_QKB : L_QKF);
        bf16_t* Wg = (bf16_t*)(p.ws + (dir ? WS_WB : WS_WF)) + (size_t)it * 8192;
        bf16_t* Ug = (bf16_t*)(p.ws + (dir ? WS_UB : WS_UF)) + (size_t)it * 8192;
        bf16_t* Qg = (bf16_t*)(p.ws + (dir ? WS_QB : WS_QF)) + (size_t)it * 8192;
        u32x2 qv[8];
        if (w < 4) {
#pragma unroll
            for (int dr = 0; dr < 8; ++dr) qv[dr] = *(const u32x2*)(QC + (row0 + w * 16 + fr) * 512 + h * 128 + dr * 16 + fq * 4);
            const bf16x8 b0 = lds16(TW + (w * 16 + fr) * 144 + fq * 16), b1 = lds16(TW + (w * 16 + fr) * 144 + 64 + fq * 16);
            const int t = w * 16 + fr; const float et = dir ? __expf(VEC[64] - VEC[64 + t]) : __expf(VEC[63] - VEC[t]);
#pragma unroll
            for (int dr = 0; dr < 8; ++dr) { f32x4 acc = {0.f, 0.f, 0.f, 0.f};
                acc = MFMA16(lds16(L + L_KT + (dr * 16 + fr) * 144 + fq * 16), b0, acc); acc = MFMA16(lds16(L + L_KT + (dr * 16 + fr) * 144 + 64 + fq * 16), b1, acc);
                const int d0 = dr * 16 + fq * 4; u32x2 o; o.x = pk2(acc[0], acc[1]); o.y = pk2(acc[2], acc[3]);
                { u32x2 og; og.x = pk2(acc[0] * et, acc[1] * et); og.y = pk2(acc[2] * et, acc[3] * et); *(u32x2*)(Wg + ((w * 4 + (dr >> 1)) * 64 + ((dr & 1) * 2 + (fq >> 1)) * 16 + fr) * 8 + (fq & 1) * 4) = og; }
                *(LAS unsigned short*)(L + L_WT + (d0 + 0) * 144 + t * 2) = (unsigned short)(o.x & 0xffff); *(LAS unsigned short*)(L + L_WT + (d0 + 1) * 144 + t * 2) = (unsigned short)(o.x >> 16);
                *(LAS unsigned short*)(L + L_WT + (d0 + 2) * 144 + t * 2) = (unsigned short)(o.y & 0xffff); *(LAS unsigned short*)(L + L_WT + (d0 + 3) * 144 + t * 2) = (unsigned short)(o.y >> 16); }
        } else {
            const int tw = w - 4;
            const bf16x8 a0 = lds16(TU + (tw * 16 + fr) * 144 + fq * 16), a1 = lds16(TU + (tw * 16 + fr) * 144 + 64 + fq * 16);
            const int t0 = tw * 16 + fq * 4; float eu[4];
#pragma unroll
            for (int j = 0; j < 4; ++j) eu[j] = dir ? __expf(VEC[64] - VEC[64 + t0 + j]) : __expf(VEC[63] - VEC[t0 + j]);
#pragma unroll
            for (int tc = 0; tc < 8; ++tc) { f32x4 acc = {0.f, 0.f, 0.f, 0.f};
                acc = MFMA16(a0, lds16(L + L_VT + (tc * 16 + fr) * 144 + fq * 16), acc); acc = MFMA16(a1, lds16(L + L_VT + (tc * 16 + fr) * 144 + 64 + fq * 16), acc);
                const int c = tc * 16 + fr; u32x2 o; o.x = pk2(acc[0], acc[1]); o.y = pk2(acc[2], acc[3]);
                *(LAS u32x2*)(L + L_UT + c * 144 + t0 * 2) = o; { u32x2 og; og.x = pk2(acc[0] * eu[0], acc[1] * eu[1]); og.y = pk2(acc[2] * eu[2], acc[3] * eu[3]); *(u32x2*)(Ug + c * 64 + t0) = og; } }
        }
        lds_barrier();
        if (w < 4) {
            const bf16x8 b0 = lds16(QKM + (w * 16 + fr) * 144 + fq * 16), b1 = lds16(QKM + (w * 16 + fr) * 144 + 64 + fq * 16);
            const int t = w * 16 + fr; const float eg = __expf(VEC[(dir ? 64 : 0) + t]);
#pragma unroll
            for (int dr = 0; dr < 8; ++dr) { f32x4 acc = {0.f, 0.f, 0.f, 0.f};
                acc = MFMA16(lds16(L + L_WT + (dr * 16 + fr) * 144 + fq * 16), b0, acc); acc = MFMA16(lds16(L + L_WT + (dr * 16 + fr) * 144 + 64 + fq * 16), b1, acc);
                const u32x2 q = qv[dr];
                u32x2 o; o.x = pk2(eg * bflo(q.x) - acc[0], eg * bfhi(q.x) - acc[1]); o.y = pk2(eg * bflo(q.y) - acc[2], eg * bfhi(q.y) - acc[3]);
                *(u32x2*)(Qg + ((w * 4 + (dr >> 1)) * 64 + ((dr & 1) * 2 + (fq >> 1)) * 16 + fr) * 8 + (fq & 1) * 4) = o; }
        } else {
            const int tw = w - 4;
            const bf16x8 b0 = lds16(QKM + (tw * 16 + fr) * 144 + fq * 16), b1 = lds16(QKM + (tw * 16 + fr) * 144 + 64 + fq * 16);
#pragma unroll
            for (int ct = 0; ct < 8; ++ct) { oacc[ct] = MFMA16(lds16(L + L_UT + (ct * 16 + fr) * 144 + fq * 16), b0, oacc[ct]); oacc[ct] = MFMA16(lds16(L + L_UT + (ct * 16 + fr) * 144 + 64 + fq * 16), b1, oacc[ct]); }
        }
        lds_barrier();
    }
    if (w >= 4 && n >= 4) { const int t = (w - 4) * 16 + fr; const size_t lrow = (size_t)b * 4096 + (n - 4) * 64 + t;
#pragma unroll
        for (int ct = 0; ct < 8; ++ct) *(f32x4*)(OG + lrow * 512 + h * 128 + ct * 16 + fq * 4) = oacc[ct]; }
    if (!dry) for (int pc = tid; pc < 1024; pc += NT) { const int d = pc >> 3, t8 = (pc & 7) * 8; const u32x4 v = *(const LAS u32x4*)(L + L_KT + d * 144 + t8 * 2);
        { const int e_ = ((((d >> 4) * 2 + (t8 >> 5)) * 64) + ((t8 >> 3) & 3) * 16 + (d & 15)) * 8; *(u32x4*)(KC + (row0 + (e_ >> 7)) * 512 + h * 128 + (e_ & 127)) = v; } }
    lds_barrier();
}

DI float logsig_f(float x) { return -softplus_f(-x); }

DI void prep_ret(const Params& p, ldsp L, int it, bool dry) {
    const int tid = threadIdx.x, lane = tid & 63, w = __builtin_amdgcn_readfirstlane(tid >> 6), fr = lane & 15, fq = lane >> 4;
    const int cr = it >> 2, h = it & 3, b = cr / 68, n = cr % 68; const bool isctx = n < 4;
    const size_t row0 = (size_t)b * TT + n * 64;
    bf16_t* RQ = (bf16_t*)(p.ws + WS_RQ); bf16_t* RK = (bf16_t*)(p.ws + WS_RK); const bf16_t* RV = (const bf16_t*)(p.ws + WS_RV);
    float* ORp = p.out + (size_t)LROWS * 512;
    constexpr int R_QS = 0, R_KS = 17408, R_KT = 36864, R_VT = 55296, R_QKD = 73728;
    const float lgf2 = logsig_f(p.ret_logit[h]) * 1.4426950408889634f, lgb2 = logsig_f(p.ret_logit[4 + h]) * 1.4426950408889634f;
    u32x4 q1s = {0u, 0u, 0u, 0u}, q2s = {0u, 0u, 0u, 0u};
    { const int r = (w & 3) * 16 + fr, p8 = ((w >> 2) * 4 + fq) * 8, t = n * 64 + r;
      float pos; int i0; float rc;
      if (p8 < 16) { pos = isctx ? (float)t : 256.f; i0 = p8; rc = 1.f / 16.f; }
      else if (p8 < 40) { pos = isctx ? 0.f : (float)((t - 256) >> 6); i0 = p8 - 16; rc = 1.f / 24.f; }
      else { pos = isctx ? 0.f : (float)((t - 256) & 63); i0 = p8 - 40; rc = 1.f / 24.f; }
      float cs[8], sn[8];
#pragma unroll
      for (int e = 0; e < 8; ++e) { const float ang = pos * exp2f(-13.287712379549449f * (float)(i0 + e) * rc); cs[e] = __cosf(ang); sn[e] = __sinf(ang); }
      const size_t g = (row0 + r) * 512 + h * 128 + p8;
      { const u32x4 k1 = *(const u32x4*)(RK + g), k2 = *(const u32x4*)(RK + g + 64);
        const unsigned a1[4] = {k1.x, k1.y, k1.z, k1.w}, a2[4] = {k2.x, k2.y, k2.z, k2.w}; unsigned o1[4], o2[4];
#pragma unroll
        for (int e = 0; e < 4; ++e) { const float x0 = bflo(a1[e]), x1 = bfhi(a1[e]), y0 = bflo(a2[e]), y1 = bfhi(a2[e]); const float sc = 0.08838834764831845f;
            o1[e] = pk2((x0 * cs[2 * e] - y0 * sn[2 * e]) * sc, (x1 * cs[2 * e + 1] - y1 * sn[2 * e + 1]) * sc);
            o2[e] = pk2((x0 * sn[2 * e] + y0 * cs[2 * e]) * sc, (x1 * sn[2 * e + 1] + y1 * cs[2 * e + 1]) * sc); }
        *(LAS u32x4*)(L + R_KS + r * 272 + p8 * 2) = (u32x4){o1[0], o1[1], o1[2], o1[3]}; *(LAS u32x4*)(L + R_KS + r * 272 + (64 + p8) * 2) = (u32x4){o2[0], o2[1], o2[2], o2[3]};
rot4(o1, fq); rot4(o2, fq);
#pragma unroll
        for (int e = 0; e < 4; ++e) { const int row = p8 + 2 * ((e + fq) & 3);
            *(LAS unsigned short*)(L + R_KT + row * 144 + r * 2) = (unsigned short)(o1[e] & 0xffff); *(LAS unsigned short*)(L + R_KT + (row + 1) * 144 + r * 2) = (unsigned short)(o1[e] >> 16);
            *(LAS unsigned short*)(L + R_KT + (64 + row) * 144 + r * 2) = (unsigned short)(o2[e] & 0xffff); *(LAS unsigned short*)(L + R_KT + (64 + row + 1) * 144 + r * 2) = (unsigned short)(o2[e] >> 16); } }
      if (!isctx) {
        const u32x4 k1 = *(const u32x4*)(RQ + g), k2 = *(const u32x4*)(RQ + g + 64);
        const unsigned a1[4] = {k1.x, k1.y, k1.z, k1.w}, a2[4] = {k2.x, k2.y, k2.z, k2.w}; unsigned o1[4], o2[4];
#pragma unroll
        for (int e = 0; e < 4; ++e) { const float x0 = bflo(a1[e]), x1 = bfhi(a1[e]), y0 = bflo(a2[e]), y1 = bfhi(a2[e]);
            o1[e] = pk2(x0 * cs[2 * e] - y0 * sn[2 * e], x1 * cs[2 * e + 1] - y1 * sn[2 * e + 1]);
            o2[e] = pk2(x0 * sn[2 * e] + y0 * cs[2 * e], x1 * sn[2 * e + 1] + y1 * cs[2 * e + 1]); }
        const u32x4 q1 = {o1[0], o1[1], o1[2], o1[3]}, q2 = {o2[0], o2[1], o2[2], o2[3]};
        *(LAS u32x4*)(L + R_QS + r * 272 + p8 * 2) = q1; *(LAS u32x4*)(L + R_QS + r * 272 + (64 + p8) * 2) = q2;
        q1s = q1; q2s = q2;
#pragma unroll
        for (int u = 0; u < 2; ++u) { const int cid = w * 2 + u, r2 = (cid & 3) * 16 + fr, c8 = ((cid >> 2) * 4 + fq) * 8; const u32x4 v = *(const u32x4*)(RV + (row0 + r2) * 512 + h * 128 + c8);
            unsigned vv[4] = {v.x, v.y, v.z, v.w}; rot4(vv, fq);
#pragma unroll
            for (int e = 0; e < 4; ++e) { const int row = c8 + 2 * ((e + fq) & 3); *(LAS unsigned short*)(L + R_VT + row * 144 + r2 * 2) = (unsigned short)(vv[e] & 0xffff); *(LAS unsigned short*)(L + R_VT + (row + 1) * 144 + r2 * 2) = (unsigned short)(vv[e] >> 16); } }
      }
    }
    lds_barrier();
    if (!dry && !isctx) { const int r = (w & 3) * 16 + fr, p8 = ((w >> 2) * 4 + fq) * 8; const int e1 = ((((r >> 4) * 4 + (p8 >> 5)) * 64) + ((p8 >> 3) & 3) * 16 + (r & 15)) * 8, e2 = e1 + 2 * 64 * 8;
        *(u32x4*)(RQ + (row0 + (e1 >> 7)) * 512 + h * 128 + (e1 & 127)) = q1s; *(u32x4*)(RQ + (row0 + (e2 >> 7)) * 512 + h * 128 + (e2 & 127)) = q2s; }
    if (!dry) for (int pc = tid; pc < 1024; pc += NT) { const int d = pc >> 3, t8 = (pc & 7) * 8; const u32x4 v = *(const LAS u32x4*)(L + R_KT + d * 144 + t8 * 2);
        { const int e_ = ((((d >> 4) * 2 + (t8 >> 5)) * 64) + ((t8 >> 3) & 3) * 16 + (d & 15)) * 8; *(u32x4*)(RK + (row0 + (e_ >> 7)) * 512 + h * 128 + (e_ & 127)) = v; } }
    if (!isctx) {
        { const int tr = w >> 1; bf16x8 a[4];
#pragma unroll
          for (int kk = 0; kk < 4; ++kk) a[kk] = lds16(L + R_QS + (tr * 16 + fr) * 272 + kk * 64 + fq * 16);
#pragma unroll
          for (int x = 0; x < 2; ++x) { const int tc = (w & 1) * 2 + x; f32x4 acc = {0.f, 0.f, 0.f, 0.f};
#pragma unroll
              for (int kk = 0; kk < 4; ++kk) acc = MFMA16(a[kk], lds16(L + R_KS + (tc * 16 + fr) * 272 + kk * 64 + fq * 16), acc);
              const int s = tc * 16 + fr;
#pragma unroll
              for (int j = 0; j < 4; ++j) { const int t = tr * 16 + fq * 4 + j, dt = t - s;
                  const float f = (dt >= 0 ? exp2f((float)dt * lgf2) : 0.f) + (dt <= 0 ? exp2f((float)(-dt) * lgb2) : 0.f);
                  *(LAS unsigned short*)(L + R_QKD + t * 144 + s * 2) = f2bf(acc[j] * f); } } }
        lds_barrier();
        { const int tw = w & 3; const bf16x8 b0 = lds16(L + R_QKD + (tw * 16 + fr) * 144 + fq * 16), b1 = lds16(L + R_QKD + (tw * 16 + fr) * 144 + 64 + fq * 16);
          const int t = tw * 16 + fr; const size_t lrow = (size_t)b * 4096 + (n - 4) * 64 + t;
#pragma unroll
          for (int x = 0; x < 4; ++x) { const int ct = (w >> 2) * 4 + x; f32x4 acc = {0.f, 0.f, 0.f, 0.f};
              acc = MFMA16(lds16(L + R_VT + (ct * 16 + fr) * 144 + fq * 16), b0, acc); acc = MFMA16(lds16(L + R_VT + (ct * 16 + fr) * 144 + 64 + fq * 16), b1, acc);
              *(f32x4*)(ORp + lrow * 512 + h * 128 + ct * 16 + fq * 4) = acc; } }
    }
    lds_barrier();
}

DI int chunk_of(int i, int dir) { return dir == 0 ? i : (i < 4 ? 3 - i : 71 - i); }
constexpr int S_ST = 0, S_VT = 8704;

struct GSet { bf16x8 W[4], Q[4], K[2]; u32x2 U; float gl; f32x4 O; };
struct GCtx { const bf16_t *Wb, *Qb, *Ub, *KC; const float* DEC; float* OG; bf16_t* OGB; int b, h, dir, slice, w, fr, fq, tr, tc; unsigned lw, lk, lu, lo; float osc; };
DI void gdn_load(GSet& s, const GCtx& c, int n) {
    const int it = __builtin_amdgcn_readfirstlane((c.b * 68 + n) * 4 + c.h); const size_t r0 = (size_t)c.b * TT + n * 64;
    const char* wp = (const char*)c.Wb + (size_t)it * 16384; const char* qp = (const char*)c.Qb + (size_t)it * 16384;
#pragma unroll
    for (int kk = 0; kk < 4; ++kk) { s.W[kk] = *(const bf16x8*)(wp + (c.lw + kk * 1024)); s.Q[kk] = *(const bf16x8*)(qp + (c.lw + kk * 1024)); }
    const char* kp = (const char*)c.KC + (r0 * 512 + c.h * 128) * 2;
    s.K[0] = *(const bf16x8*)(kp + c.lk); s.K[1] = *(const bf16x8*)(kp + (c.lk + 4 * 512 * 2));
    s.U = *(const u32x2*)((const char*)c.Ub + (size_t)it * 16384 + c.lu);
    s.gl = c.DEC[(size_t)(it * 2 + c.dir) * 80 + 64];
    if (c.dir == 0) { const int nn = n >= 4 ? n - 4 : 0; s.O = *(const f32x4*)((const char*)c.OG + (((size_t)c.b * 4096 + nn * 64) * 512 + c.h * 128 + c.slice * 32) * 4 + c.lo); }
}
DI void gdn_step(const GSet& s, const GCtx& c, ldsp L, f32x4& S0, f32x4& S1, int n) {
    f32x4 X = {0.f, 0.f, 0.f, 0.f}, OX = {0.f, 0.f, 0.f, 0.f};
#pragma unroll
    for (int kk = 0; kk < 4; ++kk) { const bf16x8 sf = lds16(L + S_ST + (c.tc * 16 + c.fr) * 272 + kk * 64 + c.fq * 16); X = MFMA16(s.W[kk], sf, X); OX = MFMA16(sf, s.Q[kk], OX); }
    { u32x2 o; o.x = pk2(bflo(s.U.x) - X[0], bfhi(s.U.x) - X[1]); o.y = pk2(bflo(s.U.y) - X[2], bfhi(s.U.y) - X[3]);
      *(LAS u32x2*)(L + S_VT + (c.tc * 16 + c.fr) * 144 + (c.tr * 16 + c.fq * 4) * 2) = o; }
    { const bool valid = n >= 4; const float sc = valid ? c.osc : 0.f;
      if (c.dir == 0) { const int nn = valid ? n - 4 : 0;
          *(f32x4*)((char*)c.OG + (((size_t)c.b * 4096 + nn * 64) * 512 + c.h * 128 + c.slice * 32) * 4 + c.lo) = s.O + OX * sc; }
      else { const size_t row = valid ? (size_t)c.b * 4096 + (n - 4) * 64 + c.tr * 16 + c.fr : (size_t)LROWS + c.tr * 16 + c.fr;
          u32x2 o; o.x = pk2(OX[0] * sc, OX[1] * sc); o.y = pk2(OX[2] * sc, OX[3] * sc);
          *(u32x2*)(c.OGB + row * 512 + c.h * 128 + c.slice * 32 + c.tc * 16 + c.fq * 4) = o; } }
    lds_barrier();
    { S0 *= s.gl; S1 *= s.gl;
#pragma unroll
      for (int kk = 0; kk < 2; ++kk) { S0 = MFMA16(s.K[kk], lds16(L + S_VT + c.fr * 144 + kk * 64 + c.fq * 16), S0); S1 = MFMA16(s.K[kk], lds16(L + S_VT + (16 + c.fr) * 144 + kk * 64 + c.fq * 16), S1); }
      u32x2 o; o.x = pk2(S0[0], S0[1]); o.y = pk2(S0[2], S0[3]); *(LAS u32x2*)(L + S_ST + c.fr * 272 + (c.w * 16 + c.fq * 4) * 2) = o;
      o.x = pk2(S1[0], S1[1]); o.y = pk2(S1[2], S1[3]); *(LAS u32x2*)(L + S_ST + (16 + c.fr) * 272 + (c.w * 16 + c.fq * 4) * 2) = o; }
    lds_barrier();
}
DI void scan_gdn(const Params& p, ldsp L, int b, int h, int dir, int slice, float osc) {
    const int tid = threadIdx.x, lane = tid & 63, w = __builtin_amdgcn_readfirstlane(tid >> 6);
    GCtx c; c.Wb = (const bf16_t*)(p.ws + (dir ? WS_WB : WS_WF)); c.Ub = (const bf16_t*)(p.ws + (dir ? WS_UB : WS_UF)); c.Qb = (const bf16_t*)(p.ws + (dir ? WS_QB : WS_QF));
    c.KC = (const bf16_t*)(p.ws + WS_KC); c.DEC = (const float*)(p.ws + WS_DEC); c.OG = p.out; c.OGB = (bf16_t*)(p.ws + WS_OGB);
    c.b = b; c.h = h; c.dir = dir; c.slice = slice; c.w = w; c.fr = lane & 15; c.fq = lane >> 4; c.tr = w >> 1; c.tc = w & 1; c.osc = osc;
    c.lw = (unsigned)((c.tr * 256 + c.fq * 16 + c.fr) * 16); c.lk = (unsigned)(((w * 8 + c.fq) * 512 + c.fr * 8) * 2);
    c.lu = (unsigned)(((slice * 32 + c.tc * 16 + c.fr) * 64 + c.tr * 16 + c.fq * 4) * 2); c.lo = (unsigned)(((c.tr * 16 + c.fr) * 512 + c.tc * 16 + c.fq * 4) * 4);
    for (int e = tid; e < (8704 + 4608) / 4; e += NT) ((LAS unsigned*)L)[e] = 0u;
    lds_barrier();
    f32x4 S0 = {0.f, 0.f, 0.f, 0.f}, S1 = {0.f, 0.f, 0.f, 0.f};
    GSet A, B, C;
    gdn_load(A, c, chunk_of(0, dir)); gdn_load(B, c, chunk_of(1, dir));
#pragma unroll 1
    for (int i = 0; i < 66; i += 6) {
        gdn_load(C, c, chunk_of(i + 2, dir)); gdn_step(A, c, L, S0, S1, chunk_of(i, dir));
        gdn_load(A, c, chunk_of(i + 3, dir)); gdn_step(B, c, L, S0, S1, chunk_of(i + 1, dir));
        gdn_load(B, c, chunk_of(i + 4, dir)); gdn_step(C, c, L, S0, S1, chunk_of(i + 2, dir));
        gdn_load(C, c, chunk_of(i + 5, dir)); gdn_step(A, c, L, S0, S1, chunk_of(i + 3, dir));
        gdn_load(A, c, chunk_of(i + 6, dir)); gdn_step(B, c, L, S0, S1, chunk_of(i + 4, dir));
        gdn_load(B, c, chunk_of(i + 7, dir)); gdn_step(C, c, L, S0, S1, chunk_of(i + 5, dir));
    }
    gdn_step(A, c, L, S0, S1, chunk_of(66, dir)); gdn_step(B, c, L, S0, S1, chunk_of(67, dir));
}

struct RSet { bf16x8 Q[4], K[2]; u32x2 V; f32x4 O; };
struct RCtx { const bf16_t *RQ, *RK, *RV; float* ORp; bf16_t* ORB; int b, h, dir, slice, w, fr, fq, tr, tc, vt, vc4; unsigned lq, lk, lv, lo; float osc, gC, zeta, xiT; };
DI void ret_load(RSet& s, const RCtx& c, int n) {
    const size_t r0 = (size_t)c.b * TT + n * 64; const size_t ub = (r0 * 512 + c.h * 128) * 2;
    const char* qp = (const char*)c.RQ + ub;
#pragma unroll
    for (int kk = 0; kk < 4; ++kk) s.Q[kk] = *(const bf16x8*)(qp + (c.lq + kk * 4 * 512 * 2));
    const char* kp = (const char*)c.RK + ub;
    s.K[0] = *(const bf16x8*)(kp + c.lk); s.K[1] = *(const bf16x8*)(kp + (c.lk + 4 * 512 * 2));
    s.V = *(const u32x2*)((const char*)c.RV + ub + c.lv);
    if (c.dir == 0) { const int nn = n >= 4 ? n - 4 : 0; s.O = *(const f32x4*)((const char*)c.ORp + (((size_t)c.b * 4096 + nn * 64) * 512 + c.h * 128 + c.slice * 32) * 4 + c.lo); }
}
DI void ret_step(const RSet& s, const RCtx& c, ldsp L, f32x4& S0, f32x4& S1, int n) {
    { unsigned vz[4] = {f2bf(bflo(s.V.x) * c.zeta), f2bf(bfhi(s.V.x) * c.zeta), f2bf(bflo(s.V.y) * c.zeta), f2bf(bfhi(s.V.y) * c.zeta)};
      const int sft = (c.vc4 >> 3) & 3; rot4(vz, sft);
#pragma unroll
      for (int i = 0; i < 4; ++i) *(LAS unsigned short*)(L + S_VT + (c.vc4 + ((i + sft) & 3)) * 144 + c.vt * 2) = (unsigned short)vz[i]; }
    { f32x4 OX = {0.f, 0.f, 0.f, 0.f};
#pragma unroll
      for (int kk = 0; kk < 4; ++kk) OX = MFMA16(lds16(L + S_ST + (c.tc * 16 + c.fr) * 272 + kk * 64 + c.fq * 16), s.Q[kk], OX);
      const bool valid = n >= 4; const float sc = valid ? c.osc * c.xiT : 0.f;
      if (c.dir == 0) { const int nn = valid ? n - 4 : 0;
          *(f32x4*)((char*)c.ORp + (((size_t)c.b * 4096 + nn * 64) * 512 + c.h * 128 + c.slice * 32) * 4 + c.lo) = s.O + OX * sc; }
      else { const size_t row = valid ? (size_t)c.b * 4096 + (n - 4) * 64 + c.tr * 16 + c.fr : (size_t)LROWS + c.tr * 16 + c.fr;
          u32x2 o; o.x = pk2(OX[0] * sc, OX[1] * sc); o.y = pk2(OX[2] * sc, OX[3] * sc);
          *(u32x2*)(c.ORB + row * 512 + c.h * 128 + c.slice * 32 + c.tc * 16 + c.fq * 4) = o; } }
    lds_barrier();
    { S0 *= c.gC; S1 *= c.gC;
#pragma unroll
      for (int kk = 0; kk < 2; ++kk) { S0 = MFMA16(s.K[kk], lds16(L + S_VT + c.fr * 144 + kk * 64 + c.fq * 16), S0); S1 = MFMA16(s.K[kk], lds16(L + S_VT + (16 + c.fr) * 144 + kk * 64 + c.fq * 16), S1); }
      u32x2 o; o.x = pk2(S0[0], S0[1]); o.y = pk2(S0[2], S0[3]); *(LAS u32x2*)(L + S_ST + c.fr * 272 + (c.w * 16 + c.fq * 4) * 2) = o;
      o.x = pk2(S1[0], S1[1]); o.y = pk2(S1[2], S1[3]); *(LAS u32x2*)(L + S_ST + (16 + c.fr) * 272 + (c.w * 16 + c.fq * 4) * 2) = o; }
    lds_barrier();
}
DI void scan_ret(const Params& p, ldsp L, int b, int h, int dir, int slice, float osc) {
    const int tid = threadIdx.x, lane = tid & 63, w = __builtin_amdgcn_readfirstlane(tid >> 6);
    RCtx c; c.RQ = (const bf16_t*)(p.ws + WS_RQ); c.RK = (const bf16_t*)(p.ws + WS_RK); c.RV = (const bf16_t*)(p.ws + WS_RV); c.ORp = p.out + (size_t)LROWS * 512; c.ORB = (bf16_t*)(p.ws + WS_ORB);
    c.b = b; c.h = h; c.dir = dir; c.slice = slice; c.w = w; c.fr = lane & 15; c.fq = lane >> 4; c.tr = w >> 1; c.tc = w & 1; c.osc = osc; c.vt = tid >> 3; c.vc4 = (tid & 7) * 4;
    c.lq = (unsigned)(((c.tr * 16 + c.fq) * 512 + c.fr * 8) * 2); c.lk = (unsigned)(((w * 8 + c.fq) * 512 + c.fr * 8) * 2); c.lv = (unsigned)((c.vt * 512 + slice * 32 + c.vc4) * 2); c.lo = (unsigned)(((c.tr * 16 + c.fr) * 512 + c.tc * 16 + c.fq * 4) * 4);
    const float lg2 = logsig_f(p.ret_logit[dir * 4 + h]) * 1.4426950408889634f;
    c.gC = exp2f(64.f * lg2); c.zeta = exp2f((float)(dir ? c.vt : 63 - c.vt) * lg2);
    { const int t = c.tr * 16 + c.fr; c.xiT = exp2f((float)(dir ? 64 - t : t + 1) * lg2); }
    for (int e = tid; e < (8704 + 4608) / 4; e += NT) ((LAS unsigned*)L)[e] = 0u;
    lds_barrier();
    f32x4 S0 = {0.f, 0.f, 0.f, 0.f}, S1 = {0.f, 0.f, 0.f, 0.f};
    RSet A, B, C;
    ret_load(A, c, chunk_of(0, dir)); ret_load(B, c, chunk_of(1, dir));
#pragma unroll 1
    for (int i = 0; i < 66; i += 6) {
        ret_load(C, c, chunk_of(i + 2, dir)); ret_step(A, c, L, S0, S1, chunk_of(i, dir));
        ret_load(A, c, chunk_of(i + 3, dir)); ret_step(B, c, L, S0, S1, chunk_of(i + 1, dir));
        ret_load(B, c, chunk_of(i + 4, dir)); ret_step(C, c, L, S0, S1, chunk_of(i + 2, dir));
        ret_load(C, c, chunk_of(i + 5, dir)); ret_step(A, c, L, S0, S1, chunk_of(i + 3, dir));
        ret_load(A, c, chunk_of(i + 6, dir)); ret_step(B, c, L, S0, S1, chunk_of(i + 4, dir));
        ret_load(B, c, chunk_of(i + 7, dir)); ret_step(C, c, L, S0, S1, chunk_of(i + 5, dir));
    }
    ret_step(A, c, L, S0, S1, chunk_of(66, dir)); ret_step(B, c, L, S0, S1, chunk_of(67, dir));
}

DI void phase_postnorm(const Params& p, ldsp L) {
    const int tid = threadIdx.x, lane = tid & 63, w = tid >> 6;
    const float* OG = p.out; const float* ORp = p.out + (size_t)LROWS * 512;
    const bf16_t* Z = (const bf16_t*)(p.ws + WS_Z); const bf16_t* RG = (const bf16_t*)(p.ws + WS_RG);
    const bf16_t* OGB = (const bf16_t*)(p.ws + WS_OGB); const bf16_t* ORB = (const bf16_t*)(p.ws + WS_ORB);
    bf16_t* Y = (bf16_t*)(p.ws + WS_Y);
    const int d0 = (lane & 15) * 8;
    float gg[8], rg_[8];
#pragma unroll
    for (int e = 0; e < 8; ++e) { gg[e] = p.gdn_norm_g[d0 + e]; rg_[e] = p.ret_norm_g[d0 + e]; }
#pragma unroll 2
    for (int R = blockIdx.x * 8 + w; R < LROWS; R += gridDim.x * 8) {
        const size_t prow = (size_t)(R >> 12) * TT + 256 + (R & 4095);
        { const f32x4 a = __builtin_nontemporal_load((const f32x4*)(OG + (size_t)R * 512 + lane * 8)), c = __builtin_nontemporal_load((const f32x4*)(OG + (size_t)R * 512 + lane * 8 + 4));
          const u32x4 sb = __builtin_nontemporal_load((const u32x4*)(OGB + (size_t)R * 512 + lane * 8));
          float v[8] = {a.x + bflo(sb.x), a.y + bfhi(sb.x), a.z + bflo(sb.y), a.w + bfhi(sb.y), c.x + bflo(sb.z), c.y + bfhi(sb.z), c.z + bflo(sb.w), c.w + bfhi(sb.w)}; float ss = 0;
#pragma unroll
          for (int e = 0; e < 8; ++e) ss += v[e] * v[e];
          ss += __shfl_xor(ss, 1); ss += __shfl_xor(ss, 2); ss += __shfl_xor(ss, 4); ss += __shfl_xor(ss, 8);
          const float rs = rsqrtf(ss * (1.f / 128.f) + 1e-6f);
          const u32x4 z = __builtin_nontemporal_load((const u32x4*)(Z + prow * 512 + lane * 8)); const unsigned zz[4] = {z.x, z.y, z.z, z.w}; unsigned o[4];
#pragma unroll
          for (int e = 0; e < 4; ++e) o[e] = pk2(v[2 * e] * rs * gg[2 * e] * silu_f(bflo(zz[e])), v[2 * e + 1] * rs * gg[2 * e + 1] * silu_f(bfhi(zz[e])));
          *(u32x4*)(Y + (size_t)R * 1024 + lane * 8) = (u32x4){o[0], o[1], o[2], o[3]}; }
        { const f32x4 a = __builtin_nontemporal_load((const f32x4*)(ORp + (size_t)R * 512 + lane * 8)), c = __builtin_nontemporal_load((const f32x4*)(ORp + (size_t)R * 512 + lane * 8 + 4));
          const u32x4 sb = __builtin_nontemporal_load((const u32x4*)(ORB + (size_t)R * 512 + lane * 8));
          float v[8] = {a.x + bflo(sb.x), a.y + bfhi(sb.x), a.z + bflo(sb.y), a.w + bfhi(sb.y), c.x + bflo(sb.z), c.y + bfhi(sb.z), c.z + bflo(sb.w), c.w + bfhi(sb.w)}; float s = 0;
#pragma unroll
          for (int e = 0; e < 8; ++e) s += v[e];
          s += __shfl_xor(s, 1); s += __shfl_xor(s, 2); s += __shfl_xor(s, 4); s += __shfl_xor(s, 8);
          const float mu = s * (1.f / 128.f); float ss = 0;
#pragma unroll
          for (int e = 0; e < 8; ++e) { v[e] -= mu; ss += v[e] * v[e]; }
          ss += __shfl_xor(ss, 1); ss += __shfl_xor(ss, 2); ss += __shfl_xor(ss, 4); ss += __shfl_xor(ss, 8);
          const float rs = rsqrtf(ss * (1.f / 128.f) + 1e-6f);
          const u32x4 z = __builtin_nontemporal_load((const u32x4*)(RG + prow * 512 + lane * 8)); const unsigned zz[4] = {z.x, z.y, z.z, z.w}; unsigned o[4];
#pragma unroll
          for (int e = 0; e < 4; ++e) o[e] = pk2(v[2 * e] * rs * rg_[2 * e] * silu_f(bflo(zz[e])), v[2 * e + 1] * rs * rg_[2 * e + 1] * silu_f(bfhi(zz[e])));
          *(u32x4*)(Y + (size_t)R * 1024 + 512 + lane * 8) = (u32x4){o[0], o[1], o[2], o[3]}; }
    }
    __syncthreads();
    bf16_t* WoT = (bf16_t*)(p.ws + WS_WOUTT); bf16_t* WfiT = (bf16_t*)(p.ws + WS_WFIT); bf16_t* WfoT = (bf16_t*)(p.ws + WS_WFOT);
    if (gridDim.x == 256) {
        for (int j = blockIdx.x; j < 1408; j += 2 * gridDim.x) { TD d[2];
#pragma unroll
            for (int u = 0; u < 2; ++u) { const int jj = j + u * gridDim.x, jc = jj < 1408 ? jj : j, kt = jc & 15, nt = jc >> 4, n0 = nt * 64, pn = n0 >> 8, bj = (n0 >> 7) & 1, i = n0 & 127;
                d[u] = TD{p.w_ffn_in, 5632, kt * 64, bj * 2816 + pn * 128 + i, WfiT, 1024, n0, jj < 1408}; }
            transpose2(d[0], d[1], L); }
    } else
    for (int j = blockIdx.x; j < 256 + 1408 + 704; j += gridDim.x) {
        if (j < 256) { const int kt = j & 15, nt = j >> 4; transpose_item(p.w_out, 1024, kt * 64, nt * 64, WoT, 1024, nt * 64, L); }
        else if (j < 256 + 1408) { const int jj = j - 256, kt = jj & 15, nt = jj >> 4, n0 = nt * 64;
            const int pn = n0 >> 8, bj = (n0 >> 7) & 1, i = n0 & 127; transpose_item(p.w_ffn_in, 5632, kt * 64, bj * 2816 + pn * 128 + i, WfiT, 1024, n0, L); }
        else { const int jj = j - 256 - 1408, kt = jj % 44, nt = jj / 44; transpose_item(p.w_ffn_out, 1024, kt * 64, nt * 64, WfoT, 2816, nt * 64, L); }
    }
}

DI void phase_norm2(const Params& p) {
    const int tid = threadIdx.x, lane = tid & 63, w = tid >> 6;
    const float* X1 = (const float*)(p.ws + WS_X1); const float* MOD = (const float*)(p.ws + WS_MOD); bf16_t* A3 = (bf16_t*)(p.ws + WS_A3);
    const int nwv = gridDim.x * 8;
    for (int R0 = blockIdx.x * 8 + w; R0 < LROWS; R0 += 2 * nwv) {
        f32x4 v[2][4]; int Rr[2]; bool ok[2];
#pragma unroll
        for (int u = 0; u < 2; ++u) { const int R = R0 + u * nwv; ok[u] = R < LROWS; Rr[u] = ok[u] ? R : R0; const float* src = X1 + (size_t)Rr[u] * 1024;
#pragma unroll
            for (int i = 0; i < 4; ++i) v[u][i] = *(const f32x4*)(src + (lane + 64 * i) * 4); }
        float ss[2];
#pragma unroll
        for (int u = 0; u < 2; ++u) { ss[u] = 0;
#pragma unroll
            for (int i = 0; i < 4; ++i) ss[u] += v[u][i].x * v[u][i].x + v[u][i].y * v[u][i].y + v[u][i].z * v[u][i].z + v[u][i].w * v[u][i].w; }
        for (int o = 32; o; o >>= 1) { ss[0] += __shfl_xor(ss[0], o); ss[1] += __shfl_xor(ss[1], o); }
#pragma unroll
        for (int u = 0; u < 2; ++u) { const float rstd = rsqrtf(ss[u] * (1.f / 1024.f) + 1e-6f); const float* mod = MOD + (size_t)(Rr[u] >> 12) * 6144;
#pragma unroll
            for (int i = 0; i < 4; ++i) { const int k = (lane + 64 * i) * 4;
                const f32x4 g = *(const f32x4*)(p.norm_ffn_g + k), sh = *(const f32x4*)(mod + 3072 + k), sc = *(const f32x4*)(mod + 4096 + k);
                const f32x4 hh = v[u][i] * rstd * g * (sc + 1.f) + sh;
                u32x2 o; o.x = pk2(hh.x, hh.y); o.y = pk2(hh.z, hh.w); if (ok[u]) *(u32x2*)(A3 + (size_t)Rr[u] * 1024 + k) = o; } }
    }
}
DI void phase_final(const Params& p) {
    const float* SSF = (const float*)(p.ws + WS_SSF);
    const int nth = gridDim.x * NT;
#pragma unroll 1
    for (int c0 = blockIdx.x * NT + threadIdx.x; c0 < LROWS * 256; c0 += 8 * nth) {
        f32x4 v[8]; float rs[8];
#pragma unroll
        for (int u = 0; u < 8; ++u) { const int c = c0 + u * nth; v[u] = __builtin_nontemporal_load((const f32x4*)(p.out + (size_t)c * 4)); rs[u] = SSF[c >> 8]; }
#pragma unroll
        for (int u = 0; u < 8; ++u) { const int c = c0 + u * nth; const f32x4 g = *(const f32x4*)(p.final_g + (c & 255) * 4);
            __builtin_nontemporal_store(v[u] * rsqrtf(rs[u] * (1.f / 1024.f) + 1e-6f) * g, (f32x4*)(p.out + (size_t)c * 4)); }
    }
}

#define XB_TMO      128
#define XB_XCNT(j)  (256  + 64 * (j))
#define XB_XSUB(j)  (1280 + 64 * (j))
#define XB_XGEN(j)  (2304 + 64 * (j))
#define XB_TOP      3328
#define XB_TOPGEN   3392
#define XCD_BAR_WORDS 3456
#define XB_SPIN_CAP (1u << 18)

__device__ __forceinline__ unsigned xb_ld(unsigned* p)              { return __hip_atomic_load(p, __ATOMIC_RELAXED, __HIP_MEMORY_SCOPE_AGENT); }
__device__ __forceinline__ unsigned xb_add(unsigned* p, unsigned v) { return __hip_atomic_fetch_add(p, v, __ATOMIC_RELAXED, __HIP_MEMORY_SCOPE_AGENT); }
__device__ __forceinline__ unsigned xb_xcc_id() { return (unsigned)__builtin_amdgcn_s_getreg((3 << 11) | 20) & 0xFu; }
#define XB_SPIN(cond, bar) do { unsigned _sp = 0; while (cond) { __builtin_amdgcn_s_sleep(1); \
    if ((++_sp & 255u) == 0u) { if (xb_ld(&(bar)[XB_TMO])) break; if (_sp > XB_SPIN_CAP) { atomicAdd(&(bar)[XB_TMO], 1u); break; } } } } while (0)

struct XcdBarrier {
    unsigned* bar; unsigned x;
    volatile LAS unsigned* st;
};

__device__ __forceinline__ XcdBarrier xcd_barrier_post(unsigned* bar, volatile LAS unsigned* st) {
    XcdBarrier b; b.bar = bar; b.x = xb_xcc_id(); b.st = st;
    if (threadIdx.x == 0) (void)xb_add(&bar[XB_XCNT(b.x)], 1u);
    return b;
}
__device__ __forceinline__ void xcd_barrier_complete(unsigned* bar, unsigned x, unsigned& nloc, unsigned& nx) {
    const unsigned G = gridDim.x * gridDim.y * gridDim.z;
    unsigned sum, cnt, mine, sp = 0u;
    for (;;) {
        sum = 0u; cnt = 0u; mine = 0u;
#pragma unroll
        for (unsigned j = 0; j < 16; ++j) { const unsigned c = xb_ld(&bar[XB_XCNT(j)]); sum += c; cnt += (c > 0u) ? 1u : 0u; mine = (j == x) ? c : mine; }
        if (sum == G) break;
        __builtin_amdgcn_s_sleep(1);
        if ((++sp & 255u) == 0u) { if (xb_ld(&bar[XB_TMO])) break; if (sp > XB_SPIN_CAP) { atomicAdd(&bar[XB_TMO], 1u); break; } }
    }
    nloc = mine > 0u ? mine : 1u; nx = cnt > 0u ? cnt : 1u;
}

__device__ __forceinline__ void xcd_barrier(const XcdBarrier& b) {
    asm volatile("s_waitcnt vmcnt(0)" ::: "memory");
    __syncthreads();
    if (threadIdx.x == 0) {
        unsigned* bar = b.bar;
        __builtin_amdgcn_s_waitcnt(0);
        unsigned nloc = b.st[0], nx = b.st[1];
        if (nloc == 0u) { xcd_barrier_complete(bar, b.x, nloc, nx); b.st[0] = nloc; b.st[1] = nx; }
        const unsigned old = xb_add(&bar[XB_XSUB(b.x)], 1u);
        const unsigned gen = old / nloc;
        if (old + 1u == (gen + 1u) * nloc) {
            __builtin_amdgcn_fence(__ATOMIC_RELEASE, "agent");
            asm volatile("s_waitcnt vmcnt(0)" ::: "memory");
            const unsigned og = xb_add(&bar[XB_TOP], 1u);
            const unsigned tg = og / nx;
            if (og + 1u == (tg + 1u) * nx) xb_add(&bar[XB_TOPGEN], 1u);
            else XB_SPIN(xb_ld(&bar[XB_TOPGEN]) == tg, bar);
            __builtin_amdgcn_fence(__ATOMIC_ACQUIRE, "agent");
            xb_add(&bar[XB_XGEN(b.x)], 1u);
            asm volatile("s_waitcnt vmcnt(0)" ::: "memory");
        } else {
            XB_SPIN(xb_ld(&bar[XB_XGEN(b.x)]) == gen, bar);
            __builtin_amdgcn_fence(__ATOMIC_ACQUIRE, "agent");
            asm volatile("s_waitcnt vmcnt(0)" ::: "memory");
        }
    }
    __syncthreads();
}

#ifndef GEMM_ALIGN
#define GEMM_ALIGN true
#endif
#ifndef GEMM_SP2
#define GEMM_SP2 true
#endif
__global__ void __launch_bounds__(NT) mega_fwd(Params p) {
    extern __shared__ __attribute__((aligned(16))) unsigned char lds_raw[];
    ldsp L = (ldsp)lds_raw;
    cg::grid_group grid = cg::this_grid();
    const int lo = p.ph_lo, hi = p.ph_hi;
#ifndef PHMASK
#define PHMASK 0xFFF
#endif
#define IN(k) (((PHMASK >> (k)) & 1) && lo <= (k) && (k) < hi)
    volatile LAS unsigned* xst = (volatile LAS unsigned*)(L + 149000);
    if (threadIdx.x == 0) { xst[0] = 0u; xst[1] = 0u; }
    __syncthreads();
    if (p.pad == 0x5a5a) grid.sync();
    const XcdBarrier xbar = xcd_barrier_post((unsigned*)(p.ws + WS_BAR), xst);
#define SEAM(k) do { if ((k) + 1 < hi) xcd_barrier(xbar); } while (0)
#ifndef DUPMASK
#define DUPMASK 0
#endif
#define NREP(k) (((DUPMASK >> (k)) & 1) ? 2 : 1)
    if (IN(0)) { { phase0(p, L); __syncthreads(); } SEAM(0); }
    if (IN(1)) { { phase1(p, L); __syncthreads(); } SEAM(1); }
    if (IN(2)) { { pg8::Gemm g{(const bf16_t*)(p.ws + WS_A1), (const bf16_t*)(p.ws + WS_WINT), MROWS, N1, 1024}; pg8::StaticOrder S; S.init(MROWS, N1, gridDim.x, blockIdx.x);
        EpiP E{(bf16_t*)(p.ws + WS_P), (float*)(p.ws + WS_GATES)}; pg8::gemm_phase<EpiP, pg8::StaticOrder, GEMM_ALIGN, GEMM_SP2>(L, g, S, E); } SEAM(2); }
    if (IN(3)) { phase_conv(p); SEAM(3); }
    if (IN(4)) { { const bool dry = p.dry != 0;
        if (gridDim.x == 256) {
            const int bx = blockIdx.x;
            for (int it = bx; it < 1088; it += 256) prep_gdn(p, L, it, dry);
            if (bx < 64) { prep_ret(p, L, bx * 2, dry); prep_ret(p, L, bx * 2 + 1, dry); }
            else { for (int j = 0; j < 5; ++j) prep_ret(p, L, 128 + (bx - 64) * 5 + j, dry); }
        } else { for (int it = blockIdx.x; it < 2176; it += gridDim.x) { if (it < 1088) prep_gdn(p, L, it, dry); else prep_ret(p, L, it - 1088, dry); } } } SEAM(4); }
    if (IN(5)) { { const float osc = p.dry ? 0.f : 1.f; for (int bx = blockIdx.x; bx < 256; bx += gridDim.x) { const int xx = bx & 7, yy = bx >> 3, slice = yy & 3, G = (yy >> 2) * 8 + xx;
            const int ty = G >> 5, dir = G & 1, h = (G >> 1) & 3, b = (G >> 3) & 3;
            if (ty == 0) scan_gdn(p, L, b, h, dir, slice, osc); else scan_ret(p, L, b, h, dir, slice, osc); __syncthreads();
            if (ty == 1 && gridDim.x == 256) {
                bf16_t* WoT = (bf16_t*)(p.ws + WS_WOUTT); bf16_t* WfoT = (bf16_t*)(p.ws + WS_WFOT);
                for (int j = bx - 128; j < 960; j += 256) { TD d[2];
#pragma unroll
                    for (int u = 0; u < 2; ++u) { const int jj = j + u * 128, jc = jj < 960 ? jj : j;
                        if (jc < 256) { const int kt = jc & 15, nt = jc >> 4; d[u] = TD{p.w_out, 1024, kt * 64, nt * 64, WoT, 1024, nt * 64, jj < 960}; }
                        else { const int j2 = jc - 256, kt = j2 % 44, nt = j2 / 44; d[u] = TD{p.w_ffn_out, 1024, kt * 64, nt * 64, WfoT, 2816, nt * 64, jj < 960}; } }
                    transpose2(d[0], d[1], L); } } } } SEAM(5); }
    if (IN(6)) { { phase_postnorm(p, L); __syncthreads(); } SEAM(6); }
    if (IN(7)) { { pg8::Gemm g{(const bf16_t*)(p.ws + WS_Y), (const bf16_t*)(p.ws + WS_WOUTT), LROWS, 1024, 1024}; pg8::StaticOrder S; S.init(LROWS, 1024, gridDim.x, blockIdx.x);
        EpiRes2 E{(bf16_t*)(p.ws + WS_X1B), p.x, (const float*)(p.ws + WS_MOD), p.norm_ffn_g, (bf16_t*)(p.ws + WS_A3), (float*)(p.ws + WS_SS)}; pg8::gemm_phase<EpiRes2, pg8::StaticOrder, GEMM_ALIGN, GEMM_SP2>(L, g, S, E); } SEAM(7); }
    if (IN(9)) { { pg8::Gemm g{(const bf16_t*)(p.ws + WS_A3), (const bf16_t*)(p.ws + WS_WFIT), LROWS, 5632, 1024}; pg8::StaticOrder S; S.init(LROWS, 5632, gridDim.x, blockIdx.x);
        EpiGLU2 E{(bf16_t*)(p.ws + WS_H), (const float*)(p.ws + WS_SS), (const float*)(p.ws + WS_BIAS2)}; pg8::gemm_phase<EpiGLU2, pg8::StaticOrder, GEMM_ALIGN, GEMM_SP2>(L, g, S, E); } SEAM(9); }
    if (IN(10)) { { pg8::Gemm g{(const bf16_t*)(p.ws + WS_H), (const bf16_t*)(p.ws + WS_WFOT), LROWS, 1024, 2816}; pg8::StaticOrder S; S.init(LROWS, 1024, gridDim.x, blockIdx.x);
        EpiRes3 E{p.out, (const bf16_t*)(p.ws + WS_X1B), (const float*)(p.ws + WS_MOD) + 5120, (float*)(p.ws + WS_SSF)}; pg8::gemm_phase<EpiRes3, pg8::StaticOrder, GEMM_ALIGN, GEMM_SP2>(L, g, S, E); } SEAM(10); }
    if (IN(11)) { phase_final(p); }
}

extern "C" void kernel_launch(void* const* d_in, const int* in_sizes, int n_in, void* d_out, int out_size, void* d_ws, size_t ws_size, hipStream_t stream) {
    static int grid_blocks = 0;
    if (!grid_blocks) {
        int dev = 0, cus = 0, per_cu = 0;
        hipGetDevice(&dev);
        hipDeviceGetAttribute(&cus, hipDeviceAttributeMultiprocessorCount, dev);
        if (hipFuncSetAttribute((const void*)mega_fwd, hipFuncAttributeMaxDynamicSharedMemorySize, LDS_BYTES) != hipSuccess) fprintf(stderr, "hipFuncSetAttribute failed\n");
        hipOccupancyMaxActiveBlocksPerMultiprocessor(&per_cu, (const void*)mega_fwd, NT, LDS_BYTES);
        if (per_cu < 1) per_cu = 1;
        grid_blocks = cus * per_cu;
        if (grid_blocks > 256) grid_blocks = 256;
    }
#ifndef PROBE_SEQ
#define PROBE_SEQ {0, 12, 0}
#endif
    static const int seq[][3] = {PROBE_SEQ};
    hipError_t e = hipSuccess;
    for (unsigned li = 0; li < sizeof(seq) / sizeof(seq[0]); ++li) {
        Params p{};
        const float** f = (const float**)&p;
        for (int i = 0; i < 19; ++i) f[i] = (const float*)d_in[i];
        p.out = (float*)d_out; p.ws = (unsigned char*)d_ws; p.ph_lo = seq[li][0]; p.ph_hi = seq[li][1]; p.dry = seq[li][2]; p.pad = 0;
        void* args[] = {&p};
        if (hipMemsetAsync((unsigned char*)d_ws + WS_BAR, 0, 3456 * 4, stream) != hipSuccess) fprintf(stderr, "barrier memset failed\n");
        e = hipLaunchCooperativeKernel((const void*)mega_fwd, dim3(grid_blocks), dim3(NT), args, LDS_BYTES, stream);
        if (e != hipSuccess) break;
    }
    if (e != hipSuccess) fprintf(stderr, "cooperative launch failed: %s (grid %d)\n", hipGetErrorString(e), grid_blocks);
}
```
